# Optimizing an MI355X kernel written in HIP

```python
import jax, jax.numpy as jnp
from jax import lax
import numpy as np

D_MODEL = 1024
BATCH = 4
SEQ = 4096
DEPTH = 2

HEAD_DIM = 64
ROPE_THETA = 10000.0
DIL_CONFIGS = ((128, 1), (512, 4), (2048, 16))
N_DIL_GROUPS = 3
DIL_HEADS = 4
DIL_WIDTH = N_DIL_GROUPS * DIL_HEADS * HEAD_DIM
DIL_OUT = DIL_HEADS * HEAD_DIM
SB_HEADS = 8
SB_WIDTH = SB_HEADS * HEAD_DIM
SB_BLOCK = 128
POOL_WINDOWS = (2, 4, 8, 16)
POOL_GROUP = 128
POOL_WIDTH = len(POOL_WINDOWS) * POOL_GROUP
N_BRANCH = 3
IN_WIDTH = 3 * DIL_WIDTH + 3 * SB_WIDTH + POOL_WIDTH
MOE_GROUPS = 4
EXP_PER_GROUP = 4
N_EXPERTS = MOE_GROUPS * EXP_PER_GROUP
TOP_K_INNER = 2
EXP_HIDDEN = 256
PLE_DIM = 256
EPS = 1e-6

kernel_name = "hybrid_dilated_stickbreak_pool_hmoe"


def rmsnorm(x, g):
    xf = x.astype(jnp.float32)
    y = xf * lax.rsqrt(jnp.mean(xf * xf, axis=-1, keepdims=True) + EPS)
    return (y * g.astype(jnp.float32)).astype(x.dtype)


def rope(t, positions):
    half = t.shape[-1] // 2
    inv = ROPE_THETA ** (-jnp.arange(half, dtype=jnp.float32) / half)
    ang = positions.astype(jnp.float32)[..., None] * inv
    cos = jnp.cos(ang)[:, :, None, :]
    sin = jnp.sin(ang)[:, :, None, :]
    t1 = t[..., :half].astype(jnp.float32)
    t2 = t[..., half:].astype(jnp.float32)
    return jnp.concatenate([t1 * cos - t2 * sin, t2 * cos + t1 * sin], axis=-1).astype(t.dtype)


def dilated_attention(q, k, v, window, dilation):
    b, s, h, c = q.shape
    n = window // dilation
    L = s // dilation
    nb = -(-L // n)
    pad = nb * n - L

    def to_blocks(t):
        t = t.reshape(b, L, dilation, h, c).transpose(0, 2, 1, 3, 4)
        t = jnp.pad(t, ((0, 0), (0, 0), (0, pad), (0, 0), (0, 0)))
        return t.reshape(b, dilation, nb, n, h, c)

    def with_prev(t):
        prev = jnp.pad(t[:, :, :-1], ((0, 0), (0, 0), (1, 0), (0, 0), (0, 0), (0, 0)))
        return jnp.concatenate([prev, t], axis=3)

    qb = to_blocks(q)
    kk = with_prev(to_blocks(k))
    vv = with_prev(to_blocks(v))
    scores = jnp.einsum('brnqhc,brnkhc->brnhqk', qb, kk,
                        preferred_element_type=jnp.float32) * (c ** -0.5)
    qi = jnp.arange(n)[:, None]
    kj = jnp.arange(2 * n)[None, :]
    band = (kj >= qi) & (kj <= qi + n)
    has_prev = (jnp.arange(nb) > 0)[:, None, None]
    mask = band[None] & (has_prev | (kj >= n)[None])
    scores = jnp.where(mask[:, None], scores, -jnp.inf)
    m = jnp.max(scores, axis=-1, keepdims=True)
    e = jnp.exp(scores - m)
    den = jnp.sum(e, axis=-1, keepdims=True)
    lse = (m + jnp.log(den))[..., 0]
    o = jnp.einsum('brnhqk,brnkhc->brnqhc', (e / den).astype(v.dtype), vv)
    o = o.reshape(b, dilation, nb * n, h, c)[:, :, :L].transpose(0, 2, 1, 3, 4).reshape(b, s, h, c)
    lse = lse.transpose(0, 1, 2, 4, 3).reshape(b, dilation, nb * n, h)[:, :, :L]
    lse = lse.transpose(0, 2, 1, 3).reshape(b, s, h)
    return o, lse


def dilated_mixture(q, k, v):
    outs, lses = [], []
    for g, (w, d) in enumerate(DIL_CONFIGS):
        o, l = dilated_attention(q[:, :, g], k[:, :, g], v[:, :, g], w, d)
        outs.append(o.astype(jnp.float32))
        lses.append(l)
    wts = jax.nn.softmax(jnp.stack(lses, axis=0), axis=0)
    o = jnp.sum(wts[..., None] * jnp.stack(outs, axis=0), axis=0)
    return o.astype(q.dtype)


def stick_breaking_attention(q, k, v):
    b, s, h, c = q.shape
    nb = s // SB_BLOCK
    kpos = jnp.arange(s)

    def block(ib):
        start = ib * SB_BLOCK
        qb = lax.dynamic_slice_in_dim(q, start, SB_BLOCK, axis=1)
        z = jnp.einsum('bqhc,bkhc->bhqk', qb, k,
                       preferred_element_type=jnp.float32) * (c ** -0.5)
        qpos = start + jnp.arange(SB_BLOCK)
        mask = kpos[None, :] < qpos[:, None]
        log_om = jnp.where(mask, jax.nn.log_sigmoid(-z), 0.0)
        after = lax.cumsum(log_om, axis=3, reverse=True) - log_om
        a = jnp.where(mask, jnp.exp(jax.nn.log_sigmoid(z) + after), 0.0)
        return jnp.einsum('bhqk,bkhc->bqhc', a.astype(v.dtype), v)

    o = lax.map(block, jnp.arange(nb))
    return o.transpose(1, 0, 2, 3, 4).reshape(b, s, h, c)


def pool_mixer(u, w_pool, pool_scale):
    b, s, _ = u.shape
    ng = len(POOL_WINDOWS)
    uf = u.astype(jnp.float32).reshape(b, s, ng, POOL_GROUP)
    cs = jnp.concatenate([jnp.zeros((b, 1, ng, POOL_GROUP), jnp.float32),
                          jnp.cumsum(uf, axis=1)], axis=1)
    pos = jnp.arange(s)
    outs = []
    for g, w in enumerate(POOL_WINDOWS):
        csg = cs[:, :, g]
        lower = jnp.pad(csg, ((0, 0), (w - 1, 0), (0, 0)))[:, :s]
        upper = csg[:, 1:]
        cnt = jnp.minimum(pos + 1, w).astype(jnp.float32)[None, :, None]
        outs.append((upper - lower) / cnt - uf[:, :, g])
    pooled = jnp.stack(outs, axis=2).astype(u.dtype)
    y = jnp.einsum('bsgc,gcd->bsgd', pooled, w_pool).reshape(b, s, POOL_WIDTH)
    return y * pool_scale


def hierarchical_moe(h, w_rg, b_rg, w_re, b_re, w_g, w_u, w_d):
    b, s, d = h.shape
    t = h.reshape(b * s, d)
    lg = jnp.einsum('td,dg->tg', t, w_rg, preferred_element_type=jnp.float32) + b_rg
    pg = jax.nn.softmax(lg, axis=-1)
    p1, gi = lax.top_k(pg, 1)
    le = jnp.einsum('td,gde->tge', t, w_re, preferred_element_type=jnp.float32) + b_re
    le_sel = jnp.take_along_axis(le, gi[:, :, None], axis=1)[:, 0]
    v2, ei = lax.top_k(le_sel, TOP_K_INNER)
    w2 = jax.nn.softmax(v2, axis=-1) * p1
    eid = gi * EXP_PER_GROUP + ei
    gate = jnp.sum(jax.nn.one_hot(eid, N_EXPERTS, dtype=jnp.float32) * w2[..., None], axis=1)
    hid = jax.nn.silu(jnp.einsum('td,edf->tef', t, w_g)) * jnp.einsum('td,edf->tef', t, w_u)
    y = jnp.einsum('tef,efd->td', hid * gate[:, :, None].astype(hid.dtype), w_d)
    return y.reshape(b, s, d)


def setup_inputs(seed: int = 0) -> dict:
    key = jax.random.key(seed)
    ks = jax.random.split(key, 26)
    f32 = jnp.float32
    nrm = lambda k, shape, scale: jax.random.normal(k, shape, f32) * scale
    L, D = DEPTH, D_MODEL
    return {
        "x": nrm(ks[0], (BATCH, SEQ, D), 1.0),
        "p": nrm(ks[1], (DEPTH, BATCH, SEQ, PLE_DIM), 1.0),
        "positions": jnp.broadcast_to(jnp.arange(SEQ, dtype=jnp.int32)[None, :], (BATCH, SEQ)),
        "norm_mix": 1.0 + nrm(ks[2], (L, D), 0.05),
        "w_in": nrm(ks[3], (L, D, IN_WIDTH), D ** -0.5),
        "w_gate": nrm(ks[4], (L, D, N_BRANCH * D), D ** -0.5),
        "b_gate": nrm(ks[5], (L, N_BRANCH * D), 0.1),
        "w_pool": nrm(ks[6], (L, len(POOL_WINDOWS), POOL_GROUP, POOL_GROUP), POOL_GROUP ** -0.5),
        "pool_scale": 1.0 + nrm(ks[7], (L, POOL_WIDTH), 0.1),
        "w_up_a": nrm(ks[8], (L, DIL_OUT, D), DIL_OUT ** -0.5),
        "w_up_b": nrm(ks[9], (L, SB_WIDTH, D), SB_WIDTH ** -0.5),
        "w_up_c": nrm(ks[10], (L, POOL_WIDTH, D), POOL_WIDTH ** -0.5),
        "w_out": nrm(ks[11], (L, D, D), D ** -0.5),
        "norm_moe": 1.0 + nrm(ks[12], (L, D), 0.05),
        "w_router_grp": nrm(ks[13], (L, D, MOE_GROUPS), D ** -0.5),
        "b_router_grp": nrm(ks[14], (L, MOE_GROUPS), 0.01),
        "w_router_exp": nrm(ks[15], (L, MOE_GROUPS, D, EXP_PER_GROUP), D ** -0.5),
        "b_router_exp": nrm(ks[16], (L, MOE_GROUPS, EXP_PER_GROUP), 0.01),
        "w_exp_gate": nrm(ks[17], (L, N_EXPERTS, D, EXP_HIDDEN), D ** -0.5),
        "w_exp_up": nrm(ks[18], (L, N_EXPERTS, D, EXP_HIDDEN), D ** -0.5),
        "w_exp_down": nrm(ks[19], (L, N_EXPERTS, EXP_HIDDEN, D), EXP_HIDDEN ** -0.5),
        "norm_ple": 1.0 + nrm(ks[20], (L, D), 0.05),
        "w_ple_in": nrm(ks[21], (L, PLE_DIM, D), PLE_DIM ** -0.5),
        "w_ple_gate": nrm(ks[22], (L, D, D), D ** -0.5),
        "norm_final": 1.0 + nrm(ks[23], (D,), 0.05),
    }


def reference(x, p, positions, norm_mix, w_in, w_gate, b_gate, w_pool, pool_scale,
              w_up_a, w_up_b, w_up_c, w_out, norm_moe, w_router_grp, b_router_grp,
              w_router_exp, b_router_exp, w_exp_gate, w_exp_up, w_exp_down,
              norm_ple, w_ple_in, w_ple_gate, norm_final):
    b, s, d = x.shape
    splits = [DIL_WIDTH, 2 * DIL_WIDTH, 3 * DIL_WIDTH, 3 * DIL_WIDTH + SB_WIDTH,
              3 * DIL_WIDTH + 2 * SB_WIDTH, 3 * DIL_WIDTH + 3 * SB_WIDTH]
    nd = N_DIL_GROUPS * DIL_HEADS
    for i in range(DEPTH):
        h = rmsnorm(x, norm_mix[i])
        proj = h @ w_in[i]
        qa, ka, va, qb, kb, vb, uc = jnp.split(proj, splits, axis=-1)
        qa = rope(qa.reshape(b, s, nd, HEAD_DIM), positions).reshape(b, s, N_DIL_GROUPS, DIL_HEADS, HEAD_DIM)
        ka = rope(ka.reshape(b, s, nd, HEAD_DIM), positions).reshape(b, s, N_DIL_GROUPS, DIL_HEADS, HEAD_DIM)
        va = va.reshape(b, s, N_DIL_GROUPS, DIL_HEADS, HEAD_DIM)
        ya = dilated_mixture(qa, ka, va).reshape(b, s, DIL_OUT) @ w_up_a[i]
        yb = stick_breaking_attention(qb.reshape(b, s, SB_HEADS, HEAD_DIM),
                                      kb.reshape(b, s, SB_HEADS, HEAD_DIM),
                                      vb.reshape(b, s, SB_HEADS, HEAD_DIM)).reshape(b, s, SB_WIDTH) @ w_up_b[i]
        yc = pool_mixer(uc, w_pool[i], pool_scale[i]) @ w_up_c[i]
        gates = jax.nn.sigmoid(h @ w_gate[i] + b_gate[i]).reshape(b, s, N_BRANCH, d)
        merged = gates[:, :, 0] * ya + gates[:, :, 1] * yb + gates[:, :, 2] * yc
        x = x + merged @ w_out[i]
        x = x + hierarchical_moe(rmsnorm(x, norm_moe[i]), w_router_grp[i], b_router_grp[i],
                                 w_router_exp[i], b_router_exp[i], w_exp_gate[i],
                                 w_exp_up[i], w_exp_down[i])
        ple_gate = jax.nn.sigmoid(rmsnorm(x, norm_ple[i]) @ w_ple_gate[i])
        x = x + (p[i] @ w_ple_in[i]) * ple_gate
    return rmsnorm(x, norm_final)
```

```cpp
#include <hip/hip_runtime.h>
#include <cstdio>
#include <cstdint>

constexpr int BATCH = 4, SEQ = 4096, T = BATCH * SEQ, D = 1024, DEPTH = 2;
constexpr int INW = 4352, C_QA = 0, C_KA = 768, C_VA = 1536, C_QB = 2304, C_KB = 2816, C_VB = 3328, C_UC = 3840;
#define PJ_HM(ch, row) (((size_t)(ch) * T + (size_t)(row)) * 64)
constexpr size_t PJ_UC = (size_t)60 * 16384 * 64;
constexpr int HC = 2304, HC_H = 0, HC_OA = 1024, HC_OB = 1280, HC_PL = 1792;
constexpr int NGATE = 3072, PLE_DIM = 256, EXP_H = 256, NEXP = 16;
constexpr float EPS = 1e-6f;
constexpr float C2 = 0.125f * 1.4426950408889634f;
constexpr int NTHREADS = 512, NWAVES = 8;

enum { I_X = 0, I_P, I_POS, I_NORM_MIX, I_W_IN, I_W_GATE, I_B_GATE, I_W_POOL, I_POOL_SCALE, I_W_UP_A, I_W_UP_B, I_W_UP_C, I_W_OUT, I_NORM_MOE,
       I_W_RG, I_B_RG, I_W_RE, I_B_RE, I_W_EG, I_W_EU, I_W_ED, I_NORM_PLE, I_W_PLE_IN, I_W_PLE_GATE, I_NORM_FINAL, N_IN };

constexpr size_t MiB = 1u << 20;
constexpr size_t WS_CTL = 0;
constexpr size_t WS_SMALL = 1 * MiB;
constexpr size_t WS_HCAT = 2 * MiB;
constexpr size_t WS_PROJ = 74 * MiB;
constexpr size_t WS_W = 210 * MiB;
constexpr size_t WS_ROPE = 256 * MiB;
constexpr size_t WS_LSE = 260 * MiB;
constexpr size_t WS_YCPRE = 262 * MiB;
constexpr size_t WS_END = 278 * MiB;
constexpr size_t OV_X3 = WS_PROJ + 32 * MiB;
constexpr size_t OV_GATES = WS_PROJ, OV_MERGED = WS_PROJ + 96 * MiB, OV_PLEG = WS_PROJ + 96 * MiB;
constexpr size_t SM_EID = WS_SMALL, SM_WGT = WS_SMALL + 128 * 1024;
constexpr size_t SM_RSTD_MOE = WS_LSE + 1 * MiB, SM_RSTD_PLE = SM_RSTD_MOE + 64 * 1024;
constexpr size_t SM_SSQ = WS_LSE + 2 * MiB;
__device__ __forceinline__ unsigned long long ssq_fix(float ps) { ps = __builtin_amdgcn_fmed3f(ps, 0.f, 2.0e9f); const unsigned hi = (unsigned)ps; const unsigned lo = (unsigned)((ps - (float)hi) * 4294967296.f); return ((unsigned long long)hi << 32) | lo; }
__device__ __forceinline__ float ssq_val(unsigned long long v) { return (float)(unsigned)(v >> 32) + (float)(unsigned)v * 2.3283064365386963e-10f; }

typedef unsigned short bf16;
typedef float f32x4 __attribute__((ext_vector_type(4)));
typedef unsigned u32x2 __attribute__((ext_vector_type(2)));
typedef unsigned u32x4 __attribute__((ext_vector_type(4)));

__device__ __forceinline__ unsigned f2bf(float f) { unsigned u = __builtin_bit_cast(unsigned, f); return (u + 0x7fffu + ((u >> 16) & 1u)) >> 16; }
__device__ __forceinline__ float bf2f(unsigned h) { return __builtin_bit_cast(float, h << 16); }
__device__ __forceinline__ unsigned pk2(float lo, float hi) { return f2bf(lo) | (f2bf(hi) << 16); }
__device__ __forceinline__ float bflo(unsigned w) { return __builtin_bit_cast(float, w << 16); }
__device__ __forceinline__ float bfhi(unsigned w) { return __builtin_bit_cast(float, w & 0xffff0000u); }
__device__ __forceinline__ float wave_sum(float v) {
#pragma unroll
    for (int o = 1; o < 64; o <<= 1) v += __shfl_xor(v, o);
    return v;
}
__device__ __forceinline__ float sigmoidf_(float x) { return 1.f / (1.f + __expf(-x)); }

struct Args { const void* in[N_IN]; float* out; unsigned char* ws; int ph_lo, ph_hi; };

struct Frame {
    int tid, lane, wave, wg, G;
    float* out; unsigned char* ws;
    float* lds;
};
extern __shared__ __attribute__((aligned(16))) unsigned char lds_raw[];
template <int I> __device__ __forceinline__ const void* arg_ptr() {
    const void* p; asm volatile("s_load_dwordx2 %0, %1, %2\n\ts_waitcnt lgkmcnt(0)" : "=s"(p) : "s"(__builtin_amdgcn_kernarg_segment_ptr()), "i"(I * 8) : "memory"); return p; }
static_assert(N_IN == 25, "Args layout: in[25] at 0, out at 200, ws at 208");

__device__ __forceinline__ int lane_id() { int l; asm volatile("v_mbcnt_lo_u32_b32 %0, -1, 0\n\tv_mbcnt_hi_u32_b32 %0, -1, %0" : "=v"(l)); return l; }
#define PHASE_FRAME(F0) Frame F; F.wave = (F0).wave; asm volatile("" : "+s"(F.wave)); F.lane = lane_id(); asm volatile("" : "+v"(F.lane)); F.tid = F.wave * 64 + F.lane; F.wg = blockIdx.x; F.G = gridDim.x; \
    F.out = (float*)arg_ptr<25>(); F.ws = (unsigned char*)arg_ptr<26>(); F.lds = (float*)lds_raw
__device__ __forceinline__ void norm_row_bf16(const float* xrow, const float* g, bf16* orow, int lane) {
    f32x4 v[4]; float s = 0.f;
#pragma unroll
    for (int j = 0; j < 4; ++j) { v[j] = *(const f32x4*)(xrow + j * 256 + lane * 4); s += (v[j][0] * v[j][0] + v[j][1] * v[j][1]) + (v[j][2] * v[j][2] + v[j][3] * v[j][3]); }
    const float r = 1.f / sqrtf(wave_sum(s) * (1.f / D) + EPS);
#pragma unroll
    for (int j = 0; j < 4; ++j) { const f32x4 gg = *(const f32x4*)(g + j * 256 + lane * 4); u32x2 o; o.x = pk2(v[j][0] * r * gg[0], v[j][1] * r * gg[1]); o.y = pk2(v[j][2] * r * gg[2], v[j][3] * r * gg[3]);
        *(u32x2*)(orow + j * 256 + lane * 4) = o; }
}

__device__ __forceinline__ void naive_tile(float (&acc)[8][4], const bf16* A, int lda, const float* B, int ldb, int m0, int n0, int K, float* lds, int tid) {
    float* As = lds;
    float* Bs = lds + 16 * 132;
    const int tx = tid & 31, ty = tid >> 5;
    const int ar = tid >> 2, ak = (tid & 3) * 4;
    const int bk = tid >> 5, bn = (tid & 31) * 4;
    for (int k0 = 0; k0 < K; k0 += 16) {
        const u32x2 av = *(const u32x2*)(A + (size_t)(m0 + ar) * lda + k0 + ak);
        const f32x4 bv = *(const f32x4*)(B + (size_t)(k0 + bk) * ldb + n0 + bn);
        __syncthreads();
        As[(ak + 0) * 132 + ar] = bflo(av.x); As[(ak + 1) * 132 + ar] = bfhi(av.x);
        As[(ak + 2) * 132 + ar] = bflo(av.y); As[(ak + 3) * 132 + ar] = bfhi(av.y);
        *(f32x4*)(Bs + bk * 132 + bn) = bv;
        __syncthreads();
#pragma unroll 4
        for (int k = 0; k < 16; ++k) {
            const f32x4 a0 = *(const f32x4*)(As + k * 132 + ty * 8), a1 = *(const f32x4*)(As + k * 132 + ty * 8 + 4);
            const f32x4 b = *(const f32x4*)(Bs + k * 132 + tx * 4);
            const float a[8] = {a0.x, a0.y, a0.z, a0.w, a1.x, a1.y, a1.z, a1.w};
#pragma unroll
            for (int i = 0; i < 8; ++i) { acc[i][0] += a[i] * b.x; acc[i][1] += a[i] * b.y; acc[i][2] += a[i] * b.z; acc[i][3] += a[i] * b.w; }
        }
    }
}
#define ZERO_ACC(acc) _Pragma("unroll") for (int i_ = 0; i_ < 8; ++i_) _Pragma("unroll") for (int j_ = 0; j_ < 4; ++j_) acc[i_][j_] = 0.f

__device__ __forceinline__ const float* xin(const Frame& F, int layer) { return layer == 0 ? (const float*)arg_ptr<I_X>() : F.out; }

template <bool XF32> __device__ __forceinline__ void norm1_rows(const Frame& F, const void* xsrc, unsigned long long* rstd, bf16* hc) {
    f32x4 v[4][4], vn[4][4];
#define N1_LOAD(t0_, V) do { _Pragma("unroll") for (int r = 0; r < 4; ++r) _Pragma("unroll") for (int j = 0; j < 4; ++j) { const size_t off = (size_t)((t0_) + r) * D + j * 256 + F.lane * 4; \
        if (XF32) V[r][j] = *(const f32x4*)((const float*)xsrc + off); \
        else { const u32x2 w = *(const u32x2*)((const bf16*)xsrc + off); V[r][j] = (f32x4){bflo(w.x), bfhi(w.x), bflo(w.y), bfhi(w.y)}; } } } while (0)
    const int tstep = F.G * NWAVES * 4; int t0 = (F.wg * NWAVES + F.wave) * 4;
    if (t0 < T) N1_LOAD(t0, v);
#pragma unroll 1
    for (; t0 < T; t0 += tstep) {
        const bool has_next = t0 + tstep < T;
        if (has_next) N1_LOAD(t0 + tstep, vn);
#pragma unroll
        for (int r = 0; r < 4; ++r) { float sq = 0.f;
#pragma unroll
            for (int j = 0; j < 4; ++j) sq += (v[r][j][0] * v[r][j][0] + v[r][j][1] * v[r][j][1]) + (v[r][j][2] * v[r][j][2] + v[r][j][3] * v[r][j][3]);
            const float ssum = wave_sum(sq);
            if (F.lane == 0) rstd[t0 + r] = ssq_fix(ssum);
#pragma unroll
            for (int j = 0; j < 4; ++j) { u32x2 o; o.x = pk2(v[r][j][0], v[r][j][1]); o.y = pk2(v[r][j][2], v[r][j][3]);
                *(u32x2*)(hc + (size_t)(t0 + r) * HC + HC_H + j * 256 + F.lane * 4) = o; } }
        if (has_next) {
#pragma unroll
            for (int r = 0; r < 4; ++r)
#pragma unroll
                for (int j = 0; j < 4; ++j) v[r][j] = vn[r][j]; }
    }
#undef N1_LOAD
}
__device__ __forceinline__ void ph_norm1(const Frame& F0, int layer) { PHASE_FRAME(F0);
    unsigned long long* rstd = (unsigned long long*)(F.ws + SM_SSQ);
    bf16* hc = (bf16*)(F.ws + WS_HCAT);
    if (layer == 0) norm1_rows<true>(F, arg_ptr<I_X>(), rstd, hc); else norm1_rows<false>(F, (const void*)F.out, rstd, hc);
}

__device__ __forceinline__ void ph_proj_naive(const Frame& F0, int layer) { PHASE_FRAME(F0);
    const bf16* hc = (const bf16*)(F.ws + WS_HCAT); bf16* proj = (bf16*)(F.ws + WS_PROJ);
    const float* W = (const float*)arg_ptr<I_W_IN>() + (size_t)layer * D * INW;
    const int ntn = INW / 128, ntiles = (T / 128) * ntn;
    for (int it = F.wg; it < ntiles; it += F.G) {
        const int m0 = (it / ntn) * 128, n0 = (it % ntn) * 128;
        float acc[8][4]; ZERO_ACC(acc);
        naive_tile(acc, hc + HC_H, HC, W, INW, m0, n0, D, F.lds, F.tid);
        const int tx = F.tid & 31, ty = F.tid >> 5;
#pragma unroll
        for (int i = 0; i < 8; ++i) { u32x2 o; o.x = pk2(acc[i][0], acc[i][1]); o.y = pk2(acc[i][2], acc[i][3]);
            *(u32x2*)(proj + (size_t)(m0 + ty * 8 + i) * INW + n0 + tx * 4) = o; }
    }
}

__device__ __forceinline__ void ph_rope_naive(const Frame& F0) { PHASE_FRAME(F0);
    bf16* proj = (bf16*)(F.ws + WS_PROJ); const int* pos = (const int*)arg_ptr<I_POS>();
    const int j = F.lane & 31, sub = F.lane >> 5;
    const float inv = exp2f(-(float)j * (13.287712379549449f / 32.0f));
    const long nitems = (long)T * 24 / 2;
    for (long it = (long)F.wg * NWAVES + F.wave; it < nitems; it += (long)F.G * NWAVES) {
        const long th = it * 2 + sub; const int t = (int)(th / 24), hh = (int)(th % 24);
        const int c0 = (hh < 12 ? C_QA : C_KA - 768) + hh * 64;
        bf16* p = proj + (size_t)t * INW + c0;
        const float t1 = bf2f(p[j]), t2 = bf2f(p[j + 32]);
        const float ang = (float)pos[t] * inv;
        double rev = (double)ang * 0.15915494309189535; rev -= floor(rev);
        const float fr = (float)rev;
        const float sn = __builtin_amdgcn_sinf(fr), cs = __builtin_amdgcn_cosf(fr);
        const float sc = hh < 12 ? C2 : 1.0f;
        const float r1 = (t1 * cs - t2 * sn) * sc, r2 = (t2 * cs + t1 * sn) * sc;
        *(unsigned*)(p + 2 * j) = pk2(r1, r2);
    }
    const long nq = (long)T * 512 / 2;
    for (long i = (long)F.wg * NTHREADS + F.tid; i < nq; i += (long)F.G * NTHREADS) {
        const int t = (int)(i / 256), c = (int)(i % 256) * 2;
        unsigned* p = (unsigned*)(proj + (size_t)t * INW + C_QB + c); const unsigned w = *p; *p = pk2(bflo(w) * C2, bfhi(w) * C2);
    }
}

__device__ __forceinline__ void ph_dil_naive(const Frame& F0) { PHASE_FRAME(F0);
    bf16* proj = (bf16*)(F.ws + WS_PROJ); float* lse = (float*)(F.ws + WS_LSE);
    const long n = (long)T * 12;
    for (long i = (long)F.wg * NTHREADS + F.tid; i < n; i += (long)F.G * NTHREADS) {
        const int gj = (int)(i / T), tt = (int)(i % T);
        const int g = gj >> 2, b = tt / SEQ, s = tt % SEQ, d = (g == 0) ? 1 : (g == 1 ? 4 : 16);
        const unsigned* qp = (const unsigned*)(proj + (size_t)tt * INW + C_QA + gj * 64);
        float q[64];
#pragma unroll
        for (int c = 0; c < 32; ++c) { const unsigned w = qp[c]; q[2 * c] = bflo(w); q[2 * c + 1] = bfhi(w); }
        float o[64];
#pragma unroll
        for (int c = 0; c < 64; ++c) o[c] = 0.f;
        float m = -1e30f, l = 0.f;
        for (int mm = 0; mm <= 128; ++mm) {
            const int sp = s - mm * d; if (sp < 0) break;
            const size_t row = (size_t)(b * SEQ + sp) * INW;
            const unsigned* kp = (const unsigned*)(proj + row + C_KA + gj * 64);
            const unsigned* vp = (const unsigned*)(proj + row + C_VA + gj * 64);
            float z = 0.f;
#pragma unroll
            for (int c = 0; c < 32; ++c) { const unsigned w = kp[c]; z += q[2 * c] * bflo(w) + q[2 * c + 1] * bfhi(w); }
            const float mn = fmaxf(m, z), a = exp2f(m - mn), pz = exp2f(z - mn);
            l = l * a + pz; m = mn;
#pragma unroll
            for (int c = 0; c < 32; ++c) { const unsigned w = vp[c]; o[2 * c] = o[2 * c] * a + pz * bflo(w); o[2 * c + 1] = o[2 * c + 1] * a + pz * bfhi(w); }
        }
        const float rl = 1.f / l;
        unsigned* op = (unsigned*)(proj + (size_t)tt * INW + C_QA + gj * 64);
#pragma unroll
        for (int c = 0; c < 32; ++c) op[c] = pk2(o[2 * c] * rl, o[2 * c + 1] * rl);
        lse[(size_t)tt * 12 + gj] = m + log2f(l);
    }
}

__device__ __forceinline__ void ph_sb_naive(const Frame& F0) { PHASE_FRAME(F0);
    const bf16* proj = (const bf16*)(F.ws + WS_PROJ); bf16* hc = (bf16*)(F.ws + WS_HCAT);
    const int nitems = BATCH * 8 * (SEQ / 64);
    for (int it = F.wg * NWAVES + F.wave; it < nitems; it += F.G * NWAVES) {
        const int chunk = (SEQ / 64 - 1) - it / (BATCH * 8), bh = it % (BATCH * 8), b = bh >> 3, h = bh & 7;
        const int t = chunk * 64 + F.lane;
        const unsigned* qp = (const unsigned*)(proj + (size_t)(b * SEQ + t) * INW + C_QB + h * 64);
        float q[64], o[64];
#pragma unroll
        for (int c = 0; c < 32; ++c) { const unsigned w = qp[c]; q[2 * c] = bflo(w); q[2 * c + 1] = bfhi(w); }
#pragma unroll
        for (int c = 0; c < 64; ++c) o[c] = 0.f;
        float carry = 0.f;
        for (int s = chunk * 64 + 62; s >= 0; --s) {
            const size_t row = (size_t)(b * SEQ + s) * INW;
            const unsigned* kp = (const unsigned*)(proj + row + C_KB + h * 64);
            const unsigned* vp = (const unsigned*)(proj + row + C_VB + h * 64);
            float z = 0.f;
#pragma unroll
            for (int c = 0; c < 32; ++c) { const unsigned w = kp[c]; z += q[2 * c] * bflo(w) + q[2 * c + 1] * bfhi(w); }
            const float sp = (z > 30.f) ? z : log2f(1.f + exp2f(z));
            float a = exp2f(z - sp - carry);
            const bool act = s < t;
            a = act ? a : 0.f; carry += act ? sp : 0.f;
#pragma unroll
            for (int c = 0; c < 32; ++c) { const unsigned w = vp[c]; o[2 * c] += a * bflo(w); o[2 * c + 1] += a * bfhi(w); }
        }
        unsigned* op = (unsigned*)(hc + (size_t)(b * SEQ + t) * HC + HC_OB + h * 64);
#pragma unroll
        for (int c = 0; c < 32; ++c) op[c] = pk2(o[2 * c], o[2 * c + 1]);
    }
}

__device__ __forceinline__ void ph_pool_naive(const Frame& F0) { PHASE_FRAME(F0);
    const bf16* proj = (const bf16*)(F.ws + WS_PROJ); bf16* hc = (bf16*)(F.ws + WS_HCAT);
    const long n = (long)T * 512;
    for (long i = (long)F.wg * NTHREADS + F.tid; i < n; i += (long)F.G * NTHREADS) {
        const int t = (int)(i / 512), c = (int)(i % 512), g = c >> 7, w = 2 << g, s = t % SEQ;
        const int cnt = (s + 1 < w) ? s + 1 : w;
        float sum = 0.f;
        for (int k = 0; k < cnt; ++k) sum += bf2f(proj[(size_t)(t - k) * INW + C_UC + c]);
        const float u = bf2f(proj[(size_t)t * INW + C_UC + c]);
        hc[(size_t)t * HC + HC_PL + c] = (bf16)f2bf(sum / (float)cnt - u);
    }
}

__device__ __forceinline__ void ph_comb_naive(const Frame& F0, int layer) { PHASE_FRAME(F0);
    const bf16* proj = (const bf16*)(F.ws + WS_PROJ); bf16* hc = (bf16*)(F.ws + WS_HCAT); const float* lse = (const float*)(F.ws + WS_LSE);
    float l0, l1, l2, n0, n1, n2; u32x4 a, b_, d_, na, nb, nd;
#define COMB_LOAD(i_, L0, L1, L2, A, B, DD) do { const int t = (i_) >> 5, c = ((i_) & 31) * 8, j = c >> 6, s_ = t & (SEQ - 1), bb = t - s_, cl = c & 63; \
        L0 = lse[(size_t)t * 12 + j]; L1 = lse[(size_t)t * 12 + 4 + j]; L2 = lse[(size_t)t * 12 + 8 + j]; \
        A = *(const u32x4*)(proj + PJ_HM(j, t) + cl); B = *(const u32x4*)(proj + PJ_HM(4 + j, bb + (s_ & 3) * (SEQ / 4) + (s_ >> 2)) + cl); DD = *(const u32x4*)(proj + PJ_HM(8 + j, bb + (s_ & 15) * (SEQ / 16) + (s_ >> 4)) + cl); } while (0)
    const int step = F.G * NTHREADS; int i = F.wg * NTHREADS + F.tid;
    if (i < T * 32) COMB_LOAD(i, l0, l1, l2, a, b_, d_);
#pragma unroll 1
    for (; i < T * 32; i += step) {
        const bool has_next = i + step < T * 32;
        if (has_next) COMB_LOAD(i + step, n0, n1, n2, na, nb, nd);
        const int t = i >> 5, c = (i & 31) * 8;
        const float mx = fmaxf(l0, fmaxf(l1, l2)), e0 = exp2f(l0 - mx), e1 = exp2f(l1 - mx), e2 = exp2f(l2 - mx), rs = 1.f / (e0 + e1 + e2);
        u32x4 o;
#pragma unroll
        for (int q = 0; q < 4; ++q) o[q] = pk2((e0 * bflo(a[q]) + e1 * bflo(b_[q]) + e2 * bflo(d_[q])) * rs, (e0 * bfhi(a[q]) + e1 * bfhi(b_[q]) + e2 * bfhi(d_[q])) * rs);
        *(u32x4*)(hc + (size_t)t * HC + HC_OA + c) = o;
        if (has_next) { l0 = n0; l1 = n1; l2 = n2; a = na; b_ = nb; d_ = nd; }
    }
#undef COMB_LOAD
}
__device__ __forceinline__ void ph_ycpre_naive(const Frame& F0, int layer) { PHASE_FRAME(F0);
    bf16* hc = (bf16*)(F.ws + WS_HCAT);
    const float* wp = (const float*)arg_ptr<I_W_POOL>() + (size_t)layer * 4 * 128 * 128; const float* ps = (const float*)arg_ptr<I_POOL_SCALE>() + layer * 512;
    bf16* yc = (bf16*)(F.ws + WS_YCPRE);
    const long n2 = (long)T * 512;
    for (long i = (long)F.wg * NTHREADS + F.tid; i < n2; i += (long)F.G * NTHREADS) {
        const int t = (int)(i / 512), c = (int)(i % 512), g = c >> 7, dd = c & 127;
        const bf16* pl = hc + (size_t)t * HC + HC_PL + g * 128; const float* w = wp + (size_t)g * 128 * 128 + dd;
        float s = 0.f;
        for (int k = 0; k < 128; ++k) s += bf2f(pl[k]) * w[k * 128];
        yc[(size_t)t * 512 + c] = (bf16)f2bf(s * ps[c]);
    }
}

__device__ __forceinline__ void ph_g4_naive(const Frame& F0, int layer) { PHASE_FRAME(F0);
    const bf16* hc = (const bf16*)(F.ws + WS_HCAT); const bf16* yc = (const bf16*)(F.ws + WS_YCPRE); bf16* mg = (bf16*)(F.ws + OV_MERGED);
    const float* wg = (const float*)arg_ptr<I_W_GATE>() + (size_t)layer * D * NGATE; const float* bg = (const float*)arg_ptr<I_B_GATE>() + layer * NGATE;
    const float* wa = (const float*)arg_ptr<I_W_UP_A>() + (size_t)layer * 256 * D; const float* wb = (const float*)arg_ptr<I_W_UP_B>() + (size_t)layer * 512 * D;
    const float* wc = (const float*)arg_ptr<I_W_UP_C>() + (size_t)layer * 512 * D;
    const int ntiles = (T / 128) * 8; const int tx = F.tid & 31, ty = F.tid >> 5;
    for (int it = F.wg; it < ntiles; it += F.G) {
        const int m0 = (it / 8) * 128, n0 = (it % 8) * 128;
        float m[8][4]; ZERO_ACC(m);
#pragma unroll 1
        for (int b = 0; b < 3; ++b) {
            float g[8][4]; ZERO_ACC(g);
            naive_tile(g, hc + HC_H, HC, wg, NGATE, m0, b * 1024 + n0, D, F.lds, F.tid);
            const f32x4 bias = *(const f32x4*)(bg + b * 1024 + n0 + tx * 4);
#pragma unroll
            for (int i = 0; i < 8; ++i) { g[i][0] = sigmoidf_(g[i][0] + bias.x); g[i][1] = sigmoidf_(g[i][1] + bias.y); g[i][2] = sigmoidf_(g[i][2] + bias.z); g[i][3] = sigmoidf_(g[i][3] + bias.w); }
            float acc[8][4]; ZERO_ACC(acc);
            if (b == 0) naive_tile(acc, hc + HC_OA, HC, wa, D, m0, n0, 256, F.lds, F.tid);
            else if (b == 1) naive_tile(acc, hc + HC_OB, HC, wb, D, m0, n0, 512, F.lds, F.tid);
            else naive_tile(acc, yc, 512, wc, D, m0, n0, 512, F.lds, F.tid);
#pragma unroll
            for (int i = 0; i < 8; ++i)
#pragma unroll
                for (int j = 0; j < 4; ++j) m[i][j] += g[i][j] * acc[i][j];
        }
#pragma unroll
        for (int i = 0; i < 8; ++i) { u32x2 o; o.x = pk2(m[i][0], m[i][1]); o.y = pk2(m[i][2], m[i][3]); *(u32x2*)(mg + (size_t)(m0 + ty * 8 + i) * D + n0 + tx * 4) = o; }
    }
}

__device__ __forceinline__ void ph_g5_naive(const Frame& F0, int layer) { PHASE_FRAME(F0);
    const bf16* mg = (const bf16*)(F.ws + OV_MERGED); const float* W = (const float*)arg_ptr<I_W_OUT>() + (size_t)layer * D * D; const float* x = xin(F, layer);
    const int ntiles = (T / 128) * 8; const int tx = F.tid & 31, ty = F.tid >> 5;
    for (int it = F.wg; it < ntiles; it += F.G) {
        const int m0 = (it / 8) * 128, n0 = (it % 8) * 128;
        float acc[8][4]; ZERO_ACC(acc);
        naive_tile(acc, mg, D, W, D, m0, n0, D, F.lds, F.tid);
#pragma unroll
        for (int i = 0; i < 8; ++i) { const size_t off = (size_t)(m0 + ty * 8 + i) * D + n0 + tx * 4; const f32x4 xv = *(const f32x4*)(x + off);
            *(f32x4*)(F.out + off) = (f32x4){xv.x + acc[i][0], xv.y + acc[i][1], xv.z + acc[i][2], xv.w + acc[i][3]}; }
    }
}

__device__ __forceinline__ void ph_route(const Frame& F0, int layer) { PHASE_FRAME(F0);
    const float* g = (const float*)arg_ptr<I_NORM_MOE>() + layer * D;
    const float* wrg = (const float*)arg_ptr<I_W_RG>() + (size_t)layer * D * 4; const float* brg = (const float*)arg_ptr<I_B_RG>() + layer * 4;
    const float* wre = (const float*)arg_ptr<I_W_RE>() + (size_t)layer * 4 * D * 4; const float* bre = (const float*)arg_ptr<I_B_RE>() + layer * 16;
    bf16* hmb = (bf16*)(F.ws + WS_PROJ); int* eid = (int*)(F.ws + SM_EID); float* wgt = (float*)(F.ws + SM_WGT);
    for (int t = F.wg * NWAVES + F.wave; t < T; t += F.G * NWAVES) {
        const float* xr = F.out + (size_t)t * D;
        float s = 0.f;
#pragma unroll
        for (int i = 0; i < 16; ++i) { const float xv = xr[i * 64 + F.lane]; s += xv * xv; }
        const float r = 1.f / sqrtf(wave_sum(s) * (1.f / D) + EPS);
        float lg[4] = {0.f, 0.f, 0.f, 0.f}; float le[16];
#pragma unroll
        for (int e = 0; e < 16; ++e) le[e] = 0.f;
#pragma unroll 2
        for (int i = 0; i < 16; ++i) {
            const int k = i * 64 + F.lane; const float hm = xr[k] * r * g[k];
            hmb[(size_t)t * D + k] = (bf16)f2bf(hm);
            const f32x4 a = *(const f32x4*)(wrg + (size_t)k * 4);
            lg[0] += hm * a.x; lg[1] += hm * a.y; lg[2] += hm * a.z; lg[3] += hm * a.w;
#pragma unroll
            for (int gg = 0; gg < 4; ++gg) { const f32x4 w = *(const f32x4*)(wre + ((size_t)gg * D + k) * 4);
                le[gg * 4 + 0] += hm * w.x; le[gg * 4 + 1] += hm * w.y; le[gg * 4 + 2] += hm * w.z; le[gg * 4 + 3] += hm * w.w; }
        }
#pragma unroll
        for (int e = 0; e < 4; ++e) lg[e] = wave_sum(lg[e]) + brg[e];
#pragma unroll
        for (int e = 0; e < 16; ++e) le[e] = wave_sum(le[e]) + bre[e];
        if (F.lane == 0) {
            int gi = 0; float mx = lg[0];
#pragma unroll
            for (int e = 1; e < 4; ++e) if (lg[e] > mx) { mx = lg[e]; gi = e; }
            float den = 0.f;
#pragma unroll
            for (int e = 0; e < 4; ++e) den += __expf(lg[e] - mx);
            const float p1 = 1.f / den;
            float ls[4];
#pragma unroll
            for (int e = 0; e < 4; ++e) ls[e] = gi == 0 ? le[e] : gi == 1 ? le[4 + e] : gi == 2 ? le[8 + e] : le[12 + e];
            int i0 = 0; float v0 = ls[0];
#pragma unroll
            for (int e = 1; e < 4; ++e) if (ls[e] > v0) { v0 = ls[e]; i0 = e; }
            int i1 = -1; float v1 = -3.0e38f;
#pragma unroll
            for (int e = 0; e < 4; ++e) if (e != i0 && ls[e] > v1) { v1 = ls[e]; i1 = e; }
            const float ex = __expf(v1 - v0), w0 = p1 / (1.f + ex), w1 = p1 * ex / (1.f + ex);
            eid[t * 2 + 0] = gi * 4 + i0; eid[t * 2 + 1] = gi * 4 + i1; wgt[t * 2 + 0] = w0; wgt[t * 2 + 1] = w1;
        }
    }
}

__device__ __forceinline__ void ph_moe_naive(const Frame& F0, int layer) { PHASE_FRAME(F0);
    const bf16* hmb = (const bf16*)(F.ws + WS_PROJ); const int* eid = (const int*)(F.ws + SM_EID); const float* wgt = (const float*)(F.ws + SM_WGT);
    const float* WG = (const float*)arg_ptr<I_W_EG>() + (size_t)layer * NEXP * D * EXP_H; const float* WU = (const float*)arg_ptr<I_W_EU>() + (size_t)layer * NEXP * D * EXP_H;
    const float* WD = (const float*)arg_ptr<I_W_ED>() + (size_t)layer * NEXP * EXP_H * D;
    float* hrow = F.lds; float* hid = F.lds + D;
    for (int t = F.wg; t < T; t += F.G) {
        __syncthreads();
        for (int k = F.tid; k < D; k += NTHREADS) hrow[k] = bf2f(hmb[(size_t)t * D + k]);
        __syncthreads();
        const int slot = F.tid >> 8, f = F.tid & 255, e = eid[t * 2 + slot];
        const float* wg = WG + (size_t)e * D * EXP_H + f; const float* wu = WU + (size_t)e * D * EXP_H + f;
        float a = 0.f, u = 0.f;
#pragma unroll 8
        for (int k = 0; k < D; ++k) { const float h = hrow[k]; a += h * wg[(size_t)k * EXP_H]; u += h * wu[(size_t)k * EXP_H]; }
        const float hv = (a / (1.f + __expf(-a))) * u * wgt[t * 2 + slot];
        hid[slot * 256 + f] = bf2f(f2bf(hv));
        __syncthreads();
        const int e0 = eid[t * 2], e1 = eid[t * 2 + 1];
        const float* d0 = WD + (size_t)e0 * EXP_H * D; const float* d1 = WD + (size_t)e1 * EXP_H * D;
        for (int n = F.tid; n < D; n += NTHREADS) {
            float y = 0.f;
#pragma unroll 8
            for (int ff = 0; ff < 256; ++ff) y += hid[ff] * d0[(size_t)ff * D + n] + hid[256 + ff] * d1[(size_t)ff * D + n];
            F.out[(size_t)t * D + n] += y;
        }
    }
}

__device__ __forceinline__ void ph_e(const Frame& F0, int layer) { PHASE_FRAME(F0);
    const float* g = (const float*)arg_ptr<I_NORM_PLE>() + layer * D; const float* p = (const float*)arg_ptr<I_P>() + (size_t)layer * T * PLE_DIM;
    bf16* hc = (bf16*)(F.ws + WS_HCAT);
    for (int t = F.wg * NWAVES + F.wave; t < T; t += F.G * NWAVES) {
        norm_row_bf16(F.out + (size_t)t * D, g, hc + (size_t)t * HC + HC_H, F.lane);
#pragma unroll
        for (int i = 0; i < 4; ++i) hc[(size_t)t * HC + HC_OA + i * 64 + F.lane] = (bf16)f2bf(p[(size_t)t * PLE_DIM + i * 64 + F.lane]);
    }
}

__device__ __forceinline__ void ph_ple_naive(const Frame& F0, int layer) { PHASE_FRAME(F0);
    const bf16* hc = (const bf16*)(F.ws + WS_HCAT);
    const float* wi = (const float*)arg_ptr<I_W_PLE_IN>() + (size_t)layer * PLE_DIM * D; const float* wg = (const float*)arg_ptr<I_W_PLE_GATE>() + (size_t)layer * D * D;
    const int ntiles = (T / 128) * 8; const int tx = F.tid & 31, ty = F.tid >> 5;
    for (int it = F.wg; it < ntiles; it += F.G) {
        const int m0 = (it / 8) * 128, n0 = (it % 8) * 128;
        float g[8][4]; ZERO_ACC(g);
        naive_tile(g, hc + HC_H, HC, wg, D, m0, n0, D, F.lds, F.tid);
        float acc[8][4]; ZERO_ACC(acc);
        naive_tile(acc, hc + HC_OA, HC, wi, D, m0, n0, PLE_DIM, F.lds, F.tid);
#pragma unroll
        for (int i = 0; i < 8; ++i) { const size_t off = (size_t)(m0 + ty * 8 + i) * D + n0 + tx * 4; f32x4 xv = *(const f32x4*)(F.out + off);
            xv.x += acc[i][0] * sigmoidf_(g[i][0]); xv.y += acc[i][1] * sigmoidf_(g[i][1]); xv.z += acc[i][2] * sigmoidf_(g[i][2]); xv.w += acc[i][3] * sigmoidf_(g[i][3]);
            *(f32x4*)(F.out + off) = xv; }
    }
}

__device__ __forceinline__ void ph_final(const Frame& F0) { PHASE_FRAME(F0);
    const float* g = (const float*)arg_ptr<I_NORM_FINAL>(); const bf16* x3 = (const bf16*)(F.ws + OV_X3);
    u32x2 xw[2][4], xn[2][4];
#define FIN_LOAD(t0_, XW) do { _Pragma("unroll") for (int r = 0; r < 2; ++r) _Pragma("unroll") for (int j = 0; j < 4; ++j) XW[r][j] = *(const u32x2*)(x3 + (size_t)((t0_) + r) * D + j * 256 + F.lane * 4); } while (0)
    const int tstep = F.G * NWAVES * 2; int t0 = (F.wg * NWAVES + F.wave) * 2;
    f32x4 gg[4];
#pragma unroll
    for (int j = 0; j < 4; ++j) gg[j] = *(const f32x4*)(g + j * 256 + F.lane * 4);
    if (t0 < T) FIN_LOAD(t0, xw);
#pragma unroll 1
    for (; t0 < T; t0 += tstep) {
        const bool has_next = t0 + tstep < T;
        if (has_next) FIN_LOAD(t0 + tstep, xn);
#pragma unroll
        for (int r = 0; r < 2; ++r) { float s = 0.f; f32x4 v[4];
#pragma unroll
            for (int j = 0; j < 4; ++j) { v[j] = (f32x4){bflo(xw[r][j].x), bfhi(xw[r][j].x), bflo(xw[r][j].y), bfhi(xw[r][j].y)}; s += (v[j][0] * v[j][0] + v[j][1] * v[j][1]) + (v[j][2] * v[j][2] + v[j][3] * v[j][3]); }
            const float rr = 1.f / sqrtf(wave_sum(s) * (1.f / D) + EPS);
#pragma unroll
            for (int j = 0; j < 4; ++j) *(f32x4*)(F.out + (size_t)(t0 + r) * D + j * 256 + F.lane * 4) = v[j] * rr * gg[j]; }
        if (has_next) {
#pragma unroll
            for (int r = 0; r < 2; ++r)
#pragma unroll
                for (int j = 0; j < 4; ++j) xw[r][j] = xn[r][j]; }
    }
#undef FIN_LOAD
}


#define LAS __attribute__((address_space(3)))
typedef short bf16x8 __attribute__((ext_vector_type(8)));
typedef float f32x2 __attribute__((ext_vector_type(2)));
#define LDS_WAIT() asm volatile("s_waitcnt lgkmcnt(0)" ::: "memory")
#define VM_WAIT() asm volatile("s_waitcnt vmcnt(0)" ::: "memory")
typedef __bf16 bf16x2_t __attribute__((ext_vector_type(2)));
__device__ __forceinline__ unsigned cvt_pk_bf16(float lo, float hi) { f32x2 v = {lo, hi}; bf16x2_t b = __builtin_convertvector(v, bf16x2_t); return __builtin_bit_cast(unsigned, b); }
#define NEG_LOG2E (-1.4426950408889634f)
__device__ __forceinline__ float sigmoid_pre(float v) { return __builtin_amdgcn_rcpf(1.f + __builtin_amdgcn_exp2f(v)); }
__device__ __forceinline__ float fast_sigmoid(float x) { return __builtin_amdgcn_rcpf(1.f + __builtin_amdgcn_exp2f(-1.4426950408889634f * x)); }

constexpr size_t WO_IN = 0;
constexpr size_t WO_BCAT = WO_IN + (size_t)INW * D;
constexpr size_t WO_OUT = WO_BCAT + (size_t)D * 4352;
constexpr size_t WO_M1 = WO_OUT + (size_t)D * D;
constexpr size_t WO_M2 = WO_M1 + (size_t)NEXP * 512 * D;
constexpr size_t WO_PLE = WO_M2 + (size_t)NEXP * D * EXP_H;
constexpr size_t WO_END = WO_PLE + (size_t)D * 1280;
static_assert(WO_END * 2 <= 46 * MiB, "layer weights fit");
constexpr int BCAT_LD = 4352, PLE_LD = 1280;
constexpr int RMAX = 36864;
constexpr size_t OV_HM = WS_PROJ;
constexpr size_t OV_HID = WS_PROJ + 32 * MiB;
constexpr size_t OV_Y2 = WS_PROJ + 50 * MiB;
constexpr size_t OV_ASORT = WS_HCAT;
constexpr size_t OV_GT = WS_PROJ;
constexpr size_t SM_ROWTOK = WS_SMALL + 768 * 1024;
constexpr size_t SM_SLOT2 = WS_SMALL + 256 * 1024, SM_WROW = WS_SMALL + 384 * 1024, SM_TILE = WS_SMALL + 704 * 1024;

__device__ __forceinline__ int xcd_remap(int c, int n) { const int q = n / 8, r = n % 8, x = c % 8, k = c / 8; return (x < r ? x * (q + 1) : r * (q + 1) + (x - r) * q) + k; }
namespace pg8 {
constexpr int BM = 256, BK = 64, HALF = 128, HTB = HALF * BK * 2, STAGE_BYTES = 8 * HTB, NXCD = 8, WGM = 8;
__device__ __forceinline__ int lds_byte(int r, int c) { const int st = (r >> 4) * 2 + (c >> 5), rr = r & 15, cc = c & 31, ob = rr * 64 + cc * 2; return st * 1024 + (ob ^ (((ob >> 9) & 1) << 5)); }
__device__ __forceinline__ void stage_rc(int b, int& R, int& C) { const int st = b / 1024, sb = b % 1024, swz = sb ^ (((sb >> 9) & 1) << 5); R = (st >> 1) * 16 + swz / 64; C = (st & 1) * 32 + (swz % 64) / 2; }
__device__ __forceinline__ int perm32(int rho) { const int n = rho >> 4, i = rho & 15; return 8 * (i >> 2) + 4 * n + (i & 3); }

struct Unit { int pm, pn, ka, kb, nt, kind; };
struct Gemm { const bf16* A; int lda; const bf16* Bt; int ldb; const int* rowmap; };

__device__ __forceinline__ bool tile_order(int nM, int nN, int G, int c, int i, int& pm, int& pn) {
    const int nwg = nM * nN; const long L = (long)i * G + c; if (L >= nwg) return false;
    int wgid = (int)L; { const int q = nwg / NXCD, r = nwg % NXCD, xcd = wgid % NXCD, off = wgid / NXCD; wgid = (xcd < r ? xcd * (q + 1) : r * (q + 1) + (xcd - r) * q) + off; }
    const int nig = WGM * nN, gid = wgid / nig, fm = gid * WGM, gsz = (nM - fm) < WGM ? (nM - fm) : WGM;
    pm = fm + ((wgid % nig) % gsz); pn = (wgid % nig) / gsz; return true;
}

template <class Epi, class Sched, bool ALIGN_EPI, bool GATHER = false>
__device__ __forceinline__ void gemm_phase(LAS unsigned char* lds, const Gemm g, const Sched& S, const Epi& E, int tid) {
    asm volatile("" : "+v"(tid));
    const int wid = __builtin_amdgcn_readfirstlane(tid >> 6), lane = tid & 63, wr = wid >> 2, wc = wid & 3, fr = lane & 15, fq = lane >> 4;
    unsigned voffB[2], cvA[2][2], nvA[2][2]; int Rr[2], Cc[2];
#pragma unroll
    for (int i = 0; i < 2; ++i) { int R, C; stage_rc(tid * 16 + i * 8192, R, C); const int Rb = 2 * (R & ~31) + perm32(R & 31);
        Rr[i] = R; Cc[i] = C; voffB[i] = (unsigned)(Rb * g.ldb + C) * 2u;
#pragma unroll
        for (int h = 0; h < 2; ++h) { cvA[h][i] = (unsigned)((R + h * HALF) * g.lda + C) * 2u; nvA[h][i] = cvA[h][i]; } }
    const size_t kstep = (size_t)(BK * 2);
    const size_t hstepB = (size_t)32 * g.ldb * 2;
#define PG8_GATHER_VOFF(u, v) do { _Pragma("unroll") for (int _h = 0; _h < 2; ++_h) _Pragma("unroll") for (int _i = 0; _i < 2; ++_i) { \
        const int tok_ = g.rowmap[(u).pm * BM + _h * HALF + Rr[_i]]; v[_h][_i] = (unsigned)(tok_ * g.lda + Cc[_i]) * 2u; } \
        asm volatile("" : "+v"(v[0][0]), "+v"(v[0][1]), "+v"(v[1][0]), "+v"(v[1][1])); } while (0)
#define PG8_STAGE_A(bufoff, gbase, h, NX) do { _Pragma("unroll") for (int _i = 0; _i < 2; ++_i) { const unsigned vo_ = (GATHER && (NX)) ? nvA[h][_i] : cvA[h][_i]; \
        __builtin_amdgcn_global_load_lds((const unsigned*)((const char*)(gbase) + vo_), (LAS unsigned*)(lds + (bufoff) + ldsw + _i * 8192), 16, 0, 0); } } while (0)
    const unsigned ldsw = (unsigned)wid * 1024u;
    const int aoff = lds_byte(wr * 64 + fr, fq * 8), boff = lds_byte(wc * 32 + fr, fq * 8);
#define PG8_SA(b, h) (((b) * 2 + (h)) * HTB)
#define PG8_SB(b, h) ((4 + (b) * 2 + (h)) * HTB)
#define PG8_STAGE(bufoff, gbase, voff) do { _Pragma("unroll") for (int _i = 0; _i < 2; ++_i) \
        __builtin_amdgcn_global_load_lds((const unsigned*)((const char*)(gbase) + (voff)[_i]), (LAS unsigned*)(lds + (bufoff) + ldsw + _i * 8192), 16, 0, 0); } while (0)
#define PG8_LDA(dst, b, h) do { _Pragma("unroll") for (int m = 0; m < 4; ++m) _Pragma("unroll") for (int k = 0; k < 2; ++k) dst[m][k] = *(const LAS bf16x8*)(lds + PG8_SA(b, h) + aoff + m * 2048 + k * 1024); } while (0)
#define PG8_LDB(dst, b, h) do { _Pragma("unroll") for (int n = 0; n < 2; ++n) _Pragma("unroll") for (int k = 0; k < 2; ++k) dst[n][k] = *(const LAS bf16x8*)(lds + PG8_SB(b, h) + boff + n * 2048 + k * 1024); } while (0)
#define PG8_MMA(ai, bj, At, Bt) do { __builtin_amdgcn_s_setprio(1); _Pragma("unroll") for (int m = 0; m < 4; ++m) _Pragma("unroll") for (int n = 0; n < 2; ++n) _Pragma("unroll") for (int k = 0; k < 2; ++k) \
        acc[ai][bj][m][n] = __builtin_amdgcn_mfma_f32_16x16x32_bf16(Bt[n][k], At[m][k], acc[ai][bj][m][n], 0, 0, 0); __builtin_amdgcn_s_setprio(0); } while (0)
#define PG8_WAIT_V(n) asm volatile("s_waitcnt vmcnt(" #n ")" ::: "memory")
#define PG8_WAIT_L(n) asm volatile("s_waitcnt lgkmcnt(" #n ")" ::: "memory")
#define PG8_BAR __builtin_amdgcn_s_barrier()
#define PG8_SCHED __builtin_amdgcn_sched_barrier(0)
#define PG8_UA(u) ((const char*)g.A + ((GATHER ? (size_t)0 : (size_t)(u).pm * BM * g.lda) + (u).ka) * 2)
#define PG8_UB(u) ((const char*)g.Bt + ((size_t)(u).pn * BM * g.ldb + (u).kb) * 2)
    Unit cur, nxt; int ui = 0;
    if (!S.next(0, cur)) return;
    f32x4 acc[2][2][4][2];
#pragma unroll
    for (int a = 0; a < 2; ++a)
#pragma unroll
        for (int b = 0; b < 2; ++b)
#pragma unroll
            for (int m = 0; m < 4; ++m)
#pragma unroll
                for (int n = 0; n < 2; ++n) acc[a][b][m][n] = (f32x4){0.f, 0.f, 0.f, 0.f};
    bf16x8 At[4][2], B0[2][2], B1[2][2];
    const char* cA = PG8_UA(cur); const char* cB = PG8_UB(cur);
    if constexpr (GATHER) PG8_GATHER_VOFF(cur, cvA);
    PG8_STAGE(PG8_SB(0, 0), cB, voffB); PG8_STAGE(PG8_SB(0, 1), cB + hstepB, voffB); PG8_STAGE_A(PG8_SA(0, 0), cA, 0, false); PG8_STAGE_A(PG8_SA(0, 1), cA, 1, false);
    if (wr == 1) PG8_BAR;
    PG8_WAIT_V(2); PG8_BAR;
    PG8_STAGE(PG8_SB(1, 0), cB + kstep, voffB); PG8_STAGE_A(PG8_SA(1, 0), cA + kstep, 0, false); PG8_STAGE(PG8_SB(1, 1), cB + hstepB + kstep, voffB);
    PG8_WAIT_V(6); PG8_BAR;
    for (;;) {
        const bool has_next = S.next(ui + 1, nxt);
        const char* nA = has_next ? PG8_UA(nxt) : cA; const char* nB = has_next ? PG8_UB(nxt) : cB;
        if constexpr (GATHER) { if (has_next) PG8_GATHER_VOFF(nxt, nvA); }
        const int nt = cur.nt;
#pragma unroll 1
        for (int t = 0; t < nt; t += 2) {
            const bool last = (t == nt - 2), nx = last && has_next;
            const char* a1 = cA + (size_t)(t + 1) * kstep;
            const char* a2 = last ? nA : cA + (size_t)(t + 2) * kstep; const char* b2 = last ? nB : cB + (size_t)(t + 2) * kstep;
            const char* a3 = a2 + kstep; const char* b3 = b2 + kstep;
            PG8_LDB(B0, 0, 0); PG8_LDB(B1, 0, 1); PG8_SCHED; PG8_LDA(At, 0, 0); PG8_STAGE_A(PG8_SA(1, 1), a1, 1, false);
            PG8_WAIT_V(8); PG8_WAIT_L(0); PG8_BAR; PG8_MMA(0, 0, At, B0); PG8_MMA(0, 1, At, B1); PG8_BAR; PG8_SCHED;
            PG8_LDA(At, 0, 1); PG8_STAGE(PG8_SB(0, 0), b2, voffB); PG8_STAGE(PG8_SB(0, 1), b2 + hstepB, voffB); PG8_STAGE_A(PG8_SA(0, 0), a2, 0, nx);
            PG8_WAIT_V(8); PG8_WAIT_L(0); PG8_BAR; PG8_MMA(1, 0, At, B0); PG8_MMA(1, 1, At, B1); PG8_BAR; PG8_SCHED;
            PG8_LDB(B0, 1, 0); PG8_LDB(B1, 1, 1); PG8_SCHED; PG8_LDA(At, 1, 0); PG8_STAGE_A(PG8_SA(0, 1), a2, 1, nx);
            PG8_WAIT_V(8); PG8_WAIT_L(0); PG8_BAR; PG8_MMA(0, 0, At, B0); PG8_MMA(0, 1, At, B1); PG8_BAR; PG8_SCHED;
            PG8_LDA(At, 1, 1); PG8_STAGE(PG8_SB(1, 0), b3, voffB); PG8_STAGE(PG8_SB(1, 1), b3 + hstepB, voffB); PG8_STAGE_A(PG8_SA(1, 0), a3, 0, nx);
            PG8_WAIT_V(8); PG8_WAIT_L(0); PG8_BAR; PG8_MMA(1, 0, At, B0); PG8_MMA(1, 1, At, B1); PG8_BAR; PG8_SCHED;
        }
        if constexpr (ALIGN_EPI) { if (wr == 0) PG8_BAR; }
        E(acc, cur, wr, wc, fr, fq);
        if (!has_next) break;
#pragma unroll
        for (int a = 0; a < 2; ++a)
#pragma unroll
            for (int b = 0; b < 2; ++b)
#pragma unroll
                for (int m = 0; m < 4; ++m)
#pragma unroll
                    for (int n = 0; n < 2; ++n) acc[a][b][m][n] = (f32x4){0.f, 0.f, 0.f, 0.f};
        cur = nxt; cA = nA; cB = nB; ++ui;
        if constexpr (GATHER) {
#pragma unroll
            for (int h = 0; h < 2; ++h)
#pragma unroll
                for (int i = 0; i < 2; ++i) cvA[h][i] = nvA[h][i]; }
        if constexpr (ALIGN_EPI) { if (wr == 1) PG8_BAR; }
    }
    PG8_WAIT_V(0);
    if constexpr (!ALIGN_EPI) { if (wr == 0) PG8_BAR; }
    PG8_BAR;
#undef PG8_SA
#undef PG8_SB
#undef PG8_STAGE
#undef PG8_STAGE_A
#undef PG8_GATHER_VOFF
#undef PG8_LDA
#undef PG8_LDB
#undef PG8_MMA
#undef PG8_WAIT_V
#undef PG8_WAIT_L
#undef PG8_BAR
#undef PG8_SCHED
#undef PG8_UA
#undef PG8_UB
}
}

typedef f32x4 AccT[2][2][4][2];
#define EPI_ROW(u, ai, m) ((u).pm * 256 + (ai) * 128 + wr * 64 + (m) * 16 + fr)
#define EPI_ROW0(u, ai, m) ((u).pm * 256 + (ai) * 128 + wr * 64 + (m) * 16)
#define EPI_FOR_AM _Pragma("unroll") for (int ai = 0; ai < 2; ++ai) _Pragma("unroll") for (int m = 0; m < 4; ++m)
__device__ __forceinline__ u32x4 pack8(const f32x4 v0, const f32x4 v1) { u32x4 w; w.x = cvt_pk_bf16(v0[0], v0[1]); w.y = cvt_pk_bf16(v0[2], v0[3]); w.z = cvt_pk_bf16(v1[0], v1[1]); w.w = cvt_pk_bf16(v1[2], v1[3]); return w; }
__device__ __forceinline__ void unpack8(const u32x4 w, f32x4& v0, f32x4& v1) { v0 = (f32x4){bflo(w.x), bfhi(w.x), bflo(w.y), bfhi(w.y)}; v1 = (f32x4){bflo(w.z), bfhi(w.z), bflo(w.w), bfhi(w.w)}; }
constexpr int STG_OFF = 133120, STG_PITCH = 144, STG_WAVE = 16 * STG_PITCH;
__device__ __forceinline__ void store_rows16(const u32x4 v0, const u32x4 v1, bf16* g0, size_t pitch, int wid, int lane) {
    LAS unsigned char* stg = (LAS unsigned char*)lds_raw + STG_OFF + wid * STG_WAVE; const int fr = lane & 15, fq = lane >> 4;
    *(LAS u32x4*)(stg + fr * STG_PITCH + fq * 16) = v0; *(LAS u32x4*)(stg + fr * STG_PITCH + 64 + fq * 16) = v1;
#pragma unroll
    for (int k = 0; k < 2; ++k) { const int row = (lane >> 3) + 8 * k; const u32x4 w = *(const LAS u32x4*)(stg + row * STG_PITCH + (lane & 7) * 16); *(u32x4*)(g0 + (size_t)row * pitch + (lane & 7) * 8) = w; }
}

__device__ __forceinline__ void store_rows16_perm(const u32x4 v0, const u32x4 v1, bf16* g0, int ld, int wid, int lane) {
    LAS unsigned char* stg = (LAS unsigned char*)lds_raw + STG_OFF + wid * STG_WAVE; const int fr = lane & 15, fq = lane >> 4;
    *(LAS u32x4*)(stg + fr * STG_PITCH + fq * 16) = v0; *(LAS u32x4*)(stg + fr * STG_PITCH + 64 + fq * 16) = v1;
#pragma unroll
    for (int k = 0; k < 2; ++k) { const int row = (lane >> 3) + 8 * k; const u32x4 w = *(const LAS u32x4*)(stg + row * STG_PITCH + (lane & 7) * 16);
        const int prow = ((row & ((1 << ld) - 1)) << (12 - ld)) + (row >> ld); *(u32x4*)(g0 + (size_t)prow * 64 + (lane & 7) * 8) = w; }
}

struct SchedProj { int G, c;
    __device__ __forceinline__ bool next(int i, pg8::Unit& u) const { int pm, pn; if (!pg8::tile_order(T / 256, INW / 256, G, c, i, pm, pn)) return false; u.pm = pm; u.pn = pn; u.ka = HC_H; u.kb = 0; u.nt = 16; u.kind = pn; return true; } };
struct EpiProj { bf16* proj; const float* rope; const unsigned long long* rstd;
    __device__ __forceinline__ void operator()(const AccT& acc, const pg8::Unit& u, int wr, int wc, int, int) const { const int l_ = lane_id(), fr = l_ & 15, fq = l_ >> 4;
        const int pn = u.pn, wid = wr * 4 + wc; const bool dorope = pn < 6; const float sc = (pn < 3 || pn == 9 || pn == 10) ? C2 : 1.f;
        const float sc_ = sc; float rsv[2][4];
        unsigned long long sq8[2][4];
        EPI_FOR_AM sq8[ai][m] = rstd[EPI_ROW(u, ai, m)];
        EPI_FOR_AM rsv[ai][m] = __builtin_amdgcn_rsqf(ssq_val(sq8[ai][m]) * (1.f / D) + EPS);
        EPI_FOR_AM { const int row = EPI_ROW(u, ai, m); u32x4 pk[2]; const float sc = sc_ * rsv[ai][m];
#pragma unroll
            for (int bj = 0; bj < 2; ++bj) { f32x4 cs0 = (f32x4){1.f, 0.f, 1.f, 0.f}, cs1 = cs0;
                if (dorope) { const f32x4* rp = (const f32x4*)(rope + ((size_t)row * 32 + 16 * bj + 4 * fq) * 2); cs0 = rp[0]; cs1 = rp[1]; }
                const f32x4 a0 = acc[ai][bj][m][0], a1 = acc[ai][bj][m][1]; f32x4 o0, o1;
                o0[0] = (a0[0] * cs0[0] - a0[1] * cs0[1]) * sc; o0[1] = (a0[1] * cs0[0] + a0[0] * cs0[1]) * sc;
                o0[2] = (a0[2] * cs0[2] - a0[3] * cs0[3]) * sc; o0[3] = (a0[3] * cs0[2] + a0[2] * cs0[3]) * sc;
                o1[0] = (a1[0] * cs1[0] - a1[1] * cs1[1]) * sc; o1[1] = (a1[1] * cs1[0] + a1[0] * cs1[1]) * sc;
                o1[2] = (a1[2] * cs1[2] - a1[3] * cs1[3]) * sc; o1[3] = (a1[3] * cs1[2] + a1[2] * cs1[3]) * sc;
                pk[bj] = pack8(o0, o1); }
            const int t0 = EPI_ROW0(u, ai, m);
            if (pn < 15) { const int ld = pn < 9 ? 2 * (pn % 3) : 0, s0 = t0 & (SEQ - 1);
                store_rows16_perm(pk[0], pk[1], proj + PJ_HM(pn * 4 + wc, (t0 - s0) + (s0 >> ld)), ld, wid, l_); }
            else store_rows16(pk[0], pk[1], proj + PJ_UC + (size_t)t0 * 512 + (pn - 15) * 256 + wc * 64, 512, wid, l_); }
    } };

struct SchedG4 { int G, c;
    __device__ __forceinline__ bool next(int i, pg8::Unit& u) const { const int ti = i / 6, sub = i - ti * 6, b = sub >> 1; int pm, pn; if (!pg8::tile_order(T / 256, 4, G, c, ti, pm, pn)) return false;
        u.pm = pm; u.pn = pn; u.kind = sub;
        if (!(sub & 1)) { u.ka = HC_H; u.kb = b * 1024; u.nt = 16; } else { u.ka = b == 0 ? HC_OA : b == 1 ? HC_OB : HC_PL; u.kb = 3072 + (b == 0 ? 0 : b == 1 ? 256 : 768); u.nt = b == 0 ? 4 : 8; }
        return true; } };
struct EpiG4 { bf16* gt; bf16* mg; const float* bias; const unsigned long long* rstd;
    __device__ __forceinline__ void operator()(const AccT& acc, const pg8::Unit& u, int wr, int wc, int, int) const { const int l_ = lane_id(), fr = l_ & 15, fq = l_ >> 4;
        const int b = u.kind >> 1, wid = wr * 4 + wc, colw = u.pn * 256 + wc * 64, colb = colw + 8 * fq;
        if (!(u.kind & 1)) {
            f32x4 bv[2][2];
#pragma unroll
            for (int bj = 0; bj < 2; ++bj) { bv[bj][0] = *(const f32x4*)(bias + b * 1024 + colb + bj * 32) * NEG_LOG2E; bv[bj][1] = *(const f32x4*)(bias + b * 1024 + colb + bj * 32 + 4) * NEG_LOG2E; }
            float rsv[2][4];
            unsigned long long sq8[2][4];
            EPI_FOR_AM sq8[ai][m] = rstd[EPI_ROW(u, ai, m)];
            EPI_FOR_AM rsv[ai][m] = __builtin_amdgcn_rsqf(ssq_val(sq8[ai][m]) * (1.f / D) + EPS);
            EPI_FOR_AM { u32x4 pk[2]; const float rs = rsv[ai][m];
#pragma unroll
                for (int bj = 0; bj < 2; ++bj) { f32x4 v0 = acc[ai][bj][m][0] * rs + bv[bj][0], v1 = acc[ai][bj][m][1] * rs + bv[bj][1];
#pragma unroll
                    for (int e = 0; e < 4; ++e) { v0[e] = sigmoid_pre(v0[e]); v1[e] = sigmoid_pre(v1[e]); }
                    pk[bj] = pack8(v0, v1); }
                store_rows16(pk[0], pk[1], gt + (size_t)EPI_ROW0(u, ai, m) * D + colw, D, wid, l_); }
        } else {
            u32x4 gvb[2][2][2], pvb[2][2][2];
#define G4_LOAD(batch, buf) do { _Pragma("unroll") for (int mm = 0; mm < 2; ++mm) { const size_t off = (size_t)EPI_ROW(u, (batch) >> 1, ((batch) & 1) * 2 + mm) * D + colb; \
                _Pragma("unroll") for (int bj = 0; bj < 2; ++bj) { gvb[buf][mm][bj] = *(const u32x4*)(gt + off + bj * 32); if (b > 0) pvb[buf][mm][bj] = *(const u32x4*)(mg + off + bj * 32); } } } while (0)
            G4_LOAD(0, 0);
#pragma unroll
            for (int batch = 0; batch < 4; ++batch) { const int ai = batch >> 1, buf = batch & 1;
                if (batch < 3) G4_LOAD(batch + 1, (batch + 1) & 1);
#pragma unroll
                for (int mm = 0; mm < 2; ++mm) { const int m = (batch & 1) * 2 + mm; u32x4 pk[2];
#pragma unroll
                    for (int bj = 0; bj < 2; ++bj) { f32x4 g0, g1; unpack8(gvb[buf][mm][bj], g0, g1);
                        f32x4 v0 = acc[ai][bj][m][0] * g0, v1 = acc[ai][bj][m][1] * g1;
                        if (b > 0) { f32x4 p0, p1; unpack8(pvb[buf][mm][bj], p0, p1); v0 += p0; v1 += p1; }
                        pk[bj] = pack8(v0, v1); }
                    store_rows16(pk[0], pk[1], mg + (size_t)EPI_ROW0(u, ai, m) * D + colw, D, wid, l_); }
            }
#undef G4_LOAD
        }
    } };

struct SchedG5 { int G, c;
    __device__ __forceinline__ bool next(int i, pg8::Unit& u) const { int pm, pn; if (!pg8::tile_order(T / 256, 4, G, c, i, pm, pn)) return false; u.pm = pm; u.pn = pn; u.ka = 0; u.kb = 0; u.nt = 16; u.kind = 0; return true; } };
template <bool XF32> struct EpiG5 { const void* x; bf16* xb; int xpitch;
    __device__ __forceinline__ void operator()(const AccT& acc, const pg8::Unit& u, int wr, int wc, int, int) const { const int l_ = lane_id(), fr = l_ & 15, fq = l_ >> 4;
        const int wid = wr * 4 + wc, colw = u.pn * 256 + wc * 64, colb = colw + 8 * fq;
        f32x4 xv[2][2][2][2]; u32x4 xr[2][2][2];
#define G5_LOAD(batch, buf) do { _Pragma("unroll") for (int mm = 0; mm < 2; ++mm) { const size_t off = (size_t)EPI_ROW(u, (batch) >> 1, ((batch) & 1) * 2 + mm) * xpitch + colb; \
            _Pragma("unroll") for (int bj = 0; bj < 2; ++bj) { \
                if (XF32) { xv[buf][mm][bj][0] = *(const f32x4*)((const float*)x + off + bj * 32); xv[buf][mm][bj][1] = *(const f32x4*)((const float*)x + off + bj * 32 + 4); } \
                else xr[buf][mm][bj] = *(const u32x4*)((const bf16*)x + off + bj * 32); } } } while (0)
        G5_LOAD(0, 0);
#pragma unroll
        for (int batch = 0; batch < 4; ++batch) { const int ai = batch >> 1, buf = batch & 1;
            if (batch < 3) G5_LOAD(batch + 1, (batch + 1) & 1);
#pragma unroll
            for (int mm = 0; mm < 2; ++mm) { const int m = (batch & 1) * 2 + mm;
                if (!XF32) { unpack8(xr[buf][mm][0], xv[buf][mm][0][0], xv[buf][mm][0][1]); unpack8(xr[buf][mm][1], xv[buf][mm][1][0], xv[buf][mm][1][1]); }
                store_rows16(pack8(xv[buf][mm][0][0] + acc[ai][0][m][0], xv[buf][mm][0][1] + acc[ai][0][m][1]), pack8(xv[buf][mm][1][0] + acc[ai][1][m][0], xv[buf][mm][1][1] + acc[ai][1][m][1]),
                             xb + (size_t)EPI_ROW0(u, ai, m) * D + colw, D, wid, l_); }
        }
#undef G5_LOAD
    } };

struct SchedPle { int G, c;
    __device__ __forceinline__ bool next(int i, pg8::Unit& u) const { int pm, pn; if (!pg8::tile_order(T / 256, 4, G, c, i, pm, pn)) return false;
        u.pm = pm; u.pn = pn; u.kind = 0; u.ka = 0; u.kb = 0; u.nt = 16; return true; } };
struct EpiPle { const bf16* pin; const bf16* xin_; bf16* xout; int xpitch; const float* rstd; unsigned long long* ssq;
    __device__ __forceinline__ void operator()(const AccT& acc, const pg8::Unit& u, int wr, int wc, int, int) const { const int l_ = lane_id(), fr = l_ & 15, fq = l_ >> 4;
        const int wid = wr * 4 + wc, colw = u.pn * 256 + wc * 64, colb = colw + 8 * fq;
        float rsv[2][4];
        EPI_FOR_AM rsv[ai][m] = rstd[EPI_ROW(u, ai, m)];
        u32x4 pva[2][2], xwa[2][2];
#define PLE_LOAD(g, buf) do { const size_t off = (size_t)EPI_ROW(u, (g) >> 2, (g) & 3) * D + colb; \
            pva[buf][0] = *(const u32x4*)(pin + off); pva[buf][1] = *(const u32x4*)(pin + off + 32); xwa[buf][0] = *(const u32x4*)(xin_ + off); xwa[buf][1] = *(const u32x4*)(xin_ + off + 32); } while (0)
        PLE_LOAD(0, 0);
#pragma unroll
        for (int g = 0; g < 8; ++g) { const int ai = g >> 2, m = g & 3, buf = g & 1; const float rs = rsv[ai][m]; f32x4 r[2][2];
            if (g < 7) PLE_LOAD(g + 1, (g + 1) & 1);
#pragma unroll
            for (int bj = 0; bj < 2; ++bj) { f32x4 g0 = acc[ai][bj][m][0] * rs, g1 = acc[ai][bj][m][1] * rs, p0, p1, x0, x1;
#pragma unroll
                for (int e = 0; e < 4; ++e) { g0[e] = sigmoid_pre(g0[e]); g1[e] = sigmoid_pre(g1[e]); }
                unpack8(pva[buf][bj], p0, p1); unpack8(xwa[buf][bj], x0, x1); r[bj][0] = x0 + p0 * g0; r[bj][1] = x1 + p1 * g1; }
            if (ssq) { const f32x4 q = r[0][0] * r[0][0] + r[0][1] * r[0][1] + r[1][0] * r[1][0] + r[1][1] * r[1][1]; float ps = (q[0] + q[1]) + (q[2] + q[3]); ps += __shfl_xor(ps, 16); ps += __shfl_xor(ps, 32);
                if (l_ < 16) atomicAdd(ssq + EPI_ROW(u, ai, m), ssq_fix(ps)); }
            store_rows16(pack8(r[0][0], r[0][1]), pack8(r[1][0], r[1][1]), xout + (size_t)EPI_ROW0(u, ai, m) * xpitch + colw, xpitch, wid, l_); }
#undef PLE_LOAD
    } };
struct SchedPin { int stride, c2;
    __device__ __forceinline__ bool next(int i, pg8::Unit& u) const { const int ti = c2 + i * stride; if (c2 < 0 || ti >= (T / 256) * 4) return false; u.pm = ti >> 2; u.pn = ti & 3; u.kind = 0; u.ka = 0; u.kb = 1024; u.nt = 4; return true; } };
struct EpiPin { bf16* pin;
    __device__ __forceinline__ void operator()(const AccT& acc, const pg8::Unit& u, int wr, int wc, int, int) const { const int l_ = lane_id();
        const int wid = wr * 4 + wc, colw = u.pn * 256 + wc * 64;
        EPI_FOR_AM store_rows16(pack8(acc[ai][0][m][0], acc[ai][0][m][1]), pack8(acc[ai][1][m][0], acc[ai][1][m][1]), pin + (size_t)EPI_ROW0(u, ai, m) * D + colw, D, wid, l_);
    } };

constexpr int LDS_TILE_OFF = 132096;
struct SchedM1 { int G, c; const LAS int* tile;
    __device__ __forceinline__ bool next(int i, pg8::Unit& u) const { const int nt_ = __builtin_amdgcn_readfirstlane(tile[0]); const int nrem = 2 * nt_ - i * G; if (c >= nrem) return false; const long L = (long)i * G + xcd_remap(c, nrem < G ? nrem : G); const int rt = (int)(L >> 1), hh = (int)(L & 1);
        u.pm = rt; u.pn = __builtin_amdgcn_readfirstlane(tile[1 + rt]) * 2 + hh; u.ka = 0; u.kb = 0; u.nt = 16; u.kind = hh; return true; } };
struct EpiM1 { bf16* hid; const float* wrow;
    __device__ __forceinline__ void operator()(const AccT& acc, const pg8::Unit& u, int wr, int wc, int, int) const { const int l_ = lane_id(), fr = l_ & 15, fq = l_ >> 4;
        const int colb = u.kind * 128 + wc * 32 + 8 * fq;
        f32x2 wv[2][4];
        EPI_FOR_AM wv[ai][m] = *(const f32x2*)(wrow + 2 * (size_t)EPI_ROW(u, ai, m));
        EPI_FOR_AM { const int row = EPI_ROW(u, ai, m); const float w = wv[ai][m][0], rs = wv[ai][m][1]; f32x4 v0, v1;
#pragma unroll
            for (int e = 0; e < 4; ++e) { const float g0 = acc[ai][0][m][0][e] * rs, g1 = acc[ai][0][m][1][e] * rs;
                v0[e] = g0 * fast_sigmoid(g0) * acc[ai][1][m][0][e] * w; v1[e] = g1 * fast_sigmoid(g1) * acc[ai][1][m][1][e] * w; }
            *(u32x4*)(hid + (size_t)row * EXP_H + colb) = pack8(v0, v1); }
    } };
struct SchedM2 { int G, c; const LAS int* tile;
    __device__ __forceinline__ bool next(int i, pg8::Unit& u) const { const int nt_ = __builtin_amdgcn_readfirstlane(tile[0]); const int nrem = 4 * nt_ - i * G; if (c >= nrem) return false; const long L = (long)i * G + xcd_remap(c, nrem < G ? nrem : G); const int rt = (int)(L >> 2), ct = (int)(L & 3);
        u.pm = rt; u.pn = __builtin_amdgcn_readfirstlane(tile[1 + rt]) * 4 + ct; u.ka = 0; u.kb = 0; u.nt = 4; u.kind = ct; return true; } };
struct EpiM2 { bf16* y2;
    __device__ __forceinline__ void operator()(const AccT& acc, const pg8::Unit& u, int wr, int wc, int, int) const { const int l_ = lane_id(), fr = l_ & 15, fq = l_ >> 4;
        const int wid = wr * 4 + wc, colw = u.kind * 256 + wc * 64;
        EPI_FOR_AM store_rows16(pack8(acc[ai][0][m][0], acc[ai][0][m][1]), pack8(acc[ai][1][m][0], acc[ai][1][m][1]), y2 + (size_t)EPI_ROW0(u, ai, m) * D + colw, D, wid, l_);
    } };

struct RmId { __device__ __forceinline__ int operator()(int n) const { return n; } };
struct RmRope { __device__ __forceinline__ int operator()(int n) const { const int hl = n & 63; return n < 1536 ? (n & ~63) + (hl < 32 ? 2 * hl : 2 * (hl - 32) + 1) : n; } };
struct RmGU { int base; __device__ __forceinline__ int operator()(int n) const { const int f = n & 127; return base + (n >> 7) * 256 + 64 * (f >> 5) + (f & 31); } };
template <class RM>
__device__ __forceinline__ void tr_matrix(const float* W, int ldw, int K_, int N_, bf16* dst, int ldt, int kdst0, RM rm, LAS float* scr, int gw, int NGW, int lane, int& base, float wscale = 1.f, const float* kscale = nullptr) {
    const int nb = N_ / 32, cnt = (K_ / 64) * nb;
    f32x4 v[8], vn[8]; float ks[8], ksn[8];
#define TR_LOAD(it_, V, KS) do { const int k0_ = ((it_) / nb) * 64, n0_ = ((it_) % nb) * 32; _Pragma("unroll") for (int j = 0; j < 8; ++j) { \
        V[j] = *(const f32x4*)(W + (size_t)(k0_ + j * 8 + (lane >> 3)) * ldw + n0_ + (lane & 7) * 4); KS[j] = kscale ? kscale[k0_ + j * 8 + (lane >> 3)] : 1.f; } } while (0)
    int it = ((gw - base) % NGW + NGW) % NGW;
    if (it < cnt) TR_LOAD(it, v, ks);
#pragma unroll 1
    for (; it < cnt; it += NGW) {
        const int k0 = (it / nb) * 64, n0 = (it % nb) * 32;
#pragma unroll
        for (int j = 0; j < 8; ++j) { LAS float* d_ = scr + (j * 8 + (lane >> 3)) * 33 + (lane & 7) * 4; const f32x4 w_ = v[j] * (ks[j] * wscale); d_[0] = w_[0]; d_[1] = w_[1]; d_[2] = w_[2]; d_[3] = w_[3]; }
        if (it + NGW < cnt) TR_LOAD(it + NGW, vn, ksn);
        LDS_WAIT(); asm volatile("" ::: "memory");
        const int c = lane & 7;
#pragma unroll
        for (int j = 0; j < 4; ++j) { const int n = (lane >> 3) + 8 * j; const LAS float* s = scr + (8 * c) * 33 + n;
            u32x4 o; o.x = pk2(s[0 * 33], s[1 * 33]); o.y = pk2(s[2 * 33], s[3 * 33]); o.z = pk2(s[4 * 33], s[5 * 33]); o.w = pk2(s[6 * 33], s[7 * 33]);
            *(u32x4*)(dst + (size_t)rm(n0 + n) * ldt + kdst0 + k0 + 8 * c) = o; }
        LDS_WAIT(); asm volatile("" ::: "memory");
#pragma unroll
        for (int j = 0; j < 8; ++j) { v[j] = vn[j]; ks[j] = ksn[j]; }
    }
#undef TR_LOAD
    base += cnt;
}
template <int PART> __device__ __forceinline__ void wconv_part(const Frame& F, int layer, int gw, int NGW) {
    LAS float* scr = (LAS float*)F.lds + F.wave * (64 * 33);
    bf16* W = (bf16*)(F.ws + WS_W); int base = 0;
#define SRC(idx, per_layer) ((const float*)arg_ptr<idx>() + (size_t)layer * (per_layer))
    if (PART == 0) { tr_matrix(SRC(I_W_IN, (size_t)D * INW), INW, D, INW, W + WO_IN, D, 0, RmRope{}, scr, gw, NGW, F.lane, base, 1.f, SRC(I_NORM_MIX, D)); return; }
    if (PART == 1) for (int b = 0; b < 3; ++b) tr_matrix(SRC(I_W_GATE, (size_t)D * NGATE) + b * 1024, NGATE, D, 1024, W + WO_BCAT, BCAT_LD, b * 1024, RmId{}, scr, gw, NGW, F.lane, base, NEG_LOG2E, SRC(I_NORM_MIX, D));
    if (PART == 1) { tr_matrix(SRC(I_W_UP_A, (size_t)256 * D), D, 256, D, W + WO_BCAT, BCAT_LD, 3072, RmId{}, scr, gw, NGW, F.lane, base);
    tr_matrix(SRC(I_W_UP_B, (size_t)512 * D), D, 512, D, W + WO_BCAT, BCAT_LD, 3328, RmId{}, scr, gw, NGW, F.lane, base);
    tr_matrix(SRC(I_W_OUT, (size_t)D * D), D, D, D, W + WO_OUT, D, 0, RmId{}, scr, gw, NGW, F.lane, base);
    tr_matrix(SRC(I_W_PLE_IN, (size_t)PLE_DIM * D), D, PLE_DIM, D, W + WO_PLE, PLE_LD, 1024, RmId{}, scr, gw, NGW, F.lane, base); }
    if (PART == 2) {
        for (int e = 0; e < NEXP; ++e) tr_matrix(SRC(I_W_ED, (size_t)NEXP * EXP_H * D) + (size_t)e * EXP_H * D, D, EXP_H, D, W + WO_M2 + (size_t)e * D * EXP_H, EXP_H, 0, RmId{}, scr, gw, NGW, F.lane, base);
        tr_matrix(SRC(I_W_PLE_GATE, (size_t)D * D), D, D, D, W + WO_PLE, PLE_LD, 0, RmId{}, scr, gw, NGW, F.lane, base, NEG_LOG2E, SRC(I_NORM_PLE, D));
        return;
    }
    for (int e = 0; e < NEXP; ++e) {
        tr_matrix(SRC(I_W_EG, (size_t)NEXP * D * EXP_H) + (size_t)e * D * EXP_H, EXP_H, D, EXP_H, W + WO_M1, D, 0, RmGU{e * 512}, scr, gw, NGW, F.lane, base, 1.f, SRC(I_NORM_MOE, D));
        tr_matrix(SRC(I_W_EU, (size_t)NEXP * D * EXP_H) + (size_t)e * D * EXP_H, EXP_H, D, EXP_H, W + WO_M1, D, 0, RmGU{e * 512 + 32}, scr, gw, NGW, F.lane, base, 1.f, SRC(I_NORM_MOE, D));
    }
    {
        const float* wp = SRC(I_W_POOL, (size_t)4 * 128 * 128); const float* ps = SRC(I_POOL_SCALE, 512); const float* wc = SRC(I_W_UP_C, (size_t)512 * D);
        for (int it = ((gw - base) % NGW + NGW) % NGW; it < 1024; it += NGW) {
            const int kc = it >> 4, n = (it & 15) * 64 + F.lane, g = kc >> 4, kl0 = (kc & 15) * 8;
            const float ps0 = ps[g * 128 + F.lane], ps1 = ps[g * 128 + 64 + F.lane];
            float al[8], ah[8], a[8];
#pragma unroll
            for (int q = 0; q < 8; ++q) { al[q] = wp[(size_t)(g * 128 + kl0 + q) * 128 + F.lane] * ps0; ah[q] = wp[(size_t)(g * 128 + kl0 + q) * 128 + 64 + F.lane] * ps1; a[q] = 0.f; }
            float bv[16], bvn[16];
#pragma unroll
            for (int j = 0; j < 16; ++j) bv[j] = wc[(size_t)(g * 128 + j) * D + n];
#pragma unroll 1
            for (int d0 = 0; d0 < 128; d0 += 16) {
                if (d0 + 16 < 128) {
#pragma unroll
                    for (int j = 0; j < 16; ++j) bvn[j] = wc[(size_t)(g * 128 + d0 + 16 + j) * D + n]; }
#pragma unroll
                for (int j = 0; j < 16; ++j)
#pragma unroll
                    for (int q = 0; q < 8; ++q) { const float av = __builtin_bit_cast(float, __builtin_amdgcn_readlane(__builtin_bit_cast(int, d0 < 64 ? al[q] : ah[q]), (d0 + j) & 63)); a[q] += av * bv[j]; }
#pragma unroll
                for (int j = 0; j < 16; ++j) bv[j] = bvn[j];
            }
            u32x4 o; o.x = pk2(a[0], a[1]); o.y = pk2(a[2], a[3]); o.z = pk2(a[4], a[5]); o.w = pk2(a[6], a[7]);
            *(u32x4*)(W + WO_BCAT + (size_t)n * BCAT_LD + 3840 + kc * 8) = o;
        }
    }
#undef SRC
}
__device__ __forceinline__ void ph_wconv(const Frame& F0, int layer) { PHASE_FRAME(F0);
    wconv_part<0>(F, layer, F.wg * NWAVES + F.wave, F.G * NWAVES);
}
__device__ __forceinline__ void ph_ropetab(const Frame& F0) { PHASE_FRAME(F0);
    float* rope = (float*)(F.ws + WS_ROPE); const int* pos = (const int*)arg_ptr<I_POS>();
    const int step = F.G * NTHREADS, i0 = F.wg * NTHREADS + F.tid;
    for (int ib = i0; ib < T * 32; ib += 4 * step) {
        int pv[4];
#pragma unroll
        for (int k = 0; k < 4; ++k) { const int i = ib + k * step; pv[k] = i < T * 32 ? pos[i >> 5] : 0; }
#pragma unroll
        for (int k = 0; k < 4; ++k) { const int i = ib + k * step; if (i < T * 32) { const int j = i & 31;
            const float inv = exp2f(-(float)j * (13.287712379549449f / 32.0f)); const float ang = (float)pv[k] * inv;
            double rev = (double)ang * 0.15915494309189535; rev -= floor(rev); const float fr = (float)rev;
            *(f32x2*)(rope + (size_t)i * 2) = (f32x2){__builtin_amdgcn_cosf(fr), __builtin_amdgcn_sinf(fr)}; } }
    }
}

__device__ __forceinline__ void ph_proj_fast(const Frame& F0, int layer) { PHASE_FRAME(F0);
    const pg8::Gemm g{(const bf16*)(F.ws + WS_HCAT), HC, (const bf16*)(F.ws + WS_W) + WO_IN, D, nullptr};
    pg8::gemm_phase<EpiProj, SchedProj, true>((LAS unsigned char*)F.lds, g, SchedProj{F.G, F.wg}, EpiProj{(bf16*)(F.ws + WS_PROJ), (const float*)(F.ws + WS_ROPE), (const unsigned long long*)(F.ws + SM_SSQ)}, F.tid);
    constexpr int NBUSY = (T / 256) * (INW / 256) - 4 * 256;
    if (F.G == 256 && F.wg >= NBUSY) wconv_part<1>(F, layer, (F.wg - NBUSY) * NWAVES + F.wave, (F.G - NBUSY) * NWAVES);
    else if (F.G != 256) wconv_part<1>(F, layer, F.wg * NWAVES + F.wave, F.G * NWAVES);
}
__device__ __forceinline__ void ph_g4_fast(const Frame& F0, int layer) { PHASE_FRAME(F0);
    const pg8::Gemm g{(const bf16*)(F.ws + WS_HCAT), HC, (const bf16*)(F.ws + WS_W) + WO_BCAT, BCAT_LD, nullptr};
    pg8::gemm_phase<EpiG4, SchedG4, true>((LAS unsigned char*)F.lds, g, SchedG4{F.G, F.wg}, EpiG4{(bf16*)(F.ws + OV_GT), (bf16*)(F.ws + OV_MERGED), (const float*)arg_ptr<I_B_GATE>() + layer * NGATE, (const unsigned long long*)(F.ws + SM_SSQ)}, F.tid);
}
__device__ __forceinline__ void ph_g5_fast(const Frame& F0, int layer) { PHASE_FRAME(F0);
    const pg8::Gemm g{(const bf16*)(F.ws + OV_MERGED), D, (const bf16*)(F.ws + WS_W) + WO_OUT, D, nullptr};
    if (layer == 0) pg8::gemm_phase<EpiG5<true>, SchedG5, true>((LAS unsigned char*)F.lds, g, SchedG5{F.G, F.wg}, EpiG5<true>{arg_ptr<I_X>(), (bf16*)F.out, D}, F.tid);
    else pg8::gemm_phase<EpiG5<false>, SchedG5, true>((LAS unsigned char*)F.lds, g, SchedG5{F.G, F.wg}, EpiG5<false>{(const void*)((const bf16*)(F.ws + WS_HCAT) + HC_H), (bf16*)F.out, HC}, F.tid);
}
__device__ __forceinline__ void ph_ple_fast(const Frame& F0, int layer) { PHASE_FRAME(F0);
    const pg8::Gemm g{(const bf16*)F.out, D, (const bf16*)(F.ws + WS_W) + WO_PLE, PLE_LD, nullptr};
    const bool last = layer == DEPTH - 1;
    pg8::gemm_phase<EpiPle, SchedPle, true>((LAS unsigned char*)F.lds, g, SchedPle{F.G, F.wg}, EpiPle{(const bf16*)(F.ws + OV_GT), (const bf16*)F.out, last ? (bf16*)(F.ws + OV_X3) : (bf16*)(F.ws + WS_HCAT) + HC_H, last ? D : HC,
        (const float*)(F.ws + SM_RSTD_PLE), last ? nullptr : (unsigned long long*)(F.ws + SM_SSQ)}, F.tid);
}
__device__ __forceinline__ void ph_m1_fast(const Frame& F0, int layer) { PHASE_FRAME(F0);
    const pg8::Gemm g{(const bf16*)F.out, D, (const bf16*)(F.ws + WS_W) + WO_M1, D, (const int*)(F.ws + SM_ROWTOK)};
    { const int* tg = (const int*)(F.ws + SM_TILE); LAS int* tl = (LAS int*)((LAS unsigned char*)F.lds + LDS_TILE_OFF); if (F.tid < 161) tl[F.tid] = tg[F.tid]; __syncthreads(); }
    pg8::gemm_phase<EpiM1, SchedM1, true, true>((LAS unsigned char*)F.lds, g, SchedM1{F.G, F.wg, (const LAS int*)((LAS unsigned char*)F.lds + LDS_TILE_OFF)}, EpiM1{(bf16*)(F.ws + OV_HID), (const float*)(F.ws + SM_WROW)}, F.tid);
    {   const pg8::Gemm gp{(const bf16*)F.out + (size_t)T * D, D, (const bf16*)(F.ws + WS_W) + WO_PLE, PLE_LD, nullptr};
        const bool std_ = F.G == 256;
        if (!std_ || F.wg >= 32) pg8::gemm_phase<EpiPin, SchedPin, true>((LAS unsigned char*)F.lds, gp, SchedPin{std_ ? F.G - 32 : F.G, std_ ? F.wg - 32 : F.wg}, EpiPin{(bf16*)(F.ws + OV_GT)}, F.tid); }
    if (F.G == 256 && F.wg >= 64) { wconv_part<2>(F, layer, (F.wg - 64) * NWAVES + F.wave, (F.G - 64) * NWAVES); if (layer + 1 < DEPTH) wconv_part<0>(F, layer + 1, (F.wg - 64) * NWAVES + F.wave, (F.G - 64) * NWAVES); }
    else if (F.G != 256) { wconv_part<2>(F, layer, F.wg * NWAVES + F.wave, F.G * NWAVES); if (layer + 1 < DEPTH) wconv_part<0>(F, layer + 1, F.wg * NWAVES + F.wave, F.G * NWAVES); }
}
__device__ __forceinline__ void ph_m2_fast(const Frame& F0) { PHASE_FRAME(F0);
    const pg8::Gemm g{(const bf16*)(F.ws + OV_HID), EXP_H, (const bf16*)(F.ws + WS_W) + WO_M2, EXP_H, nullptr};
    { const int* tg = (const int*)(F.ws + SM_TILE); LAS int* tl = (LAS int*)((LAS unsigned char*)F.lds + LDS_TILE_OFF); if (F.tid < 161) tl[F.tid] = tg[F.tid]; __syncthreads(); }
    pg8::gemm_phase<EpiM2, SchedM2, true>((LAS unsigned char*)F.lds, g, SchedM2{F.G, F.wg, (const LAS int*)((LAS unsigned char*)F.lds + LDS_TILE_OFF)}, EpiM2{(bf16*)(F.ws + OV_Y2)}, F.tid);
}

constexpr size_t SM_CHUNK = WS_SMALL + 720 * 1024;
__device__ __forceinline__ int wave_sum_i(int v) {
#pragma unroll
    for (int o = 1; o < 64; o <<= 1) v += __shfl_xor(v, o);
    return v;
}
__device__ __forceinline__ void ph_route2(const Frame& F0, int layer) { PHASE_FRAME(F0);
    const float* g = (const float*)arg_ptr<I_NORM_MOE>() + layer * D;
    const float* wrg = (const float*)arg_ptr<I_W_RG>() + (size_t)layer * D * 4; const float* brg = (const float*)arg_ptr<I_B_RG>() + layer * 4;
    const float* wre = (const float*)arg_ptr<I_W_RE>() + (size_t)layer * 4 * D * 4; const float* bre = (const float*)arg_ptr<I_B_RE>() + layer * 16;
    bf16* hmb = (bf16*)(F.ws + OV_HM); int* eid = (int*)(F.ws + SM_EID); float* wgt = (float*)(F.ws + SM_WGT); int* chunk = (int*)(F.ws + SM_CHUNK);
    {
        const float* p = (const float*)arg_ptr<I_P>() + (size_t)layer * T * PLE_DIM; bf16* pob = (bf16*)F.out + (size_t)T * D; f32x4 pv8[8];
#pragma unroll
        for (int q = 0; q < 8; ++q) pv8[q] = *(const f32x4*)(p + (size_t)(F.wg * 64 + F.wave * 8 + q) * PLE_DIM + F.lane * 4);
#pragma unroll
        for (int q = 0; q < 8; ++q) { u32x2 po; po.x = pk2(pv8[q][0], pv8[q][1]); po.y = pk2(pv8[q][2], pv8[q][3]); *(u32x2*)(pob + (size_t)(F.wg * 64 + F.wave * 8 + q) * D + F.lane * 4) = po; } }
    LAS float* Wl = (LAS float*)F.lds;
    LAS int* cnt = (LAS int*)(F.lds + 5 * 1024 * 4);
    const int tw0 = F.wg * 64 + F.wave * 8;
    unsigned xw[4][8]; f32x2 gk[8];
#pragma unroll
    for (int i = 0; i < 8; ++i) {
#pragma unroll
        for (int q = 0; q < 4; ++q) xw[q][i] = *(const unsigned*)((const bf16*)F.out + (size_t)(tw0 + q) * D + i * 128 + 2 * F.lane);
        gk[i] = *(const f32x2*)(g + i * 128 + 2 * F.lane); }
    for (int i = F.tid; i < 1024; i += NTHREADS) { *(LAS f32x4*)(Wl + (size_t)i * 4) = *(const f32x4*)(wrg + (size_t)i * 4);
#pragma unroll
        for (int gg = 0; gg < 4; ++gg) *(LAS f32x4*)(Wl + ((size_t)(1 + gg) * 1024 + i) * 4) = *(const f32x4*)(wre + ((size_t)gg * D + i) * 4); }
    if (F.tid < 16) cnt[F.tid] = 0;
    __syncthreads();
#pragma unroll 1
    for (int pass = 0; pass < 2; ++pass) {
        const int tk = tw0 + pass * 4;
        float a20[20];
#pragma unroll
        for (int i = 0; i < 20; ++i) a20[i] = 0.f;
#pragma unroll
        for (int i = 0; i < 8; ++i) { const int k = i * 128 + 2 * F.lane;
            const f32x4 w0 = *(const LAS f32x4*)(Wl + (size_t)k * 4), w1 = *(const LAS f32x4*)(Wl + (size_t)(k + 1) * 4);
#pragma unroll
            for (int q = 0; q < 4; ++q) { const float x0 = bflo(xw[q][i]), x1 = bfhi(xw[q][i]); a20[q * 5] += x0 * x0 + x1 * x1; const float y0 = x0 * gk[i][0], y1 = x1 * gk[i][1];
#pragma unroll
                for (int e = 0; e < 4; ++e) a20[q * 5 + 1 + e] += y0 * w0[e] + y1 * w1[e]; } }
        float u5[5];
        {   float w10[10];
#pragma unroll
            for (int i = 0; i < 10; ++i) { const float lo = a20[i], hi_ = a20[10 + i]; const bool up = (F.lane & 32) != 0; const float keep = up ? hi_ : lo, send = up ? lo : hi_; w10[i] = keep + __shfl_xor(send, 32); }
#pragma unroll
            for (int i = 0; i < 5; ++i) { const bool up = (F.lane & 16) != 0; const float keep = up ? w10[i + 5] : w10[i], send = up ? w10[i] : w10[i + 5]; u5[i] = keep + __shfl_xor(send, 16); } }
#pragma unroll
        for (int i = 0; i < 5; ++i) { float v = u5[i]; v += __shfl_xor(v, 8); v += __shfl_xor(v, 4); v += __shfl_xor(v, 2); v += __shfl_xor(v, 1); u5[i] = v; }
        const float rsq = 1.f / sqrtf(u5[0] * (1.f / D) + EPS);
        float lg[4];
#pragma unroll
        for (int e = 0; e < 4; ++e) lg[e] = u5[1 + e] * rsq + brg[e];
        int gi = 0; float mx = lg[0];
#pragma unroll
        for (int e = 1; e < 4; ++e) if (lg[e] > mx) { mx = lg[e]; gi = e; }
        float den = 0.f;
#pragma unroll
        for (int e = 0; e < 4; ++e) den += __expf(lg[e] - mx);
        const float p1 = 1.f / den;
        float rs[4]; int gq[4];
#pragma unroll
        for (int q = 0; q < 4; ++q) { rs[q] = __builtin_bit_cast(float, __builtin_amdgcn_readlane(__builtin_bit_cast(int, rsq), q * 16)); gq[q] = __builtin_amdgcn_readlane(gi, q * 16); }
        float a16[16];
#pragma unroll
        for (int i = 0; i < 16; ++i) a16[i] = 0.f;
#pragma unroll
        for (int i = 0; i < 8; ++i) { const int k = i * 128 + 2 * F.lane;
#pragma unroll
            for (int q = 0; q < 4; ++q) { const LAS float* wq = Wl + ((size_t)(1 + gq[q]) * 1024 + k) * 4; const f32x4 w0 = *(const LAS f32x4*)wq, w1 = *(const LAS f32x4*)(wq + 4);
                const float y0 = bflo(xw[q][i]) * gk[i][0], y1 = bfhi(xw[q][i]) * gk[i][1];
#pragma unroll
                for (int e = 0; e < 4; ++e) a16[q * 4 + e] += y0 * w0[e] + y1 * w1[e]; } }
        float u4[4];
        {   float w8[8];
#pragma unroll
            for (int i = 0; i < 8; ++i) { const float lo = a16[i], hi_ = a16[8 + i]; const bool up = (F.lane & 32) != 0; const float keep = up ? hi_ : lo, send = up ? lo : hi_; w8[i] = keep + __shfl_xor(send, 32); }
#pragma unroll
            for (int i = 0; i < 4; ++i) { const bool up = (F.lane & 16) != 0; const float keep = up ? w8[i + 4] : w8[i], send = up ? w8[i] : w8[i + 4]; u4[i] = keep + __shfl_xor(send, 16); } }
#pragma unroll
        for (int i = 0; i < 4; ++i) { float v = u4[i]; v += __shfl_xor(v, 8); v += __shfl_xor(v, 4); v += __shfl_xor(v, 2); v += __shfl_xor(v, 1); u4[i] = v; }
        if ((F.lane & 15) == 0) {
            const int q = F.lane >> 4;
            float ls[4];
#pragma unroll
            for (int e = 0; e < 4; ++e) ls[e] = u4[e] * rsq + bre[gi * 4 + e];
            int i0 = 0; float v0 = ls[0];
#pragma unroll
            for (int e = 1; e < 4; ++e) if (ls[e] > v0) { v0 = ls[e]; i0 = e; }
            int i1 = -1; float v1 = -3.0e38f;
#pragma unroll
            for (int e = 0; e < 4; ++e) if (e != i0 && ls[e] > v1) { v1 = ls[e]; i1 = e; }
            const float ex = __expf(v1 - v0), w0_ = p1 / (1.f + ex), w1_ = p1 * ex / (1.f + ex);
            const int t = tk + q, ea = gi * 4 + i0, eb = gi * 4 + i1;
            eid[t * 2 + 0] = ea; eid[t * 2 + 1] = eb; wgt[t * 2 + 0] = w0_; wgt[t * 2 + 1] = w1_; ((float*)(F.ws + SM_RSTD_MOE))[t] = rsq;
            __hip_atomic_fetch_add(&cnt[ea], 1, __ATOMIC_RELAXED, __HIP_MEMORY_SCOPE_WORKGROUP); __hip_atomic_fetch_add(&cnt[eb], 1, __ATOMIC_RELAXED, __HIP_MEMORY_SCOPE_WORKGROUP);
        }
        if (pass == 0) {
#pragma unroll
            for (int i = 0; i < 8; ++i)
#pragma unroll
                for (int q = 0; q < 4; ++q) xw[q][i] = *(const unsigned*)((const bf16*)F.out + (size_t)(tw0 + 4 + q) * D + i * 128 + 2 * F.lane); }
    }
    __syncthreads();
    if (F.tid < 16) chunk[F.wg * 16 + F.tid] = cnt[F.tid];
}
__device__ __forceinline__ void ph_scatter2(const Frame& F0) { PHASE_FRAME(F0);
    const int* eid = (const int*)(F.ws + SM_EID); const float* wgt = (const float*)(F.ws + SM_WGT); const int* chunk = (const int*)(F.ws + SM_CHUNK);
    int* rowtok = (int*)(F.ws + SM_ROWTOK); float* wrow = (float*)(F.ws + SM_WROW); int* tile = (int*)(F.ws + SM_TILE);
    LAS int* L = (LAS int*)F.lds;
    const int t0 = F.wg * 64;
    int e0 = 0, e1 = 0; float wg0 = 0.f, wg1 = 0.f, r0 = 0.f, r1 = 0.f;
    if (F.wave == 0) { const float* rstd = (const float*)(F.ws + SM_RSTD_MOE); e0 = eid[t0 * 2 + F.lane]; e1 = eid[t0 * 2 + 64 + F.lane]; wg0 = wgt[t0 * 2 + F.lane]; wg1 = wgt[t0 * 2 + 64 + F.lane]; r0 = rstd[t0 + (F.lane >> 1)]; r1 = rstd[t0 + 32 + (F.lane >> 1)]; }
#pragma unroll
    for (int ee = 0; ee < 2; ++ee) { const int e = 2 * F.wave + ee; int ts = 0, ps = 0;
        for (int ch = F.lane; ch < F.G; ch += 64) { const int v = chunk[ch * 16 + e]; ts += v; ps += (ch < F.wg) ? v : 0; }
        ts = wave_sum_i(ts); ps = wave_sum_i(ps);
        if (F.lane == 0) { L[e] = ts; L[16 + e] = ps; } }
    __syncthreads();
    if (F.tid == 0) { int b = 0;
        for (int e = 0; e < NEXP; ++e) { L[32 + e] = b; const int ntl = (L[e] + 255) >> 8; if (F.wg == 0) for (int q = 0; q < ntl; ++q) tile[1 + (b >> 8) + q] = e; b += ntl << 8; }
        if (F.wg == 0) tile[0] = b >> 8; }
    __syncthreads();
    if (F.wave == 0) {
        int p0 = 0, p1 = 0;
        const unsigned long long below = (1ull << F.lane) - 1ull;
#pragma unroll
        for (int e = 0; e < NEXP; ++e) { const unsigned long long b0 = __ballot(e0 == e), b1 = __ballot(e1 == e);
            if (e0 == e) p0 = __popcll(b0 & below); if (e1 == e) p1 = __popcll(b0) + __popcll(b1 & below); }
        const int s0 = L[32 + e0] + L[16 + e0] + p0, s1 = L[32 + e1] + L[16 + e1] + p1;
        L[64 + F.lane] = s0; L[128 + F.lane] = s1;
        ((int*)(F.ws + SM_SLOT2))[t0 * 2 + F.lane] = s0; ((int*)(F.ws + SM_SLOT2))[t0 * 2 + 64 + F.lane] = s1;
        rowtok[s0] = t0 + (F.lane >> 1); *(f32x2*)(wrow + 2 * (size_t)s0) = (f32x2){wg0 * r0, r0}; rowtok[s1] = t0 + 32 + (F.lane >> 1); *(f32x2*)(wrow + 2 * (size_t)s1) = (f32x2){wg1 * r1, r1};
    }
    __syncthreads();
    for (int e = F.wg; e < NEXP; e += F.G) { const int b = L[32 + e], n = L[e], np = ((n + 255) >> 8) << 8; for (int s = n + F.tid; s < np; s += NTHREADS) { rowtok[b + s] = 0; *(f32x2*)(wrow + 2 * (size_t)(b + s)) = (f32x2){0.f, 0.f}; } }
}
__device__ __forceinline__ void ph_e_fast(const Frame& F0, int layer) { PHASE_FRAME(F0);
    const bf16* y2 = (const bf16*)(F.ws + OV_Y2); const int* slot2 = (const int*)(F.ws + SM_SLOT2);
    u32x2 xw[2][4], ya[2][4], yb[2][4], xwn[2][4], yan[2][4], ybn[2][4];
#define E_LOAD(t0_, XW, YA, YB) do { _Pragma("unroll") for (int r = 0; r < 2; ++r) { const size_t t = (size_t)(t0_) + r; \
        const size_t sa = (size_t)__builtin_amdgcn_readfirstlane(slot2[t * 2]), sb = (size_t)__builtin_amdgcn_readfirstlane(slot2[t * 2 + 1]); \
        _Pragma("unroll") for (int j = 0; j < 4; ++j) { const int k = j * 256 + F.lane * 4; XW[r][j] = *(const u32x2*)((const bf16*)F.out + t * D + k); YA[r][j] = *(const u32x2*)(y2 + sa * D + k); YB[r][j] = *(const u32x2*)(y2 + sb * D + k); } } } while (0)
    const int tstep = F.G * NWAVES * 2; int t0 = (F.wg * NWAVES + F.wave) * 2;
    if (t0 < T) E_LOAD(t0, xw, ya, yb);
#pragma unroll 1
    for (; t0 < T; t0 += tstep) {
        const bool has_next = t0 + tstep < T;
        if (has_next) E_LOAD(t0 + tstep, xwn, yan, ybn);
#pragma unroll
        for (int r = 0; r < 2; ++r) { const size_t t = t0 + r; float s = 0.f; f32x4 xv[4];
#pragma unroll
            for (int j = 0; j < 4; ++j) { f32x4 v = (f32x4){bflo(xw[r][j].x), bfhi(xw[r][j].x), bflo(xw[r][j].y), bfhi(xw[r][j].y)};
                v[0] += bflo(ya[r][j].x) + bflo(yb[r][j].x); v[1] += bfhi(ya[r][j].x) + bfhi(yb[r][j].x); v[2] += bflo(ya[r][j].y) + bflo(yb[r][j].y); v[3] += bfhi(ya[r][j].y) + bfhi(yb[r][j].y);
                xv[j] = v; s += (v[0] * v[0] + v[1] * v[1]) + (v[2] * v[2] + v[3] * v[3]); u32x2 xo; xo.x = pk2(v[0], v[1]); xo.y = pk2(v[2], v[3]); *(u32x2*)((bf16*)F.out + t * D + j * 256 + F.lane * 4) = xo; }
            const float rr = 1.f / sqrtf(wave_sum(s) * (1.f / D) + EPS);
            if (F.lane == 0) { ((float*)(F.ws + SM_RSTD_PLE))[t] = rr;
                if (layer + 1 < DEPTH) ((unsigned long long*)(F.ws + SM_SSQ))[t] = 0ull; }
        }
        if (has_next) {
#pragma unroll
            for (int r = 0; r < 2; ++r) {
#pragma unroll
                for (int j = 0; j < 4; ++j) { xw[r][j] = xwn[r][j]; ya[r][j] = yan[r][j]; yb[r][j] = ybn[r][j]; } } }
    }
#undef E_LOAD
}


typedef float f32x16 __attribute__((ext_vector_type(16)));
typedef short s16x4 __attribute__((ext_vector_type(4)));
#define MFMA32(a, b, c) __builtin_amdgcn_mfma_f32_32x32x16_bf16((a), (b), (c), 0, 0, 0)
constexpr int AT_K = 0, AT_V = 49152, AT_OST = 98304, AT_FLAG = 131072;
constexpr float NEG_BIG = -1.0e30f;
#ifndef SB_EARLY_EXIT
#define SB_EARLY_EXIT 1
#endif
constexpr float SB_EXIT_THR = 160.0f;

__device__ __forceinline__ int crow(int r, int hi) { return (r & 3) + 8 * (r >> 2) + 4 * hi; }
template <int S> __device__ __forceinline__ bf16x8 pack_step(const f32x16& x) {
    u32x4 p; p.x = cvt_pk_bf16(x[8 * S], x[8 * S + 1]); p.y = cvt_pk_bf16(x[8 * S + 2], x[8 * S + 3]); p.z = cvt_pk_bf16(x[8 * S + 4], x[8 * S + 5]); p.w = cvt_pk_bf16(x[8 * S + 6], x[8 * S + 7]);
    return __builtin_bit_cast(bf16x8, p); }
__device__ __forceinline__ void glds16(const void* gsrc, LAS unsigned char* dst) { __builtin_amdgcn_global_load_lds((const unsigned*)gsrc, (LAS unsigned*)dst, 16, 0, 0); }
typedef short v4i16_t __attribute__((ext_vector_type(4)));
__device__ __forceinline__ s16x4 vtr(const LAS unsigned char* p) { return __builtin_bit_cast(s16x4, __builtin_amdgcn_ds_read_tr16_b64_v4i16((LAS v4i16_t*)p)); }
#define AT_WAITBAR() asm volatile("s_waitcnt vmcnt(0) lgkmcnt(0)\n\ts_barrier" ::: "memory")

__device__ __forceinline__ void at_qkt(f32x16& p0, f32x16& p1, const LAS unsigned char* kt, const bf16x8 (&qr)[4], int r32, int hi) {
    const LAS unsigned char* kb = kt + r32 * 128; const int x = r32 & 7;
    const f32x16 zero = {0.f, 0.f, 0.f, 0.f, 0.f, 0.f, 0.f, 0.f, 0.f, 0.f, 0.f, 0.f, 0.f, 0.f, 0.f, 0.f};
#pragma unroll
    for (int d0 = 0; d0 < 4; ++d0) { const int off = ((2 * d0 + hi) ^ x) * 16; const bf16x8 b0 = *(const LAS bf16x8*)(kb + off), b1 = *(const LAS bf16x8*)(kb + 4096 + off);
        p0 = MFMA32(b0, qr[d0], d0 == 0 ? zero : p0); p1 = MFMA32(b1, qr[d0], d0 == 0 ? zero : p1); }
}
__device__ __forceinline__ void at_pv(f32x16& o0, f32x16& o1, const LAS unsigned char* vt, int lane, int hi, bf16x8 pa0, bf16x8 pa1, bf16x8 pa2, bf16x8 pa3) {
    const LAS unsigned char* vp = vt + ((lane >> 4) & 1) * 32 + (lane & 3) * 8 + (4 * hi + ((lane & 15) >> 2)) * 64;
#define AT_VF(off) ({ const s16x4 lo_ = vtr(vp + (off)), hi_ = vtr(vp + (off) + 512); (bf16x8){lo_[0], lo_[1], lo_[2], lo_[3], hi_[0], hi_[1], hi_[2], hi_[3]}; })
    o0 = MFMA32(pa0, AT_VF(0), o0);    o0 = MFMA32(pa1, AT_VF(1024), o0); o0 = MFMA32(pa2, AT_VF(2048), o0); o0 = MFMA32(pa3, AT_VF(3072), o0);
    o1 = MFMA32(pa0, AT_VF(4096), o1); o1 = MFMA32(pa1, AT_VF(5120), o1); o1 = MFMA32(pa2, AT_VF(6144), o1); o1 = MFMA32(pa3, AT_VF(7168), o1);
#undef AT_VF
}
template <class RowPtr>
__device__ __forceinline__ void at_store_o(const f32x16& o0, const f32x16& o1, const float (&sc)[16], LAS unsigned char* lds, int wid, int lane, RowPtr rowptr) {
    const int r32 = lane & 31, hi = lane >> 5; LAS bf16* stg = (LAS bf16*)(lds + AT_OST + wid * 4096);
#pragma unroll
    for (int r = 0; r < 16; ++r) { const int orow = crow(r, hi); const unsigned pk = cvt_pk_bf16(o0[r] * sc[r], o1[r] * sc[r]); stg[orow * 64 + r32] = (bf16)(pk & 0xffffu); stg[orow * 64 + 32 + r32] = (bf16)(pk >> 16); }
    LDS_WAIT();
#pragma unroll
    for (int i = 0; i < 4; ++i) { const int row = i * 8 + (lane >> 3), ch = lane & 7; const u32x4 v = *(const LAS u32x4*)(stg + row * 64 + ch * 8); *(u32x4*)(rowptr(row) + ch * 8) = v; }
}

struct SbRow { bf16* base; __device__ __forceinline__ bf16* operator()(int row) const { return base + (size_t)row * HC; } };
__device__ __forceinline__ void sb_unit(const Frame& F, int b, int h, int qb, const bf16* proj, bf16* hc) {
    LAS unsigned char* lds = (LAS unsigned char*)lds_raw;
    const int lane = F.lane, r32 = lane & 31, hi = lane >> 5, wid = F.wave;
    const size_t rowbase = (size_t)b * SEQ; const int q0 = qb * 256;
    const bf16* Qw = proj + PJ_HM(36 + h, rowbase + q0 + wid * 32);
    const bf16* ksrc = proj + PJ_HM(44 + h, rowbase + 8 * wid + (lane >> 3)) + (((lane & 7) ^ ((lane >> 3) & 7)) * 8);
    const bf16* vsrc = proj + PJ_HM(52 + h, rowbase + 16 * (wid & 3) + (lane >> 2)) + (wid >> 2) * 32 + (lane & 3) * 8;
#define SB_DMA(t, slot) do { glds16(ksrc + (size_t)(t) * 64 * 64, lds + AT_K + (slot) * 8192 + wid * 1024); glds16(vsrc + (size_t)(t) * 64 * 64, lds + AT_V + (slot) * 8192 + wid * 1024); } while (0)
    bf16x8 qr[4];
#pragma unroll
    for (int d0 = 0; d0 < 4; ++d0) qr[d0] = *(const bf16x8*)(Qw + (size_t)r32 * 64 + d0 * 16 + hi * 8);
    bf16x8 tri0, tri1, ones;
#pragma unroll
    for (int j = 0; j < 8; ++j) { const int k0 = 8 * (j >> 2) + 4 * hi + (j & 3); tri0[j] = (k0 >= r32) ? (short)0x3F80 : (short)0; tri1[j] = (16 + k0 >= r32) ? (short)0x3F80 : (short)0; ones[j] = (short)0x3F80; }
    const int NT = 4 * (qb + 1), jd = 4 * qb + (wid >> 1), qpos = q0 + wid * 32 + r32;
    f32x16 o0, o1;
#pragma unroll
    for (int r = 0; r < 16; ++r) { o0[r] = 0.f; o1[r] = 0.f; }
    float carry = 0.f;
    SB_DMA(NT - 1, 0); AT_WAITBAR();
    int cur = 0; bool wdone = false;
    for (int t = NT - 1; t >= 0; --t) {
        if (t > 0) SB_DMA(t - 1, cur ^ 1);
        if (t <= jd && !wdone) {
            f32x16 z0, z1;
            at_qkt(z0, z1, lds + AT_K + cur * 8192, qr, r32, hi);
            if (t == jd) { const int kb_ = 64 * t + 4 * hi;
#pragma unroll
                for (int r = 0; r < 16; ++r) { const int kv = kb_ + (r & 3) + 8 * (r >> 2); if (kv >= qpos) z0[r] = NEG_BIG; if (kv + 32 >= qpos) z1[r] = NEG_BIG; } }
            f32x16 s0, s1;
#pragma unroll
            for (int r = 0; r < 16; ++r) { z0[r] = __builtin_amdgcn_fmed3f(z0[r], 126.f, -3.0e38f); z1[r] = __builtin_amdgcn_fmed3f(z1[r], 126.f, -3.0e38f);
                s0[r] = __builtin_amdgcn_logf(1.f + __builtin_amdgcn_exp2f(z0[r])); s1[r] = __builtin_amdgcn_logf(1.f + __builtin_amdgcn_exp2f(z1[r])); }
            const bf16x8 x0a = pack_step<0>(s0), x0b = pack_step<1>(s0), x1a = pack_step<0>(s1), x1b = pack_step<1>(s1);
            f32x16 T1, y1, y0;
#pragma unroll
            for (int r = 0; r < 16; ++r) { T1[r] = carry; y1[r] = carry - z1[r]; }
            T1 = MFMA32(ones, x1a, T1); T1 = MFMA32(ones, x1b, T1);
            y1 = MFMA32(tri0, x1a, y1); y1 = MFMA32(tri1, x1b, y1);
#pragma unroll
            for (int r = 0; r < 16; ++r) y0[r] = T1[r] - z0[r];
            y0 = MFMA32(tri0, x0a, y0); y0 = MFMA32(tri1, x0b, y0);
            T1 = MFMA32(ones, x0a, T1); T1 = MFMA32(ones, x0b, T1); carry = T1[0];
#pragma unroll
            for (int r = 0; r < 16; ++r) { y0[r] = __builtin_amdgcn_exp2f(-y0[r]); y1[r] = __builtin_amdgcn_exp2f(-y1[r]); }
            at_pv(o0, o1, lds + AT_V + cur * 8192, lane, hi, pack_step<0>(y0), pack_step<1>(y0), pack_step<0>(y1), pack_step<1>(y1));
        }
        if (SB_EARLY_EXIT) { wdone = __all(carry > SB_EXIT_THR) != 0; if (lane == 0) ((LAS int*)(lds + AT_FLAG))[(t & 1) * 8 + wid] = wdone ? 1 : 0; }
        AT_WAITBAR();
        if (SB_EARLY_EXIT) { const LAS int* fl = (const LAS int*)(lds + AT_FLAG) + (t & 1) * 8; const int all = fl[0] & fl[1] & fl[2] & fl[3] & fl[4] & fl[5] & fl[6] & fl[7];
            if (__builtin_amdgcn_readfirstlane(all)) break; }
        cur ^= 1;
    }
#undef SB_DMA
    float one[16];
#pragma unroll
    for (int r = 0; r < 16; ++r) one[r] = 1.f;
    at_store_o(o0, o1, one, lds, wid, lane, SbRow{hc + (rowbase + q0 + wid * 32) * HC + HC_OB + h * 64});
    AT_WAITBAR();
}
__device__ __forceinline__ void ph_sb_fast(const Frame& F0) { PHASE_FRAME(F0);
    const bf16* proj = (const bf16*)(F.ws + WS_PROJ); bf16* hc = (bf16*)(F.ws + WS_HCAT);
    for (int idx0 = F.wg; idx0 < 256; idx0 += F.G) { const int idx = F.G == 256 ? xcd_remap(idx0, 256) : idx0, bh = idx >> 3, s = idx & 7;
        sb_unit(F, bh >> 3, bh & 7, 15 - s, proj, hc); sb_unit(F, bh >> 3, bh & 7, s, proj, hc); }
}

struct DilRow { bf16* base; size_t stride; __device__ __forceinline__ bf16* operator()(int row) const { return base + (size_t)row * stride; } };
struct DilUnit { int b, gj, res, blk, d, l0; size_t rowbase, prow; };
__device__ __forceinline__ DilUnit dil_decode(int u) { DilUnit U; const int x = u & 15, bgj = u >> 4; U.gj = bgj % 12; U.b = bgj / 12; const int g = U.gj >> 2;
    U.res = g == 0 ? 0 : (g == 1 ? (x >> 2) : x); U.blk = g == 0 ? x : (g == 1 ? (x & 3) : 0); U.d = (g == 0) ? 1 : (g == 1 ? 4 : 16); U.l0 = U.blk * 256; U.rowbase = (size_t)U.b * SEQ; U.prow = U.rowbase + (size_t)U.res * (SEQ / U.d); return U; }
__device__ __forceinline__ void dil_issue_k(const DilUnit& U, const bf16* proj, LAS unsigned char* lds, int wid, int lane) {
#pragma unroll 1
    for (int tile = 0; tile < 6; ++tile) { int lk = U.l0 - 128 + tile * 64 + 8 * wid + (lane >> 3); lk = lk < 0 ? 0 : lk;
        glds16(proj + PJ_HM(12 + U.gj, U.prow + lk) + (((lane & 7) ^ ((lane >> 3) & 7)) * 8), lds + AT_K + tile * 8192 + wid * 1024); } }
__device__ __forceinline__ void dil_issue_v(const DilUnit& U, const bf16* proj, LAS unsigned char* lds, int wid, int lane) {
#pragma unroll 1
    for (int tile = 0; tile < 6; ++tile) { int lv = U.l0 - 128 + tile * 64 + 16 * (wid & 3) + (lane >> 2); lv = lv < 0 ? 0 : lv;
        glds16(proj + PJ_HM(24 + U.gj, U.prow + lv) + (wid >> 2) * 32 + (lane & 3) * 8, lds + AT_V + tile * 8192 + wid * 1024); } }
__device__ __forceinline__ void dil_load_q(const DilUnit& U, const bf16* proj, bf16x8 (&q)[4], int wid, int r32, int hi) {
    const bf16* qp = proj + PJ_HM(U.gj, U.prow + U.l0 + 32 * wid + r32);
#pragma unroll
    for (int d0 = 0; d0 < 4; ++d0) q[d0] = *(const bf16x8*)(qp + d0 * 16 + hi * 8); }
#define AT_BAR() asm volatile("s_waitcnt lgkmcnt(0)\n\ts_barrier" ::: "memory")
__device__ __forceinline__ void ph_dil_fast(const Frame& F0) { PHASE_FRAME(F0);
    bf16* proj = (bf16*)(F.ws + WS_PROJ); float* lse = (float*)(F.ws + WS_LSE);
    LAS unsigned char* lds = (LAS unsigned char*)lds_raw;
    const int lane = F.lane, r32 = lane & 31, hi = lane >> 5, wid = F.wave;
    const int NU = BATCH * 12 * 16;
    if (F.wg >= NU) return;
    const int c_ = F.G == 256 ? xcd_remap(F.wg, 256) : F.wg;
    DilUnit U = dil_decode(c_);
    bf16x8 qr[4], qn[4];
    dil_load_q(U, proj, qr, wid, r32, hi);
    asm volatile("s_waitcnt vmcnt(0)" : "+v"(qr[0]), "+v"(qr[1]), "+v"(qr[2]), "+v"(qr[3]) :: "memory");
    dil_issue_k(U, proj, lds, wid, lane); dil_issue_v(U, proj, lds, wid, lane);
#pragma unroll 1
    for (int u = c_; u < NU; u += F.G) {
        const bool has_next = u + F.G < NU; DilUnit UN = U;
        asm volatile("s_waitcnt vmcnt(6)" ::: "memory"); AT_BAR();
        if (has_next) { UN = dil_decode(u + F.G); dil_load_q(UN, proj, qn, wid, r32, hi); }
        const int l0 = U.l0, qloc = 32 * wid + r32, tb = wid >> 1, kmin = (128 - l0) > qloc ? (128 - l0) : qloc, kmax = qloc + 128;
        f32x16 za[3], zb[3]; float m = NEG_BIG;
#pragma unroll
        for (int ti = 0; ti < 3; ++ti) {
            at_qkt(za[ti], zb[ti], lds + AT_K + (tb + ti) * 8192, qr, r32, hi);
            const int thr_lo = kmin - 64 * (tb + ti) - 4 * hi, thr_hi = kmax - 64 * (tb + ti) - 4 * hi;
            if (ti == 0 || l0 == 0) {
#pragma unroll
                for (int r = 0; r < 16; ++r) { const int C = (r & 3) + 8 * (r >> 2); za[ti][r] = (C >= thr_lo) ? za[ti][r] : NEG_BIG; zb[ti][r] = (C + 32 >= thr_lo) ? zb[ti][r] : NEG_BIG; } }
            if (ti == 2) {
#pragma unroll
                for (int r = 0; r < 16; ++r) { const int C = (r & 3) + 8 * (r >> 2); za[ti][r] = (C <= thr_hi) ? za[ti][r] : NEG_BIG; zb[ti][r] = (C + 32 <= thr_hi) ? zb[ti][r] : NEG_BIG; } }
#pragma unroll
            for (int r = 0; r < 16; r += 2) m = fmaxf(fmaxf(m, fmaxf(za[ti][r], zb[ti][r])), fmaxf(za[ti][r + 1], zb[ti][r + 1]));
        }
        AT_BAR();
        asm volatile("s_waitcnt vmcnt(0)" : "+v"(qn[0]), "+v"(qn[1]), "+v"(qn[2]), "+v"(qn[3]) :: "memory");
        if (has_next) dil_issue_k(UN, proj, lds, wid, lane);
        m = fmaxf(m, __shfl_xor(m, 32));
        float l = 0.f;
#pragma unroll
        for (int ti = 0; ti < 3; ++ti)
#pragma unroll
            for (int r = 0; r < 16; ++r) { za[ti][r] = __builtin_amdgcn_exp2f(za[ti][r] - m); zb[ti][r] = __builtin_amdgcn_exp2f(zb[ti][r] - m); l += za[ti][r] + zb[ti][r]; }
        l += __shfl_xor(l, 32);
        AT_BAR();
        f32x16 o0, o1;
#pragma unroll
        for (int r = 0; r < 16; ++r) { o0[r] = 0.f; o1[r] = 0.f; }
#pragma unroll
        for (int ti = 0; ti < 3; ++ti) at_pv(o0, o1, lds + AT_V + (tb + ti) * 8192, lane, hi, pack_step<0>(za[ti]), pack_step<1>(za[ti]), pack_step<0>(zb[ti]), pack_step<1>(zb[ti]));
        AT_BAR();
        const size_t qrow = U.rowbase + (size_t)(l0 + qloc) * U.d + U.res;
        LAS float* lsc = (LAS float*)(lds + AT_OST + wid * 4096);
        if (hi == 0) { lsc[r32] = 1.f / l; lse[qrow * 12 + U.gj] = m + __builtin_amdgcn_logf(l); }
        LDS_WAIT();
        float sc[16];
#pragma unroll
        for (int r = 0; r < 16; ++r) sc[r] = lsc[crow(r, hi)];
        LDS_WAIT();
        at_store_o(o0, o1, sc, lds, wid, lane, DilRow{proj + PJ_HM(U.gj, U.prow + l0 + 32 * wid), (size_t)64});
        if (has_next) { dil_issue_v(UN, proj, lds, wid, lane);
#pragma unroll
            for (int d0 = 0; d0 < 4; ++d0) qr[d0] = qn[d0]; U = UN; }
    }
    AT_WAITBAR();
}
template <int W> __device__ __forceinline__ void pool_item(const bf16* uc, bf16* hc, int t0, int s0, int c) {
    unsigned uv[32 + W - 1];
#pragma unroll
    for (int k = 0; k < 32 + W - 1; ++k) { const int dt = k - (W - 1); uv[k] = (s0 + dt >= 0) ? *(const unsigned*)(uc + (size_t)(t0 + dt) * 512 + c) : 0u; }
    float sa = 0.f, sb = 0.f;
#pragma unroll
    for (int k = 0; k < W - 1; ++k) { sa += bflo(uv[k]); sb += bfhi(uv[k]); }
#pragma unroll
    for (int tt = 0; tt < 32; ++tt) { const int s = s0 + tt; const unsigned u = uv[tt + W - 1]; const float ua = bflo(u), ub = bfhi(u);
        sa += ua; sb += ub;
        const float rc = 1.f / (float)((s + 1 < W) ? s + 1 : W);
        *(unsigned*)(hc + (size_t)(t0 + tt) * HC + HC_PL + c) = pk2(sa * rc - ua, sb * rc - ub);
        sa -= bflo(uv[tt]); sb -= bfhi(uv[tt]); }
}
__device__ __forceinline__ void ph_pool_fast(const Frame& F0) { PHASE_FRAME(F0);
    const bf16* uc = (const bf16*)(F.ws + WS_PROJ) + PJ_UC; bf16* hc = (bf16*)(F.ws + WS_HCAT);
    for (int i = F.wg * NTHREADS + F.tid; i < (T / 32) * 256; i += F.G * NTHREADS) {
        const int cp = i & 255, chunk = i >> 8, c = cp * 2, g = __builtin_amdgcn_readfirstlane(c >> 7), t0 = chunk * 32, s0 = t0 % SEQ;
        if (g == 0) pool_item<2>(uc, hc, t0, s0, c); else if (g == 1) pool_item<4>(uc, hc, t0, s0, c); else if (g == 2) pool_item<8>(uc, hc, t0, s0, c); else pool_item<16>(uc, hc, t0, s0, c);
    }
}

typedef __attribute__((address_space(1))) unsigned gu32;
#define RLX_AGENT __ATOMIC_RELAXED, __HIP_MEMORY_SCOPE_AGENT
#define XB_TMO      128
#define XB_XCNT(j)  (256  + 64 * (j))
#define XB_XSUB(j)  (1280 + 64 * (j))
#define XB_XGEN(j)  (2304 + 64 * (j))
#define XB_TOP      3328
#define XB_TOPGEN   3392
#define XCD_BAR_WORDS 3456
#define XB_SPIN_CAP (1u << 18)
__device__ __forceinline__ unsigned xb_ld(unsigned* p)              { return __hip_atomic_load(p, __ATOMIC_RELAXED, __HIP_MEMORY_SCOPE_AGENT); }
__device__ __forceinline__ unsigned xb_add(unsigned* p, unsigned v) { return __hip_atomic_fetch_add(p, v, __ATOMIC_RELAXED, __HIP_MEMORY_SCOPE_AGENT); }
__device__ __forceinline__ unsigned xb_xcc_id() { return (unsigned)__builtin_amdgcn_s_getreg((3 << 11) | 20) & 0xFu; }
#define XB_SPIN(cond, bar) do { unsigned _sp = 0; while (cond) { __builtin_amdgcn_s_sleep(1); \
    if ((++_sp & 255u) == 0u) { if (xb_ld(&(bar)[XB_TMO])) break; if (_sp > XB_SPIN_CAP) { atomicAdd(&(bar)[XB_TMO], 1u); break; } } } } while (0)
struct XcdBarrier { unsigned* bar; unsigned x; volatile LAS unsigned* st; };
__device__ __forceinline__ XcdBarrier xcd_barrier_post(unsigned* bar, volatile LAS unsigned* st, bool t0) {
    XcdBarrier b; b.bar = bar; b.x = xb_xcc_id(); b.st = st;
    if (t0) (void)xb_add(&bar[XB_XCNT(b.x)], 1u);
    return b;
}
__device__ __forceinline__ void xcd_barrier_complete(unsigned* bar, unsigned x, unsigned& nloc, unsigned& nx) {
    const unsigned G = gridDim.x * gridDim.y * gridDim.z;
    unsigned sum, cnt, mine, sp = 0u;
    for (;;) {
        sum = 0u; cnt = 0u; mine = 0u;
#pragma unroll
        for (unsigned j = 0; j < 16; ++j) { const unsigned c = xb_ld(&bar[XB_XCNT(j)]); sum += c; cnt += (c > 0u) ? 1u : 0u; mine = (j == x) ? c : mine; }
        if (sum == G) break;
        __builtin_amdgcn_s_sleep(1);
        if ((++sp & 255u) == 0u) { if (xb_ld(&bar[XB_TMO])) break; if (sp > XB_SPIN_CAP) { atomicAdd(&bar[XB_TMO], 1u); break; } }
    }
    nloc = mine > 0u ? mine : 1u; nx = cnt > 0u ? cnt : 1u;
}
__device__ __forceinline__ void xcd_barrier(const XcdBarrier& b, bool t0) {
    asm volatile("s_waitcnt vmcnt(0)" ::: "memory");
    __syncthreads();
    if (t0) {
        unsigned* bar = b.bar;
        __builtin_amdgcn_s_waitcnt(0);
        unsigned nloc = b.st[0], nx = b.st[1];
        if (nloc == 0u) { xcd_barrier_complete(bar, b.x, nloc, nx); b.st[0] = nloc; b.st[1] = nx; }
        const unsigned old = xb_add(&bar[XB_XSUB(b.x)], 1u);
        const unsigned gen = old / nloc;
        if (old + 1u == (gen + 1u) * nloc) {
            __builtin_amdgcn_fence(__ATOMIC_RELEASE, "agent");
            asm volatile("s_waitcnt vmcnt(0)" ::: "memory");
            const unsigned og = xb_add(&bar[XB_TOP], 1u);
            const unsigned tg = og / nx;
            if (og + 1u == (tg + 1u) * nx) xb_add(&bar[XB_TOPGEN], 1u);
            else XB_SPIN(xb_ld(&bar[XB_TOPGEN]) == tg, bar);
            __builtin_amdgcn_fence(__ATOMIC_ACQUIRE, "agent");
            xb_add(&bar[XB_XGEN(b.x)], 1u);
            asm volatile("s_waitcnt vmcnt(0)" ::: "memory");
        } else {
            XB_SPIN(xb_ld(&bar[XB_XGEN(b.x)]) == gen, bar);
            __builtin_amdgcn_fence(__ATOMIC_ACQUIRE, "agent");
            asm volatile("s_waitcnt vmcnt(0)" ::: "memory");
        }
    }
    __syncthreads();
}

#define USE_FAST_DIL 1
#define USE_FAST_SB 1
#define USE_FAST_POOL 1
constexpr int LDS_BYTES = 163840, MISC_OFF = 131072 + 320;
constexpr int CW_BAR = 4096;

__global__ void __launch_bounds__(NTHREADS, 2) mega(Args args) {
    Frame F{}; F.wave = __builtin_amdgcn_readfirstlane((int)threadIdx.x >> 6);
    volatile LAS unsigned* MISC = (volatile LAS unsigned*)((LAS unsigned char*)lds_raw + MISC_OFF);
    if (threadIdx.x < 32) MISC[threadIdx.x] = 0u;
    __syncthreads();
    (void)xcd_barrier_post((unsigned*)((unsigned char*)arg_ptr<26>() + WS_CTL) + CW_BAR, MISC + 8, threadIdx.x == 0);
#define GRID_BAR() do { XcdBarrier b_; b_.bar = (unsigned*)((unsigned char*)arg_ptr<26>() + WS_CTL) + CW_BAR; b_.x = xb_xcc_id(); b_.st = MISC + 8; xcd_barrier(b_, F.wave == 0 && lane_id() == 0); } while (0)
#define LAYER_PROGRAM(layer) do { \
        if (layer == 0) { ph_wconv(F, layer); ph_norm1(F, layer); ph_ropetab(F); \
        GRID_BAR(); } \
        ph_proj_fast(F, layer); \
        GRID_BAR(); \
        if (USE_FAST_DIL) ph_dil_fast(F); else ph_dil_naive(F); if (USE_FAST_SB) ph_sb_fast(F); else ph_sb_naive(F); if (USE_FAST_POOL) ph_pool_fast(F); else ph_pool_naive(F); \
        GRID_BAR(); \
        ph_comb_naive(F, layer); \
        GRID_BAR(); \
        ph_g4_fast(F, layer); \
        GRID_BAR(); \
        ph_g5_fast(F, layer); \
        GRID_BAR(); \
        ph_route2(F, layer); \
        GRID_BAR(); \
        ph_scatter2(F); \
        GRID_BAR(); \
        ph_m1_fast(F, layer); \
        GRID_BAR(); \
        ph_m2_fast(F); \
        GRID_BAR(); \
        ph_e_fast(F, layer); \
        GRID_BAR(); \
        ph_ple_fast(F, layer); \
        GRID_BAR(); \
     \
    } while (0)
    LAYER_PROGRAM(0);
    LAYER_PROGRAM(1);
    ph_final(F);
}

extern "C" void kernel_launch(void* const* d_in, const int* in_sizes, int n_in, void* d_out, int out_size, void* d_ws, size_t ws_size, hipStream_t stream) {
    static int grid = 0;
    if (grid == 0) {
        if (n_in != N_IN || out_size != T * D || ws_size < WS_END) { fprintf(stderr, "kernel_launch: unexpected shapes n_in %d out %d ws %zu\n", n_in, out_size, ws_size); grid = -1; return; }
        int dev = 0, cus = 0, per_cu = 0;
        (void)hipGetDevice(&dev); (void)hipDeviceGetAttribute(&cus, hipDeviceAttributeMultiprocessorCount, dev);
        if (hipFuncSetAttribute((const void*)mega, hipFuncAttributeMaxDynamicSharedMemorySize, LDS_BYTES) != hipSuccess) { fprintf(stderr, "kernel_launch: hipFuncSetAttribute failed\n"); grid = -1; return; }
        if (hipOccupancyMaxActiveBlocksPerMultiprocessor(&per_cu, (const void*)mega, NTHREADS, LDS_BYTES) != hipSuccess || per_cu < 1) { fprintf(stderr, "kernel_launch: occupancy query says %d blocks per CU\n", per_cu); grid = -1; return; }
        (void)hipGetLastError();
        if (cus < 256) { fprintf(stderr, "kernel_launch: needs >= 256 CUs\n"); grid = -1; return; }
        grid = 256;
    }
    if (grid < 0) return;
    (void)hipMemsetAsync((char*)d_ws + WS_CTL, 0, 32 * 1024, stream);
    Args a{};
    for (int i = 0; i < N_IN; ++i) a.in[i] = d_in[i];
    a.out = (float*)d_out; a.ws = (unsigned char*)d_ws;
    void* kargs[] = {&a};
    hipError_t e = hipLaunchCooperativeKernel((const void*)mega, dim3(grid), dim3(NTHREADS), kargs, LDS_BYTES, stream);
    if (e != hipSuccess) fprintf(stderr, "kernel_launch: cooperative launch failed: %s (grid %d)\n", hipGetErrorString(e), grid);
}
```

```cpp
#include <hip/hip_runtime.h>
#include <cstdio>
#include <cstdint>

constexpr int BATCH = 4, SEQ = 4096, T = BATCH * SEQ, D = 1024, DEPTH = 2;
constexpr int INW = 4352, C_QA = 0, C_KA = 768, C_VA = 1536, C_QB = 2304, C_KB = 2816, C_VB = 3328, C_UC = 3840;
#define PJ_HM(ch, row) (((size_t)(ch) * T + (size_t)(row)) * 64)
constexpr size_t PJ_UC = (size_t)60 * 16384 * 64;
constexpr int HC = 2304, HC_H = 0, HC_OA = 1024, HC_OB = 1280, HC_PL = 1792;
constexpr int NGATE = 3072, PLE_DIM = 256, EXP_H = 256, NEXP = 16;
constexpr float EPS = 1e-6f;
constexpr float C2 = 0.125f * 1.4426950408889634f;
constexpr int NTHREADS = 512, NWAVES = 8;

enum { I_X = 0, I_P, I_POS, I_NORM_MIX, I_W_IN, I_W_GATE, I_B_GATE, I_W_POOL, I_POOL_SCALE, I_W_UP_A, I_W_UP_B, I_W_UP_C, I_W_OUT, I_NORM_MOE,
       I_W_RG, I_B_RG, I_W_RE, I_B_RE, I_W_EG, I_W_EU, I_W_ED, I_NORM_PLE, I_W_PLE_IN, I_W_PLE_GATE, I_NORM_FINAL, N_IN };

constexpr size_t MiB = 1u << 20;
constexpr size_t WS_CTL = 0;
constexpr size_t WS_SMALL = 1 * MiB;
constexpr size_t WS_HCAT = 2 * MiB;
constexpr size_t WS_PROJ = 74 * MiB;
constexpr size_t WS_W = 210 * MiB;
constexpr size_t WS_ROPE = 256 * MiB;
constexpr size_t WS_LSE = 260 * MiB;
constexpr size_t WS_YCPRE = 262 * MiB;
constexpr size_t WS_END = 278 * MiB;
constexpr size_t OV_X3 = WS_PROJ + 32 * MiB;
constexpr size_t OV_GATES = WS_PROJ, OV_MERGED = WS_PROJ + 96 * MiB, OV_PLEG = WS_PROJ + 96 * MiB;
constexpr size_t SM_EID = WS_SMALL, SM_WGT = WS_SMALL + 128 * 1024;
constexpr size_t SM_RSTD_MOE = WS_LSE + 1 * MiB, SM_RSTD_PLE = SM_RSTD_MOE + 64 * 1024;
constexpr size_t SM_SSQ = WS_LSE + 2 * MiB;
__device__ __forceinline__ unsigned long long ssq_fix(float ps) { ps = __builtin_amdgcn_fmed3f(ps, 0.f, 2.0e9f); const unsigned hi = (unsigned)ps; const unsigned lo = (unsigned)((ps - (float)hi) * 4294967296.f); return ((unsigned long long)hi << 32) | lo; }
__device__ __forceinline__ float ssq_val(unsigned long long v) { return (float)(unsigned)(v >> 32) + (float)(unsigned)v * 2.3283064365386963e-10f; }

typedef unsigned short bf16;
typedef float f32x4 __attribute__((ext_vector_type(4)));
typedef unsigned u32x2 __attribute__((ext_vector_type(2)));
typedef unsigned u32x4 __attribute__((ext_vector_type(4)));

__device__ __forceinline__ unsigned f2bf(float f) { unsigned u = __builtin_bit_cast(unsigned, f); return (u + 0x7fffu + ((u >> 16) & 1u)) >> 16; }
__device__ __forceinline__ float bf2f(unsigned h) { return __builtin_bit_cast(float, h << 16); }
__device__ __forceinline__ unsigned pk2(float lo, float hi) { return f2bf(lo) | (f2bf(hi) << 16); }
__device__ __forceinline__ float bflo(unsigned w) { return __builtin_bit_cast(float, w << 16); }
__device__ __forceinline__ float bfhi(unsigned w) { return __builtin_bit_cast(float, w & 0xffff0000u); }
__device__ __forceinline__ float wave_sum(float v) {
#pragma unroll
    for (int o = 1; o < 64; o <<= 1) v += __shfl_xor(v, o);
    return v;
}
__device__ __forceinline__ float sigmoidf_(float x) { return 1.f / (1.f + __expf(-x)); }

struct Args { const void* in[N_IN]; float* out; unsigned char* ws; int ph_lo, ph_hi; };

struct Frame {
    int tid, lane, wave, wg, G;
    float* out; unsigned char* ws;
    float* lds;
};
extern __shared__ __attribute__((aligned(16))) unsigned char lds_raw[];
template <int I> __device__ __forceinline__ const void* arg_ptr() {
    const void* p; asm volatile("s_load_dwordx2 %0, %1, %2\n\ts_waitcnt lgkmcnt(0)" : "=s"(p) : "s"(__builtin_amdgcn_kernarg_segment_ptr()), "i"(I * 8) : "memory"); return p; }
static_assert(N_IN == 25, "Args layout: in[25] at 0, out at 200, ws at 208");

__device__ __forceinline__ int lane_id() { int l; asm volatile("v_mbcnt_lo_u32_b32 %0, -1, 0\n\tv_mbcnt_hi_u32_b32 %0, -1, %0" : "=v"(l)); return l; }
#define PHASE_FRAME(F0) Frame F; F.wave = (F0).wave; asm volatile("" : "+s"(F.wave)); F.lane = lane_id(); asm volatile("" : "+v"(F.lane)); F.tid = F.wave * 64 + F.lane; F.wg = blockIdx.x; F.G = gridDim.x; \
    F.out = (float*)arg_ptr<25>(); F.ws = (unsigned char*)arg_ptr<26>(); F.lds = (float*)lds_raw
__device__ __forceinline__ void norm_row_bf16(const float* xrow, const float* g, bf16* orow, int lane) {
    f32x4 v[4]; float s = 0.f;
#pragma unroll
    for (int j = 0; j < 4; ++j) { v[j] = *(const f32x4*)(xrow + j * 256 + lane * 4); s += (v[j][0] * v[j][0] + v[j][1] * v[j][1]) + (v[j][2] * v[j][2] + v[j][3] * v[j][3]); }
    const float r = 1.f / sqrtf(wave_sum(s) * (1.f / D) + EPS);
#pragma unroll
    for (int j = 0; j < 4; ++j) { const f32x4 gg = *(const f32x4*)(g + j * 256 + lane * 4); u32x2 o; o.x = pk2(v[j][0] * r * gg[0], v[j][1] * r * gg[1]); o.y = pk2(v[j][2] * r * gg[2], v[j][3] * r * gg[3]);
        *(u32x2*)(orow + j * 256 + lane * 4) = o; }
}

__device__ __forceinline__ void naive_tile(float (&acc)[8][4], const bf16* A, int lda, const float* B, int ldb, int m0, int n0, int K, float* lds, int tid) {
    float* As = lds;
    float* Bs = lds + 16 * 132;
    const int tx = tid & 31, ty = tid >> 5;
    const int ar = tid >> 2, ak = (tid & 3) * 4;
    const int bk = tid >> 5, bn = (tid & 31) * 4;
    for (int k0 = 0; k0 < K; k0 += 16) {
        const u32x2 av = *(const u32x2*)(A + (size_t)(m0 + ar) * lda + k0 + ak);
        const f32x4 bv = *(const f32x4*)(B + (size_t)(k0 + bk) * ldb + n0 + bn);
        __syncthreads();
        As[(ak + 0) * 132 + ar] = bflo(av.x); As[(ak + 1) * 132 + ar] = bfhi(av.x);
        As[(ak + 2) * 132 + ar] = bflo(av.y); As[(ak + 3) * 132 + ar] = bfhi(av.y);
        *(f32x4*)(Bs + bk * 132 + bn) = bv;
        __syncthreads();
#pragma unroll 4
        for (int k = 0; k < 16; ++k) {
            const f32x4 a0 = *(const f32x4*)(As + k * 132 + ty * 8), a1 = *(const f32x4*)(As + k * 132 + ty * 8 + 4);
            const f32x4 b = *(const f32x4*)(Bs + k * 132 + tx * 4);
            const float a[8] = {a0.x, a0.y, a0.z, a0.w, a1.x, a1.y, a1.z, a1.w};
#pragma unroll
            for (int i = 0; i < 8; ++i) { acc[i][0] += a[i] * b.x; acc[i][1] += a[i] * b.y; acc[i][2] += a[i] * b.z; acc[i][3] += a[i] * b.w; }
        }
    }
}
#define ZERO_ACC(acc) _Pragma("unroll") for (int i_ = 0; i_ < 8; ++i_) _Pragma("unroll") for (int j_ = 0; j_ < 4; ++j_) acc[i_][j_] = 0.f

__device__ __forceinline__ const float* xin(const Frame& F, int layer) { return layer == 0 ? (const float*)arg_ptr<I_X>() : F.out; }

template <bool XF32> __device__ __forceinline__ void norm1_rows(const Frame& F, const void* xsrc, unsigned long long* rstd, bf16* hc) {
    f32x4 v[4][4], vn[4][4];
#define N1_LOAD(t0_, V) do { _Pragma("unroll") for (int r = 0; r < 4; ++r) _Pragma("unroll") for (int j = 0; j < 4; ++j) { const size_t off = (size_t)((t0_) + r) * D + j * 256 + F.lane * 4; \
        if (XF32) V[r][j] = *(const f32x4*)((const float*)xsrc + off); \
        else { const u32x2 w = *(const u32x2*)((const bf16*)xsrc + off); V[r][j] = (f32x4){bflo(w.x), bfhi(w.x), bflo(w.y), bfhi(w.y)}; } } } while (0)
    const int tstep = F.G * NWAVES * 4; int t0 = (F.wg * NWAVES + F.wave) * 4;
    if (t0 < T) N1_LOAD(t0, v);
#pragma unroll 1
    for (; t0 < T; t0 += tstep) {
        const bool has_next = t0 + tstep < T;
        if (has_next) N1_LOAD(t0 + tstep, vn);
#pragma unroll
        for (int r = 0; r < 4; ++r) { float sq = 0.f;
#pragma unroll
            for (int j = 0; j < 4; ++j) sq += (v[r][j][0] * v[r][j][0] + v[r][j][1] * v[r][j][1]) + (v[r][j][2] * v[r][j][2] + v[r][j][3] * v[r][j][3]);
            const float rr = 1.f / sqrtf(wave_sum(sq) * (1.f / D) + EPS);
#pragma unroll
            for (int j = 0; j < 4; ++j) { u32x2 o; o.x = pk2(v[r][j][0] * rr, v[r][j][1] * rr); o.y = pk2(v[r][j][2] * rr, v[r][j][3] * rr);
                *(u32x2*)(hc + (size_t)(t0 + r) * HC + HC_H + j * 256 + F.lane * 4) = o; } }
        if (has_next) {
#pragma unroll
            for (int r = 0; r < 4; ++r)
#pragma unroll
                for (int j = 0; j < 4; ++j) v[r][j] = vn[r][j]; }
    }
#undef N1_LOAD
}
__device__ __forceinline__ void ph_norm1(const Frame& F0, int layer) { PHASE_FRAME(F0);
    unsigned long long* rstd = (unsigned long long*)(F.ws + SM_SSQ);
    bf16* hc = (bf16*)(F.ws + WS_HCAT);
    if (layer == 0) norm1_rows<true>(F, arg_ptr<I_X>(), rstd, hc); else norm1_rows<false>(F, (const void*)F.out, rstd, hc);
}

__device__ __forceinline__ void ph_proj_naive(const Frame& F0, int layer) { PHASE_FRAME(F0);
    const bf16* hc = (const bf16*)(F.ws + WS_HCAT); bf16* proj = (bf16*)(F.ws + WS_PROJ);
    const float* W = (const float*)arg_ptr<I_W_IN>() + (size_t)layer * D * INW;
    const int ntn = INW / 128, ntiles = (T / 128) * ntn;
    for (int it = F.wg; it < ntiles; it += F.G) {
        const int m0 = (it / ntn) * 128, n0 = (it % ntn) * 128;
        float acc[8][4]; ZERO_ACC(acc);
        naive_tile(acc, hc + HC_H, HC, W, INW, m0, n0, D, F.lds, F.tid);
        const int tx = F.tid & 31, ty = F.tid >> 5;
#pragma unroll
        for (int i = 0; i < 8; ++i) { u32x2 o; o.x = pk2(acc[i][0], acc[i][1]); o.y = pk2(acc[i][2], acc[i][3]);
            *(u32x2*)(proj + (size_t)(m0 + ty * 8 + i) * INW + n0 + tx * 4) = o; }
    }
}

__device__ __forceinline__ void ph_rope_naive(const Frame& F0) { PHASE_FRAME(F0);
    bf16* proj = (bf16*)(F.ws + WS_PROJ); const int* pos = (const int*)arg_ptr<I_POS>();
    const int j = F.lane & 31, sub = F.lane >> 5;
    const float inv = exp2f(-(float)j * (13.287712379549449f / 32.0f));
    const long nitems = (long)T * 24 / 2;
    for (long it = (long)F.wg * NWAVES + F.wave; it < nitems; it += (long)F.G * NWAVES) {
        const long th = it * 2 + sub; const int t = (int)(th / 24), hh = (int)(th % 24);
        const int c0 = (hh < 12 ? C_QA : C_KA - 768) + hh * 64;
        bf16* p = proj + (size_t)t * INW + c0;
        const float t1 = bf2f(p[j]), t2 = bf2f(p[j + 32]);
        const float ang = (float)pos[t] * inv;
        double rev = (double)ang * 0.15915494309189535; rev -= floor(rev);
        const float fr = (float)rev;
        const float sn = __builtin_amdgcn_sinf(fr), cs = __builtin_amdgcn_cosf(fr);
        const float sc = hh < 12 ? C2 : 1.0f;
        const float r1 = (t1 * cs - t2 * sn) * sc, r2 = (t2 * cs + t1 * sn) * sc;
        *(unsigned*)(p + 2 * j) = pk2(r1, r2);
    }
    const long nq = (long)T * 512 / 2;
    for (long i = (long)F.wg * NTHREADS + F.tid; i < nq; i += (long)F.G * NTHREADS) {
        const int t = (int)(i / 256), c = (int)(i % 256) * 2;
        unsigned* p = (unsigned*)(proj + (size_t)t * INW + C_QB + c); const unsigned w = *p; *p = pk2(bflo(w) * C2, bfhi(w) * C2);
    }
}

__device__ __forceinline__ void ph_dil_naive(const Frame& F0) { PHASE_FRAME(F0);
    bf16* proj = (bf16*)(F.ws + WS_PROJ); float* lse = (float*)(F.ws + WS_LSE);
    const long n = (long)T * 12;
    for (long i = (long)F.wg * NTHREADS + F.tid; i < n; i += (long)F.G * NTHREADS) {
        const int gj = (int)(i / T), tt = (int)(i % T);
        const int g = gj >> 2, b = tt / SEQ, s = tt % SEQ, d = (g == 0) ? 1 : (g == 1 ? 4 : 16);
        const unsigned* qp = (const unsigned*)(proj + (size_t)tt * INW + C_QA + gj * 64);
        float q[64];
#pragma unroll
        for (int c = 0; c < 32; ++c) { const unsigned w = qp[c]; q[2 * c] = bflo(w); q[2 * c + 1] = bfhi(w); }
        float o[64];
#pragma unroll
        for (int c = 0; c < 64; ++c) o[c] = 0.f;
        float m = -1e30f, l = 0.f;
        for (int mm = 0; mm <= 128; ++mm) {
            const int sp = s - mm * d; if (sp < 0) break;
            const size_t row = (size_t)(b * SEQ + sp) * INW;
            const unsigned* kp = (const unsigned*)(proj + row + C_KA + gj * 64);
            const unsigned* vp = (const unsigned*)(proj + row + C_VA + gj * 64);
            float z = 0.f;
#pragma unroll
            for (int c = 0; c < 32; ++c) { const unsigned w = kp[c]; z += q[2 * c] * bflo(w) + q[2 * c + 1] * bfhi(w); }
            const float mn = fmaxf(m, z), a = exp2f(m - mn), pz = exp2f(z - mn);
            l = l * a + pz; m = mn;
#pragma unroll
            for (int c = 0; c < 32; ++c) { const unsigned w = vp[c]; o[2 * c] = o[2 * c] * a + pz * bflo(w); o[2 * c + 1] = o[2 * c + 1] * a + pz * bfhi(w); }
        }
        const float rl = 1.f / l;
        unsigned* op = (unsigned*)(proj + (size_t)tt * INW + C_QA + gj * 64);
#pragma unroll
        for (int c = 0; c < 32; ++c) op[c] = pk2(o[2 * c] * rl, o[2 * c + 1] * rl);
        lse[(size_t)tt * 12 + gj] = m + log2f(l);
    }
}

__device__ __forceinline__ void ph_sb_naive(const Frame& F0) { PHASE_FRAME(F0);
    const bf16* proj = (const bf16*)(F.ws + WS_PROJ); bf16* hc = (bf16*)(F.ws + WS_HCAT);
    const int nitems = BATCH * 8 * (SEQ / 64);
    for (int it = F.wg * NWAVES + F.wave; it < nitems; it += F.G * NWAVES) {
        const int chunk = (SEQ / 64 - 1) - it / (BATCH * 8), bh = it % (BATCH * 8), b = bh >> 3, h = bh & 7;
        const int t = chunk * 64 + F.lane;
        const unsigned* qp = (const unsigned*)(proj + (size_t)(b * SEQ + t) * INW + C_QB + h * 64);
        float q[64], o[64];
#pragma unroll
        for (int c = 0; c < 32; ++c) { const unsigned w = qp[c]; q[2 * c] = bflo(w); q[2 * c + 1] = bfhi(w); }
#pragma unroll
        for (int c = 0; c < 64; ++c) o[c] = 0.f;
        float carry = 0.f;
        for (int s = chunk * 64 + 62; s >= 0; --s) {
            const size_t row = (size_t)(b * SEQ + s) * INW;
            const unsigned* kp = (const unsigned*)(proj + row + C_KB + h * 64);
            const unsigned* vp = (const unsigned*)(proj + row + C_VB + h * 64);
            float z = 0.f;
#pragma unroll
            for (int c = 0; c < 32; ++c) { const unsigned w = kp[c]; z += q[2 * c] * bflo(w) + q[2 * c + 1] * bfhi(w); }
            const float sp = (z > 30.f) ? z : log2f(1.f + exp2f(z));
            float a = exp2f(z - sp - carry);
            const bool act = s < t;
            a = act ? a : 0.f; carry += act ? sp : 0.f;
#pragma unroll
            for (int c = 0; c < 32; ++c) { const unsigned w = vp[c]; o[2 * c] += a * bflo(w); o[2 * c + 1] += a * bfhi(w); }
        }
        unsigned* op = (unsigned*)(hc + (size_t)(b * SEQ + t) * HC + HC_OB + h * 64);
#pragma unroll
        for (int c = 0; c < 32; ++c) op[c] = pk2(o[2 * c], o[2 * c + 1]);
    }
}

__device__ __forceinline__ void ph_pool_naive(const Frame& F0) { PHASE_FRAME(F0);
    const bf16* proj = (const bf16*)(F.ws + WS_PROJ); bf16* hc = (bf16*)(F.ws + WS_HCAT);
    const long n = (long)T * 512;
    for (long i = (long)F.wg * NTHREADS + F.tid; i < n; i += (long)F.G * NTHREADS) {
        const int t = (int)(i / 512), c = (int)(i % 512), g = c >> 7, w = 2 << g, s = t % SEQ;
        const int cnt = (s + 1 < w) ? s + 1 : w;
        float sum = 0.f;
        for (int k = 0; k < cnt; ++k) sum += bf2f(proj[(size_t)(t - k) * INW + C_UC + c]);
        const float u = bf2f(proj[(size_t)t * INW + C_UC + c]);
        hc[(size_t)t * HC + HC_PL + c] = (bf16)f2bf(sum / (float)cnt - u);
    }
}

__device__ __forceinline__ void ph_comb_naive(const Frame& F0, int layer) { PHASE_FRAME(F0);
    const bf16* proj = (const bf16*)(F.ws + WS_PROJ); bf16* hc = (bf16*)(F.ws + WS_HCAT); const float* lse = (const float*)(F.ws + WS_LSE);
    float l0, l1, l2, n0, n1, n2; u32x4 a, b_, d_, na, nb, nd;
#define COMB_LOAD(i_, L0, L1, L2, A, B, DD) do { const int t = (i_) >> 5, c = ((i_) & 31) * 8, j = c >> 6, s_ = t & (SEQ - 1), bb = t - s_, cl = c & 63; \
        L0 = lse[(size_t)t * 12 + j]; L1 = lse[(size_t)t * 12 + 4 + j]; L2 = lse[(size_t)t * 12 + 8 + j]; \
        A = *(const u32x4*)(proj + PJ_HM(j, t) + cl); B = *(const u32x4*)(proj + PJ_HM(4 + j, bb + (s_ & 3) * (SEQ / 4) + (s_ >> 2)) + cl); DD = *(const u32x4*)(proj + PJ_HM(8 + j, bb + (s_ & 15) * (SEQ / 16) + (s_ >> 4)) + cl); } while (0)
    const int step = F.G * NTHREADS; int i = F.wg * NTHREADS + F.tid;
    if (i < T * 32) COMB_LOAD(i, l0, l1, l2, a, b_, d_);
#pragma unroll 1
    for (; i < T * 32; i += step) {
        const bool has_next = i + step < T * 32;
        if (has_next) COMB_LOAD(i + step, n0, n1, n2, na, nb, nd);
        const int t = i >> 5, c = (i & 31) * 8;
        const float mx = fmaxf(l0, fmaxf(l1, l2)), e0 = exp2f(l0 - mx), e1 = exp2f(l1 - mx), e2 = exp2f(l2 - mx), rs = 1.f / (e0 + e1 + e2);
        u32x4 o;
#pragma unroll
        for (int q = 0; q < 4; ++q) o[q] = pk2((e0 * bflo(a[q]) + e1 * bflo(b_[q]) + e2 * bflo(d_[q])) * rs, (e0 * bfhi(a[q]) + e1 * bfhi(b_[q]) + e2 * bfhi(d_[q])) * rs);
        *(u32x4*)(hc + (size_t)t * HC + HC_OA + c) = o;
        if (has_next) { l0 = n0; l1 = n1; l2 = n2; a = na; b_ = nb; d_ = nd; }
    }
#undef COMB_LOAD
}
__device__ __forceinline__ void ph_ycpre_naive(const Frame& F0, int layer) { PHASE_FRAME(F0);
    bf16* hc = (bf16*)(F.ws + WS_HCAT);
    const float* wp = (const float*)arg_ptr<I_W_POOL>() + (size_t)layer * 4 * 128 * 128; const float* ps = (const float*)arg_ptr<I_POOL_SCALE>() + layer * 512;
    bf16* yc = (bf16*)(F.ws + WS_YCPRE);
    const long n2 = (long)T * 512;
    for (long i = (long)F.wg * NTHREADS + F.tid; i < n2; i += (long)F.G * NTHREADS) {
        const int t = (int)(i / 512), c = (int)(i % 512), g = c >> 7, dd = c & 127;
        const bf16* pl = hc + (size_t)t * HC + HC_PL + g * 128; const float* w = wp + (size_t)g * 128 * 128 + dd;
        float s = 0.f;
        for (int k = 0; k < 128; ++k) s += bf2f(pl[k]) * w[k * 128];
        yc[(size_t)t * 512 + c] = (bf16)f2bf(s * ps[c]);
    }
}

__device__ __forceinline__ void ph_g4_naive(const Frame& F0, int layer) { PHASE_FRAME(F0);
    const bf16* hc = (const bf16*)(F.ws + WS_HCAT); const bf16* yc = (const bf16*)(F.ws + WS_YCPRE); bf16* mg = (bf16*)(F.ws + OV_MERGED);
    const float* wg = (const float*)arg_ptr<I_W_GATE>() + (size_t)layer * D * NGATE; const float* bg = (const float*)arg_ptr<I_B_GATE>() + layer * NGATE;
    const float* wa = (const float*)arg_ptr<I_W_UP_A>() + (size_t)layer * 256 * D; const float* wb = (const float*)arg_ptr<I_W_UP_B>() + (size_t)layer * 512 * D;
    const float* wc = (const float*)arg_ptr<I_W_UP_C>() + (size_t)layer * 512 * D;
    const int ntiles = (T / 128) * 8; const int tx = F.tid & 31, ty = F.tid >> 5;
    for (int it = F.wg; it < ntiles; it += F.G) {
        const int m0 = (it / 8) * 128, n0 = (it % 8) * 128;
        float m[8][4]; ZERO_ACC(m);
#pragma unroll 1
        for (int b = 0; b < 3; ++b) {
            float g[8][4]; ZERO_ACC(g);
            naive_tile(g, hc + HC_H, HC, wg, NGATE, m0, b * 1024 + n0, D, F.lds, F.tid);
            const f32x4 bias = *(const f32x4*)(bg + b * 1024 + n0 + tx * 4);
#pragma unroll
            for (int i = 0; i < 8; ++i) { g[i][0] = sigmoidf_(g[i][0] + bias.x); g[i][1] = sigmoidf_(g[i][1] + bias.y); g[i][2] = sigmoidf_(g[i][2] + bias.z); g[i][3] = sigmoidf_(g[i][3] + bias.w); }
            float acc[8][4]; ZERO_ACC(acc);
            if (b == 0) naive_tile(acc, hc + HC_OA, HC, wa, D, m0, n0, 256, F.lds, F.tid);
            else if (b == 1) naive_tile(acc, hc + HC_OB, HC, wb, D, m0, n0, 512, F.lds, F.tid);
            else naive_tile(acc, yc, 512, wc, D, m0, n0, 512, F.lds, F.tid);
#pragma unroll
            for (int i = 0; i < 8; ++i)
#pragma unroll
                for (int j = 0; j < 4; ++j) m[i][j] += g[i][j] * acc[i][j];
        }
#pragma unroll
        for (int i = 0; i < 8; ++i) { u32x2 o; o.x = pk2(m[i][0], m[i][1]); o.y = pk2(m[i][2], m[i][3]); *(u32x2*)(mg + (size_t)(m0 + ty * 8 + i) * D + n0 + tx * 4) = o; }
    }
}

__device__ __forceinline__ void ph_g5_naive(const Frame& F0, int layer) { PHASE_FRAME(F0);
    const bf16* mg = (const bf16*)(F.ws + OV_MERGED); const float* W = (const float*)arg_ptr<I_W_OUT>() + (size_t)layer * D * D; const float* x = xin(F, layer);
    const int ntiles = (T / 128) * 8; const int tx = F.tid & 31, ty = F.tid >> 5;
    for (int it = F.wg; it < ntiles; it += F.G) {
        const int m0 = (it / 8) * 128, n0 = (it % 8) * 128;
        float acc[8][4]; ZERO_ACC(acc);
        naive_tile(acc, mg, D, W, D, m0, n0, D, F.lds, F.tid);
#pragma unroll
        for (int i = 0; i < 8; ++i) { const size_t off = (size_t)(m0 + ty * 8 + i) * D + n0 + tx * 4; const f32x4 xv = *(const f32x4*)(x + off);
            *(f32x4*)(F.out + off) = (f32x4){xv.x + acc[i][0], xv.y + acc[i][1], xv.z + acc[i][2], xv.w + acc[i][3]}; }
    }
}

__device__ __forceinline__ void ph_route(const Frame& F0, int layer) { PHASE_FRAME(F0);
    const float* g = (const float*)arg_ptr<I_NORM_MOE>() + layer * D;
    const float* wrg = (const float*)arg_ptr<I_W_RG>() + (size_t)layer * D * 4; const float* brg = (const float*)arg_ptr<I_B_RG>() + layer * 4;
    const float* wre = (const float*)arg_ptr<I_W_RE>() + (size_t)layer * 4 * D * 4; const float* bre = (const float*)arg_ptr<I_B_RE>() + layer * 16;
    bf16* hmb = (bf16*)(F.ws + WS_PROJ); int* eid = (int*)(F.ws + SM_EID); float* wgt = (float*)(F.ws + SM_WGT);
    for (int t = F.wg * NWAVES + F.wave; t < T; t += F.G * NWAVES) {
        const float* xr = F.out + (size_t)t * D;
        float s = 0.f;
#pragma unroll
        for (int i = 0; i < 16; ++i) { const float xv = xr[i * 64 + F.lane]; s += xv * xv; }
        const float r = 1.f / sqrtf(wave_sum(s) * (1.f / D) + EPS);
        float lg[4] = {0.f, 0.f, 0.f, 0.f}; float le[16];
#pragma unroll
        for (int e = 0; e < 16; ++e) le[e] = 0.f;
#pragma unroll 2
        for (int i = 0; i < 16; ++i) {
            const int k = i * 64 + F.lane; const float hm = xr[k] * r * g[k];
            hmb[(size_t)t * D + k] = (bf16)f2bf(hm);
            const f32x4 a = *(const f32x4*)(wrg + (size_t)k * 4);
            lg[0] += hm * a.x; lg[1] += hm * a.y; lg[2] += hm * a.z; lg[3] += hm * a.w;
#pragma unroll
            for (int gg = 0; gg < 4; ++gg) { const f32x4 w = *(const f32x4*)(wre + ((size_t)gg * D + k) * 4);
                le[gg * 4 + 0] += hm * w.x; le[gg * 4 + 1] += hm * w.y; le[gg * 4 + 2] += hm * w.z; le[gg * 4 + 3] += hm * w.w; }
        }
#pragma unroll
        for (int e = 0; e < 4; ++e) lg[e] = wave_sum(lg[e]) + brg[e];
#pragma unroll
        for (int e = 0; e < 16; ++e) le[e] = wave_sum(le[e]) + bre[e];
        if (F.lane == 0) {
            int gi = 0; float mx = lg[0];
#pragma unroll
            for (int e = 1; e < 4; ++e) if (lg[e] > mx) { mx = lg[e]; gi = e; }
            float den = 0.f;
#pragma unroll
            for (int e = 0; e < 4; ++e) den += __expf(lg[e] - mx);
            const float p1 = 1.f / den;
            float ls[4];
#pragma unroll
            for (int e = 0; e < 4; ++e) ls[e] = gi == 0 ? le[e] : gi == 1 ? le[4 + e] : gi == 2 ? le[8 + e] : le[12 + e];
            int i0 = 0; float v0 = ls[0];
#pragma unroll
            for (int e = 1; e < 4; ++e) if (ls[e] > v0) { v0 = ls[e]; i0 = e; }
            int i1 = -1; float v1 = -3.0e38f;
#pragma unroll
            for (int e = 0; e < 4; ++e) if (e != i0 && ls[e] > v1) { v1 = ls[e]; i1 = e; }
            const float ex = __expf(v1 - v0), w0 = p1 / (1.f + ex), w1 = p1 * ex / (1.f + ex);
            eid[t * 2 + 0] = gi * 4 + i0; eid[t * 2 + 1] = gi * 4 + i1; wgt[t * 2 + 0] = w0; wgt[t * 2 + 1] = w1;
        }
    }
}

__device__ __forceinline__ void ph_moe_naive(const Frame& F0, int layer) { PHASE_FRAME(F0);
    const bf16* hmb = (const bf16*)(F.ws + WS_PROJ); const int* eid = (const int*)(F.ws + SM_EID); const float* wgt = (const float*)(F.ws + SM_WGT);
    const float* WG = (const float*)arg_ptr<I_W_EG>() + (size_t)layer * NEXP * D * EXP_H; const float* WU = (const float*)arg_ptr<I_W_EU>() + (size_t)layer * NEXP * D * EXP_H;
    const float* WD = (const float*)arg_ptr<I_W_ED>() + (size_t)layer * NEXP * EXP_H * D;
    float* hrow = F.lds; float* hid = F.lds + D;
    for (int t = F.wg; t < T; t += F.G) {
        __syncthreads();
        for (int k = F.tid; k < D; k += NTHREADS) hrow[k] = bf2f(hmb[(size_t)t * D + k]);
        __syncthreads();
        const int slot = F.tid >> 8, f = F.tid & 255, e = eid[t * 2 + slot];
        const float* wg = WG + (size_t)e * D * EXP_H + f; const float* wu = WU + (size_t)e * D * EXP_H + f;
        float a = 0.f, u = 0.f;
#pragma unroll 8
        for (int k = 0; k < D; ++k) { const float h = hrow[k]; a += h * wg[(size_t)k * EXP_H]; u += h * wu[(size_t)k * EXP_H]; }
        const float hv = (a / (1.f + __expf(-a))) * u * wgt[t * 2 + slot];
        hid[slot * 256 + f] = bf2f(f2bf(hv));
        __syncthreads();
        const int e0 = eid[t * 2], e1 = eid[t * 2 + 1];
        const float* d0 = WD + (size_t)e0 * EXP_H * D; const float* d1 = WD + (size_t)e1 * EXP_H * D;
        for (int n = F.tid; n < D; n += NTHREADS) {
            float y = 0.f;
#pragma unroll 8
            for (int ff = 0; ff < 256; ++ff) y += hid[ff] * d0[(size_t)ff * D + n] + hid[256 + ff] * d1[(size_t)ff * D + n];
            F.out[(size_t)t * D + n] += y;
        }
    }
}

__device__ __forceinline__ void ph_e(const Frame& F0, int layer) { PHASE_FRAME(F0);
    const float* g = (const float*)arg_ptr<I_NORM_PLE>() + layer * D; const float* p = (const float*)arg_ptr<I_P>() + (size_t)layer * T * PLE_DIM;
    bf16* hc = (bf16*)(F.ws + WS_HCAT);
    for (int t = F.wg * NWAVES + F.wave; t < T; t += F.G * NWAVES) {
        norm_row_bf16(F.out + (size_t)t * D, g, hc + (size_t)t * HC + HC_H, F.lane);
#pragma unroll
        for (int i = 0; i < 4; ++i) hc[(size_t)t * HC + HC_OA + i * 64 + F.lane] = (bf16)f2bf(p[(size_t)t * PLE_DIM + i * 64 + F.lane]);
    }
}

__device__ __forceinline__ void ph_ple_naive(const Frame& F0, int layer) { PHASE_FRAME(F0);
    const bf16* hc = (const bf16*)(F.ws + WS_HCAT);
    const float* wi = (const float*)arg_ptr<I_W_PLE_IN>() + (size_t)layer * PLE_DIM * D; const float* wg = (const float*)arg_ptr<I_W_PLE_GATE>() + (size_t)layer * D * D;
    const int ntiles = (T / 128) * 8; const int tx = F.tid & 31, ty = F.tid >> 5;
    for (int it = F.wg; it < ntiles; it += F.G) {
        const int m0 = (it / 8) * 128, n0 = (it % 8) * 128;
        float g[8][4]; ZERO_ACC(g);
        naive_tile(g, hc + HC_H, HC, wg, D, m0, n0, D, F.lds, F.tid);
        float acc[8][4]; ZERO_ACC(acc);
        naive_tile(acc, hc + HC_OA, HC, wi, D, m0, n0, PLE_DIM, F.lds, F.tid);
#pragma unroll
        for (int i = 0; i < 8; ++i) { const size_t off = (size_t)(m0 + ty * 8 + i) * D + n0 + tx * 4; f32x4 xv = *(const f32x4*)(F.out + off);
            xv.x += acc[i][0] * sigmoidf_(g[i][0]); xv.y += acc[i][1] * sigmoidf_(g[i][1]); xv.z += acc[i][2] * sigmoidf_(g[i][2]); xv.w += acc[i][3] * sigmoidf_(g[i][3]);
            *(f32x4*)(F.out + off) = xv; }
    }
}

__device__ __forceinline__ void ph_final(const Frame& F0) { PHASE_FRAME(F0);
    const float* g = (const float*)arg_ptr<I_NORM_FINAL>(); const bf16* x3 = (const bf16*)(F.ws + OV_X3);
    u32x2 xw[2][4], xn[2][4];
#define FIN_LOAD(t0_, XW) do { _Pragma("unroll") for (int r = 0; r < 2; ++r) _Pragma("unroll") for (int j = 0; j < 4; ++j) XW[r][j] = *(const u32x2*)(x3 + (size_t)((t0_) + r) * D + j * 256 + F.lane * 4); } while (0)
    const int tstep = F.G * NWAVES * 2; int t0 = (F.wg * NWAVES + F.wave) * 2;
    f32x4 gg[4];
#pragma unroll
    for (int j = 0; j < 4; ++j) gg[j] = *(const f32x4*)(g + j * 256 + F.lane * 4);
    if (t0 < T) FIN_LOAD(t0, xw);
#pragma unroll 1
    for (; t0 < T; t0 += tstep) {
        const bool has_next = t0 + tstep < T;
        if (has_next) FIN_LOAD(t0 + tstep, xn);
#pragma unroll
        for (int r = 0; r < 2; ++r) { float s = 0.f; f32x4 v[4];
#pragma unroll
            for (int j = 0; j < 4; ++j) { v[j] = (f32x4){bflo(xw[r][j].x), bfhi(xw[r][j].x), bflo(xw[r][j].y), bfhi(xw[r][j].y)}; s += (v[j][0] * v[j][0] + v[j][1] * v[j][1]) + (v[j][2] * v[j][2] + v[j][3] * v[j][3]); }
            const float rr = 1.f / sqrtf(wave_sum(s) * (1.f / D) + EPS);
#pragma unroll
            for (int j = 0; j < 4; ++j) *(f32x4*)(F.out + (size_t)(t0 + r) * D + j * 256 + F.lane * 4) = v[j] * rr * gg[j]; }
        if (has_next) {
#pragma unroll
            for (int r = 0; r < 2; ++r)
#pragma unroll
                for (int j = 0; j < 4; ++j) xw[r][j] = xn[r][j]; }
    }
#undef FIN_LOAD
}


#define LAS __attribute__((address_space(3)))
typedef short bf16x8 __attribute__((ext_vector_type(8)));
typedef float f32x2 __attribute__((ext_vector_type(2)));
#define LDS_WAIT() asm volatile("s_waitcnt lgkmcnt(0)" ::: "memory")
#define VM_WAIT() asm volatile("s_waitcnt vmcnt(0)" ::: "memory")
typedef __bf16 bf16x2_t __attribute__((ext_vector_type(2)));
__device__ __forceinline__ unsigned cvt_pk_bf16(float lo, float hi) { f32x2 v = {lo, hi}; bf16x2_t b = __builtin_convertvector(v, bf16x2_t); return __builtin_bit_cast(unsigned, b); }
#define NEG_LOG2E (-1.4426950408889634f)
__device__ __forceinline__ float sigmoid_pre(float v) { return __builtin_amdgcn_rcpf(1.f + __builtin_amdgcn_exp2f(v)); }
__device__ __forceinline__ float fast_sigmoid(float x) { return __builtin_amdgcn_rcpf(1.f + __builtin_amdgcn_exp2f(-1.4426950408889634f * x)); }

constexpr size_t WO_IN = 0;
constexpr size_t WO_BCAT = WO_IN + (size_t)INW * D;
constexpr size_t WO_OUT = WO_BCAT + (size_t)D * 4352;
constexpr size_t WO_M1 = WO_OUT + (size_t)D * D;
constexpr size_t WO_M2 = WO_M1 + (size_t)NEXP * 512 * D;
constexpr size_t WO_PLE = WO_M2 + (size_t)NEXP * D * EXP_H;
constexpr size_t WO_END = WO_PLE + (size_t)D * 1280;
static_assert(WO_END * 2 <= 46 * MiB, "layer weights fit");
constexpr int BCAT_LD = 4352, PLE_LD = 1280;
constexpr int RMAX = 36864;
constexpr size_t OV_HM = WS_PROJ;
constexpr size_t OV_HID = WS_PROJ + 32 * MiB;
constexpr size_t OV_Y2 = WS_PROJ + 50 * MiB;
constexpr size_t OV_ASORT = WS_HCAT;
constexpr size_t OV_GT = WS_PROJ;
constexpr size_t SM_ROWTOK = WS_SMALL + 768 * 1024;
constexpr size_t SM_SLOT2 = WS_SMALL + 256 * 1024, SM_WROW = WS_SMALL + 384 * 1024, SM_TILE = WS_SMALL + 704 * 1024;

__device__ __forceinline__ int xcd_remap(int c, int n) { const int q = n / 8, r = n % 8, x = c % 8, k = c / 8; return (x < r ? x * (q + 1) : r * (q + 1) + (x - r) * q) + k; }
namespace pg8 {
constexpr int BM = 256, BK = 64, HALF = 128, HTB = HALF * BK * 2, STAGE_BYTES = 8 * HTB, NXCD = 8, WGM = 8;
__device__ __forceinline__ int lds_byte(int r, int c) { const int st = (r >> 4) * 2 + (c >> 5), rr = r & 15, cc = c & 31, ob = rr * 64 + cc * 2; return st * 1024 + (ob ^ (((ob >> 9) & 1) << 5)); }
__device__ __forceinline__ void stage_rc(int b, int& R, int& C) { const int st = b / 1024, sb = b % 1024, swz = sb ^ (((sb >> 9) & 1) << 5); R = (st >> 1) * 16 + swz / 64; C = (st & 1) * 32 + (swz % 64) / 2; }
__device__ __forceinline__ int perm32(int rho) { const int n = rho >> 4, i = rho & 15; return 8 * (i >> 2) + 4 * n + (i & 3); }

struct Unit { int pm, pn, ka, kb, nt, kind; };
struct Gemm { const bf16* A; int lda; const bf16* Bt; int ldb; const int* rowmap; };

__device__ __forceinline__ bool tile_order(int nM, int nN, int G, int c, int i, int& pm, int& pn) {
    const int nwg = nM * nN; const long L = (long)i * G + c; if (L >= nwg) return false;
    int wgid = (int)L; { const int q = nwg / NXCD, r = nwg % NXCD, xcd = wgid % NXCD, off = wgid / NXCD; wgid = (xcd < r ? xcd * (q + 1) : r * (q + 1) + (xcd - r) * q) + off; }
    const int nig = WGM * nN, gid = wgid / nig, fm = gid * WGM, gsz = (nM - fm) < WGM ? (nM - fm) : WGM;
    pm = fm + ((wgid % nig) % gsz); pn = (wgid % nig) / gsz; return true;
}

template <class Epi, class Sched, bool ALIGN_EPI, bool GATHER = false>
__device__ __forceinline__ void gemm_phase(LAS unsigned char* lds, const Gemm g, const Sched& S, const Epi& E, int tid) {
    asm volatile("" : "+v"(tid));
    const int wid = __builtin_amdgcn_readfirstlane(tid >> 6), lane = tid & 63, wr = wid >> 2, wc = wid & 3, fr = lane & 15, fq = lane >> 4;
    unsigned voffB[2], cvA[2][2], nvA[2][2]; int Rr[2], Cc[2];
#pragma unroll
    for (int i = 0; i < 2; ++i) { int R, C; stage_rc(tid * 16 + i * 8192, R, C); const int Rb = 2 * (R & ~31) + perm32(R & 31);
        Rr[i] = R; Cc[i] = C; voffB[i] = (unsigned)(Rb * g.ldb + C) * 2u;
#pragma unroll
        for (int h = 0; h < 2; ++h) { cvA[h][i] = (unsigned)((R + h * HALF) * g.lda + C) * 2u; nvA[h][i] = cvA[h][i]; } }
    const size_t kstep = (size_t)(BK * 2);
    const size_t hstepB = (size_t)32 * g.ldb * 2;
#define PG8_GATHER_VOFF(u, v) do { _Pragma("unroll") for (int _h = 0; _h < 2; ++_h) _Pragma("unroll") for (int _i = 0; _i < 2; ++_i) { \
        const int tok_ = g.rowmap[(u).pm * BM + _h * HALF + Rr[_i]]; v[_h][_i] = (unsigned)(tok_ * g.lda + Cc[_i]) * 2u; } \
        asm volatile("" : "+v"(v[0][0]), "+v"(v[0][1]), "+v"(v[1][0]), "+v"(v[1][1])); } while (0)
#define PG8_STAGE_A(bufoff, gbase, h, NX) do { _Pragma("unroll") for (int _i = 0; _i < 2; ++_i) { const unsigned vo_ = (GATHER && (NX)) ? nvA[h][_i] : cvA[h][_i]; \
        __builtin_amdgcn_global_load_lds((const unsigned*)((const char*)(gbase) + vo_), (LAS unsigned*)(lds + (bufoff) + ldsw + _i * 8192), 16, 0, 0); } } while (0)
    const unsigned ldsw = (unsigned)wid * 1024u;
    const int aoff = lds_byte(wr * 64 + fr, fq * 8), boff = lds_byte(wc * 32 + fr, fq * 8);
#define PG8_SA(b, h) (((b) * 2 + (h)) * HTB)
#define PG8_SB(b, h) ((4 + (b) * 2 + (h)) * HTB)
#define PG8_STAGE(bufoff, gbase, voff) do { _Pragma("unroll") for (int _i = 0; _i < 2; ++_i) \
        __builtin_amdgcn_global_load_lds((const unsigned*)((const char*)(gbase) + (voff)[_i]), (LAS unsigned*)(lds + (bufoff) + ldsw + _i * 8192), 16, 0, 0); } while (0)
#define PG8_LDA(dst, b, h) do { _Pragma("unroll") for (int m = 0; m < 4; ++m) _Pragma("unroll") for (int k = 0; k < 2; ++k) dst[m][k] = *(const LAS bf16x8*)(lds + PG8_SA(b, h) + aoff + m * 2048 + k * 1024); } while (0)
#define PG8_LDB(dst, b, h) do { _Pragma("unroll") for (int n = 0; n < 2; ++n) _Pragma("unroll") for (int k = 0; k < 2; ++k) dst[n][k] = *(const LAS bf16x8*)(lds + PG8_SB(b, h) + boff + n * 2048 + k * 1024); } while (0)
#define PG8_MMA(ai, bj, At, Bt) do { __builtin_amdgcn_s_setprio(1); _Pragma("unroll") for (int m = 0; m < 4; ++m) _Pragma("unroll") for (int n = 0; n < 2; ++n) _Pragma("unroll") for (int k = 0; k < 2; ++k) \
        acc[ai][bj][m][n] = __builtin_amdgcn_mfma_f32_16x16x32_bf16(Bt[n][k], At[m][k], acc[ai][bj][m][n], 0, 0, 0); __builtin_amdgcn_s_setprio(0); } while (0)
#define PG8_WAIT_V(n) asm volatile("s_waitcnt vmcnt(" #n ")" ::: "memory")
#define PG8_WAIT_L(n) asm volatile("s_waitcnt lgkmcnt(" #n ")" ::: "memory")
#define PG8_BAR __builtin_amdgcn_s_barrier()
#define PG8_SCHED __builtin_amdgcn_sched_barrier(0)
#define PG8_UA(u) ((const char*)g.A + ((GATHER ? (size_t)0 : (size_t)(u).pm * BM * g.lda) + (u).ka) * 2)
#define PG8_UB(u) ((const char*)g.Bt + ((size_t)(u).pn * BM * g.ldb + (u).kb) * 2)
    Unit cur, nxt; int ui = 0;
    if (!S.next(0, cur)) return;
    f32x4 acc[2][2][4][2];
#pragma unroll
    for (int a = 0; a < 2; ++a)
#pragma unroll
        for (int b = 0; b < 2; ++b)
#pragma unroll
            for (int m = 0; m < 4; ++m)
#pragma unroll
                for (int n = 0; n < 2; ++n) acc[a][b][m][n] = (f32x4){0.f, 0.f, 0.f, 0.f};
    bf16x8 At[4][2], B0[2][2], B1[2][2];
    const char* cA = PG8_UA(cur); const char* cB = PG8_UB(cur);
    if constexpr (GATHER) PG8_GATHER_VOFF(cur, cvA);
    PG8_STAGE(PG8_SB(0, 0), cB, voffB); PG8_STAGE(PG8_SB(0, 1), cB + hstepB, voffB); PG8_STAGE_A(PG8_SA(0, 0), cA, 0, false); PG8_STAGE_A(PG8_SA(0, 1), cA, 1, false);
    if (wr == 1) PG8_BAR;
    PG8_WAIT_V(2); PG8_BAR;
    PG8_STAGE(PG8_SB(1, 0), cB + kstep, voffB); PG8_STAGE_A(PG8_SA(1, 0), cA + kstep, 0, false); PG8_STAGE(PG8_SB(1, 1), cB + hstepB + kstep, voffB);
    PG8_WAIT_V(6); PG8_BAR;
    for (;;) {
        const bool has_next = S.next(ui + 1, nxt);
        const char* nA = has_next ? PG8_UA(nxt) : cA; const char* nB = has_next ? PG8_UB(nxt) : cB;
        if constexpr (GATHER) { if (has_next) PG8_GATHER_VOFF(nxt, nvA); }
        const int nt = cur.nt;
#pragma unroll 1
        for (int t = 0; t < nt; t += 2) {
            const bool last = (t == nt - 2), nx = last && has_next;
            const char* a1 = cA + (size_t)(t + 1) * kstep;
            const char* a2 = last ? nA : cA + (size_t)(t + 2) * kstep; const char* b2 = last ? nB : cB + (size_t)(t + 2) * kstep;
            const char* a3 = a2 + kstep; const char* b3 = b2 + kstep;
            PG8_LDB(B0, 0, 0); PG8_LDB(B1, 0, 1); PG8_SCHED; PG8_LDA(At, 0, 0); PG8_STAGE_A(PG8_SA(1, 1), a1, 1, false);
            PG8_WAIT_V(8); PG8_WAIT_L(0); PG8_BAR; PG8_MMA(0, 0, At, B0); PG8_MMA(0, 1, At, B1); PG8_BAR; PG8_SCHED;
            PG8_LDA(At, 0, 1); PG8_STAGE(PG8_SB(0, 0), b2, voffB); PG8_STAGE(PG8_SB(0, 1), b2 + hstepB, voffB); PG8_STAGE_A(PG8_SA(0, 0), a2, 0, nx);
            PG8_WAIT_V(8); PG8_WAIT_L(0); PG8_BAR; PG8_MMA(1, 0, At, B0); PG8_MMA(1, 1, At, B1); PG8_BAR; PG8_SCHED;
            PG8_LDB(B0, 1, 0); PG8_LDB(B1, 1, 1); PG8_SCHED; PG8_LDA(At, 1, 0); PG8_STAGE_A(PG8_SA(0, 1), a2, 1, nx);
            PG8_WAIT_V(8); PG8_WAIT_L(0); PG8_BAR; PG8_MMA(0, 0, At, B0); PG8_MMA(0, 1, At, B1); PG8_BAR; PG8_SCHED;
            PG8_LDA(At, 1, 1); PG8_STAGE(PG8_SB(1, 0), b3, voffB); PG8_STAGE(PG8_SB(1, 1), b3 + hstepB, voffB); PG8_STAGE_A(PG8_SA(1, 0), a3, 0, nx);
            PG8_WAIT_V(8); PG8_WAIT_L(0); PG8_BAR; PG8_MMA(1, 0, At, B0); PG8_MMA(1, 1, At, B1); PG8_BAR; PG8_SCHED;
        }
        if constexpr (ALIGN_EPI) { if (wr == 0) PG8_BAR; }
        E(acc, cur, wr, wc, fr, fq);
        if (!has_next) break;
#pragma unroll
        for (int a = 0; a < 2; ++a)
#pragma unroll
            for (int b = 0; b < 2; ++b)
#pragma unroll
                for (int m = 0; m < 4; ++m)
#pragma unroll
                    for (int n = 0; n < 2; ++n) acc[a][b][m][n] = (f32x4){0.f, 0.f, 0.f, 0.f};
        cur = nxt; cA = nA; cB = nB; ++ui;
        if constexpr (GATHER) {
#pragma unroll
            for (int h = 0; h < 2; ++h)
#pragma unroll
                for (int i = 0; i < 2; ++i) cvA[h][i] = nvA[h][i]; }
        if constexpr (ALIGN_EPI) { if (wr == 1) PG8_BAR; }
    }
    PG8_WAIT_V(0);
    if constexpr (!ALIGN_EPI) { if (wr == 0) PG8_BAR; }
    PG8_BAR;
#undef PG8_SA
#undef PG8_SB
#undef PG8_STAGE
#undef PG8_STAGE_A
#undef PG8_GATHER_VOFF
#undef PG8_LDA
#undef PG8_LDB
#undef PG8_MMA
#undef PG8_WAIT_V
#undef PG8_WAIT_L
#undef PG8_BAR
#undef PG8_SCHED
#undef PG8_UA
#undef PG8_UB
}
}

typedef f32x4 AccT[2][2][4][2];
#define EPI_ROW(u, ai, m) ((u).pm * 256 + (ai) * 128 + wr * 64 + (m) * 16 + fr)
#define EPI_ROW0(u, ai, m) ((u).pm * 256 + (ai) * 128 + wr * 64 + (m) * 16)
#define EPI_FOR_AM _Pragma("unroll") for (int ai = 0; ai < 2; ++ai) _Pragma("unroll") for (int m = 0; m < 4; ++m)
__device__ __forceinline__ u32x4 pack8(const f32x4 v0, const f32x4 v1) { u32x4 w; w.x = cvt_pk_bf16(v0[0], v0[1]); w.y = cvt_pk_bf16(v0[2], v0[3]); w.z = cvt_pk_bf16(v1[0], v1[1]); w.w = cvt_pk_bf16(v1[2], v1[3]); return w; }
__device__ __forceinline__ void unpack8(const u32x4 w, f32x4& v0, f32x4& v1) { v0 = (f32x4){bflo(w.x), bfhi(w.x), bflo(w.y), bfhi(w.y)}; v1 = (f32x4){bflo(w.z), bfhi(w.z), bflo(w.w), bfhi(w.w)}; }
constexpr int STG_OFF = 133120, STG_PITCH = 144, STG_WAVE = 16 * STG_PITCH;
__device__ __forceinline__ void store_rows16(const u32x4 v0, const u32x4 v1, bf16* g0, size_t pitch, int wid, int lane) {
    LAS unsigned char* stg = (LAS unsigned char*)lds_raw + STG_OFF + wid * STG_WAVE; const int fr = lane & 15, fq = lane >> 4;
    *(LAS u32x4*)(stg + fr * STG_PITCH + fq * 16) = v0; *(LAS u32x4*)(stg + fr * STG_PITCH + 64 + fq * 16) = v1;
#pragma unroll
    for (int k = 0; k < 2; ++k) { const int row = (lane >> 3) + 8 * k; const u32x4 w = *(const LAS u32x4*)(stg + row * STG_PITCH + (lane & 7) * 16); *(u32x4*)(g0 + (size_t)row * pitch + (lane & 7) * 8) = w; }
}

__device__ __forceinline__ void store_rows16_perm(const u32x4 v0, const u32x4 v1, bf16* g0, int ld, int wid, int lane) {
    LAS unsigned char* stg = (LAS unsigned char*)lds_raw + STG_OFF + wid * STG_WAVE; const int fr = lane & 15, fq = lane >> 4;
    *(LAS u32x4*)(stg + fr * STG_PITCH + fq * 16) = v0; *(LAS u32x4*)(stg + fr * STG_PITCH + 64 + fq * 16) = v1;
#pragma unroll
    for (int k = 0; k < 2; ++k) { const int row = (lane >> 3) + 8 * k; const u32x4 w = *(const LAS u32x4*)(stg + row * STG_PITCH + (lane & 7) * 16);
        const int prow = ((row & ((1 << ld) - 1)) << (12 - ld)) + (row >> ld); *(u32x4*)(g0 + (size_t)prow * 64 + (lane & 7) * 8) = w; }
}

struct SchedProj { int G, c;
    __device__ __forceinline__ bool next(int i, pg8::Unit& u) const { int pm, pn; if (!pg8::tile_order(T / 256, INW / 256, G, c, i, pm, pn)) return false; u.pm = pm; u.pn = pn; u.ka = HC_H; u.kb = 0; u.nt = 16; u.kind = pn; return true; } };
struct EpiProj { bf16* proj; const float* rope; const unsigned long long* rstd;
    __device__ __forceinline__ void operator()(const AccT& acc, const pg8::Unit& u, int wr, int wc, int, int) const { const int l_ = lane_id(), fr = l_ & 15, fq = l_ >> 4;
        const int pn = u.pn, wid = wr * 4 + wc; const bool dorope = pn < 6; const float sc = (pn < 3 || pn == 9 || pn == 10) ? C2 : 1.f;
        const float sc_ = sc; float rsv[2][4];
        EPI_FOR_AM rsv[ai][m] = 1.f;
        if (rstd) { unsigned long long sq8[2][4];
            EPI_FOR_AM sq8[ai][m] = rstd[EPI_ROW(u, ai, m)];
            EPI_FOR_AM rsv[ai][m] = __builtin_amdgcn_rsqf(ssq_val(sq8[ai][m]) * (1.f / D) + EPS); }
        EPI_FOR_AM { const int row = EPI_ROW(u, ai, m); u32x4 pk[2]; const float sc = sc_ * rsv[ai][m];
#pragma unroll
            for (int bj = 0; bj < 2; ++bj) { f32x4 cs0 = (f32x4){1.f, 0.f, 1.f, 0.f}, cs1 = cs0;
                if (dorope) { const f32x4* rp = (const f32x4*)(rope + ((size_t)row * 32 + 16 * bj + 4 * fq) * 2); cs0 = rp[0]; cs1 = rp[1]; }
                const f32x4 a0 = acc[ai][bj][m][0], a1 = acc[ai][bj][m][1]; f32x4 o0, o1;
                o0[0] = (a0[0] * cs0[0] - a0[1] * cs0[1]) * sc; o0[1] = (a0[1] * cs0[0] + a0[0] * cs0[1]) * sc;
                o0[2] = (a0[2] * cs0[2] - a0[3] * cs0[3]) * sc; o0[3] = (a0[3] * cs0[2] + a0[2] * cs0[3]) * sc;
                o1[0] = (a1[0] * cs1[0] - a1[1] * cs1[1]) * sc; o1[1] = (a1[1] * cs1[0] + a1[0] * cs1[1]) * sc;
                o1[2] = (a1[2] * cs1[2] - a1[3] * cs1[3]) * sc; o1[3] = (a1[3] * cs1[2] + a1[2] * cs1[3]) * sc;
                pk[bj] = pack8(o0, o1); }
            const int t0 = EPI_ROW0(u, ai, m);
            if (pn < 15) { const int ld = pn < 9 ? 2 * (pn % 3) : 0, s0 = t0 & (SEQ - 1);
                store_rows16_perm(pk[0], pk[1], proj + PJ_HM(pn * 4 + wc, (t0 - s0) + (s0 >> ld)), ld, wid, l_); }
            else store_rows16(pk[0], pk[1], proj + PJ_UC + (size_t)t0 * 512 + (pn - 15) * 256 + wc * 64, 512, wid, l_); }
    } };

struct SchedG4 { int G, c;
    __device__ __forceinline__ bool next(int i, pg8::Unit& u) const { const int ti = i / 6, sub = i - ti * 6, b = sub >> 1; int pm, pn; if (!pg8::tile_order(T / 256, 4, G, c, ti, pm, pn)) return false;
        u.pm = pm; u.pn = pn; u.kind = sub;
        if (!(sub & 1)) { u.ka = HC_H; u.kb = b * 1024; u.nt = 16; } else { u.ka = b == 0 ? HC_OA : b == 1 ? HC_OB : HC_PL; u.kb = 3072 + (b == 0 ? 0 : b == 1 ? 256 : 768); u.nt = b == 0 ? 4 : 8; }
        return true; } };
struct EpiG4 { bf16* gt; bf16* mg; const float* bias; const unsigned long long* rstd;
    __device__ __forceinline__ void operator()(const AccT& acc, const pg8::Unit& u, int wr, int wc, int, int) const { const int l_ = lane_id(), fr = l_ & 15, fq = l_ >> 4;
        const int b = u.kind >> 1, wid = wr * 4 + wc, colw = u.pn * 256 + wc * 64, colb = colw + 8 * fq;
        if (!(u.kind & 1)) {
            f32x4 bv[2][2];
#pragma unroll
            for (int bj = 0; bj < 2; ++bj) { bv[bj][0] = *(const f32x4*)(bias + b * 1024 + colb + bj * 32) * NEG_LOG2E; bv[bj][1] = *(const f32x4*)(bias + b * 1024 + colb + bj * 32 + 4) * NEG_LOG2E; }
            float rsv[2][4];
            EPI_FOR_AM rsv[ai][m] = 1.f;
            if (rstd) { unsigned long long sq8[2][4];
                EPI_FOR_AM sq8[ai][m] = rstd[EPI_ROW(u, ai, m)];
                EPI_FOR_AM rsv[ai][m] = __builtin_amdgcn_rsqf(ssq_val(sq8[ai][m]) * (1.f / D) + EPS); }
            EPI_FOR_AM { u32x4 pk[2]; const float rs = rsv[ai][m];
#pragma unroll
                for (int bj = 0; bj < 2; ++bj) { f32x4 v0 = acc[ai][bj][m][0] * rs + bv[bj][0], v1 = acc[ai][bj][m][1] * rs + bv[bj][1];
#pragma unroll
                    for (int e = 0; e < 4; ++e) { v0[e] = sigmoid_pre(v0[e]); v1[e] = sigmoid_pre(v1[e]); }
                    pk[bj] = pack8(v0, v1); }
                store_rows16(pk[0], pk[1], gt + (size_t)EPI_ROW0(u, ai, m) * D + colw, D, wid, l_); }
        } else {
            u32x4 gvb[2][2][2], pvb[2][2][2];
#define G4_LOAD(batch, buf) do { _Pragma("unroll") for (int mm = 0; mm < 2; ++mm) { const size_t off = (size_t)EPI_ROW(u, (batch) >> 1, ((batch) & 1) * 2 + mm) * D + colb; \
                _Pragma("unroll") for (int bj = 0; bj < 2; ++bj) { gvb[buf][mm][bj] = *(const u32x4*)(gt + off + bj * 32); if (b > 0) pvb[buf][mm][bj] = *(const u32x4*)(mg + off + bj * 32); } } } while (0)
            G4_LOAD(0, 0);
#pragma unroll
            for (int batch = 0; batch < 4; ++batch) { const int ai = batch >> 1, buf = batch & 1;
                if (batch < 3) G4_LOAD(batch + 1, (batch + 1) & 1);
#pragma unroll
                for (int mm = 0; mm < 2; ++mm) { const int m = (batch & 1) * 2 + mm; u32x4 pk[2];
#pragma unroll
                    for (int bj = 0; bj < 2; ++bj) { f32x4 g0, g1; unpack8(gvb[buf][mm][bj], g0, g1);
                        f32x4 v0 = acc[ai][bj][m][0] * g0, v1 = acc[ai][bj][m][1] * g1;
                        if (b > 0) { f32x4 p0, p1; unpack8(pvb[buf][mm][bj], p0, p1); v0 += p0; v1 += p1; }
                        pk[bj] = pack8(v0, v1); }
                    store_rows16(pk[0], pk[1], mg + (size_t)EPI_ROW0(u, ai, m) * D + colw, D, wid, l_); }
            }
#undef G4_LOAD
        }
    } };

struct SchedG5 { int G, c;
    __device__ __forceinline__ bool next(int i, pg8::Unit& u) const { int pm, pn; if (!pg8::tile_order(T / 256, 4, G, c, i, pm, pn)) return false; u.pm = pm; u.pn = pn; u.ka = 0; u.kb = 0; u.nt = 16; u.kind = 0; return true; } };
template <bool XF32> struct EpiG5 { const void* x; bf16* xb; int xpitch;
    __device__ __forceinline__ void operator()(const AccT& acc, const pg8::Unit& u, int wr, int wc, int, int) const { const int l_ = lane_id(), fr = l_ & 15, fq = l_ >> 4;
        const int wid = wr * 4 + wc, colw = u.pn * 256 + wc * 64, colb = colw + 8 * fq;
        f32x4 xv[2][2][2][2]; u32x4 xr[2][2][2];
#define G5_LOAD(batch, buf) do { _Pragma("unroll") for (int mm = 0; mm < 2; ++mm) { const size_t off = (size_t)EPI_ROW(u, (batch) >> 1, ((batch) & 1) * 2 + mm) * xpitch + colb; \
            _Pragma("unroll") for (int bj = 0; bj < 2; ++bj) { \
                if (XF32) { xv[buf][mm][bj][0] = *(const f32x4*)((const float*)x + off + bj * 32); xv[buf][mm][bj][1] = *(const f32x4*)((const float*)x + off + bj * 32 + 4); } \
                else xr[buf][mm][bj] = *(const u32x4*)((const bf16*)x + off + bj * 32); } } } while (0)
        G5_LOAD(0, 0);
#pragma unroll
        for (int batch = 0; batch < 4; ++batch) { const int ai = batch >> 1, buf = batch & 1;
            if (batch < 3) G5_LOAD(batch + 1, (batch + 1) & 1);
#pragma unroll
            for (int mm = 0; mm < 2; ++mm) { const int m = (batch & 1) * 2 + mm;
                if (!XF32) { unpack8(xr[buf][mm][0], xv[buf][mm][0][0], xv[buf][mm][0][1]); unpack8(xr[buf][mm][1], xv[buf][mm][1][0], xv[buf][mm][1][1]); }
                store_rows16(pack8(xv[buf][mm][0][0] + acc[ai][0][m][0], xv[buf][mm][0][1] + acc[ai][0][m][1]), pack8(xv[buf][mm][1][0] + acc[ai][1][m][0], xv[buf][mm][1][1] + acc[ai][1][m][1]),
                             xb + (size_t)EPI_ROW0(u, ai, m) * D + colw, D, wid, l_); }
        }
#undef G5_LOAD
    } };

struct SchedPle { int G, c;
    __device__ __forceinline__ bool next(int i, pg8::Unit& u) const { int pm, pn; if (!pg8::tile_order(T / 256, 4, G, c, i, pm, pn)) return false;
        u.pm = pm; u.pn = pn; u.kind = 0; u.ka = 0; u.kb = 0; u.nt = 16; return true; } };
struct EpiPle { const bf16* pin; const bf16* xin_; bf16* xout; int xpitch; const float* rstd; unsigned long long* ssq;
    __device__ __forceinline__ void operator()(const AccT& acc, const pg8::Unit& u, int wr, int wc, int, int) const { const int l_ = lane_id(), fr = l_ & 15, fq = l_ >> 4;
        const int wid = wr * 4 + wc, colw = u.pn * 256 + wc * 64, colb = colw + 8 * fq;
        float rsv[2][4];
        EPI_FOR_AM rsv[ai][m] = rstd[EPI_ROW(u, ai, m)];
        u32x4 pva[2][2], xwa[2][2];
#define PLE_LOAD(g, buf) do { const size_t off = (size_t)EPI_ROW(u, (g) >> 2, (g) & 3) * D + colb; \
            pva[buf][0] = *(const u32x4*)(pin + off); pva[buf][1] = *(const u32x4*)(pin + off + 32); xwa[buf][0] = *(const u32x4*)(xin_ + off); xwa[buf][1] = *(const u32x4*)(xin_ + off + 32); } while (0)
        PLE_LOAD(0, 0);
#pragma unroll
        for (int g = 0; g < 8; ++g) { const int ai = g >> 2, m = g & 3, buf = g & 1; const float rs = rsv[ai][m]; f32x4 r[2][2];
            if (g < 7) PLE_LOAD(g + 1, (g + 1) & 1);
#pragma unroll
            for (int bj = 0; bj < 2; ++bj) { f32x4 g0 = acc[ai][bj][m][0] * rs, g1 = acc[ai][bj][m][1] * rs, p0, p1, x0, x1;
#pragma unroll
                for (int e = 0; e < 4; ++e) { g0[e] = sigmoid_pre(g0[e]); g1[e] = sigmoid_pre(g1[e]); }
                unpack8(pva[buf][bj], p0, p1); unpack8(xwa[buf][bj], x0, x1); r[bj][0] = x0 + p0 * g0; r[bj][1] = x1 + p1 * g1; }
            if (ssq) { const f32x4 q = r[0][0] * r[0][0] + r[0][1] * r[0][1] + r[1][0] * r[1][0] + r[1][1] * r[1][1]; float ps = (q[0] + q[1]) + (q[2] + q[3]); ps += __shfl_xor(ps, 16); ps += __shfl_xor(ps, 32);
                if (l_ < 16) atomicAdd(ssq + EPI_ROW(u, ai, m), ssq_fix(ps)); }
            store_rows16(pack8(r[0][0], r[0][1]), pack8(r[1][0], r[1][1]), xout + (size_t)EPI_ROW0(u, ai, m) * xpitch + colw, xpitch, wid, l_); }
#undef PLE_LOAD
    } };
struct SchedPin { int stride, c2;
    __device__ __forceinline__ bool next(int i, pg8::Unit& u) const { const int ti = c2 + i * stride; if (c2 < 0 || ti >= (T / 256) * 4) return false; u.pm = ti >> 2; u.pn = ti & 3; u.kind = 0; u.ka = 0; u.kb = 1024; u.nt = 4; return true; } };
struct EpiPin { bf16* pin;
    __device__ __forceinline__ void operator()(const AccT& acc, const pg8::Unit& u, int wr, int wc, int, int) const { const int l_ = lane_id();
        const int wid = wr * 4 + wc, colw = u.pn * 256 + wc * 64;
        EPI_FOR_AM store_rows16(pack8(acc[ai][0][m][0], acc[ai][0][m][1]), pack8(acc[ai][1][m][0], acc[ai][1][m][1]), pin + (size_t)EPI_ROW0(u, ai, m) * D + colw, D, wid, l_);
    } };

constexpr int LDS_TILE_OFF = 132096;
struct SchedM1 { int G, c; const LAS int* tile;
    __device__ __forceinline__ bool next(int i, pg8::Unit& u) const { const int nt_ = __builtin_amdgcn_readfirstlane(tile[0]); const int nrem = 2 * nt_ - i * G; if (c >= nrem) return false; const long L = (long)i * G + xcd_remap(c, nrem < G ? nrem : G); const int rt = (int)(L >> 1), hh = (int)(L & 1);
        u.pm = rt; u.pn = __builtin_amdgcn_readfirstlane(tile[1 + rt]) * 2 + hh; u.ka = 0; u.kb = 0; u.nt = 16; u.kind = hh; return true; } };
struct EpiM1 { bf16* hid; const float* wrow;
    __device__ __forceinline__ void operator()(const AccT& acc, const pg8::Unit& u, int wr, int wc, int, int) const { const int l_ = lane_id(), fr = l_ & 15, fq = l_ >> 4;
        const int colb = u.kind * 128 + wc * 32 + 8 * fq;
        f32x2 wv[2][4];
        EPI_FOR_AM wv[ai][m] = *(const f32x2*)(wrow + 2 * (size_t)EPI_ROW(u, ai, m));
        EPI_FOR_AM { const int row = EPI_ROW(u, ai, m); const float w = wv[ai][m][0], rs = wv[ai][m][1]; f32x4 v0, v1;
#pragma unroll
            for (int e = 0; e < 4; ++e) { const float g0 = acc[ai][0][m][0][e] * rs, g1 = acc[ai][0][m][1][e] * rs;
                v0[e] = g0 * fast_sigmoid(g0) * acc[ai][1][m][0][e] * w; v1[e] = g1 * fast_sigmoid(g1) * acc[ai][1][m][1][e] * w; }
            *(u32x4*)(hid + (size_t)row * EXP_H + colb) = pack8(v0, v1); }
    } };
struct SchedM2 { int G, c; const LAS int* tile;
    __device__ __forceinline__ bool next(int i, pg8::Unit& u) const { const int nt_ = __builtin_amdgcn_readfirstlane(tile[0]); const int nrem = 4 * nt_ - i * G; if (c >= nrem) return false; const long L = (long)i * G + xcd_remap(c, nrem < G ? nrem : G); const int rt = (int)(L >> 2), ct = (int)(L & 3);
        u.pm = rt; u.pn = __builtin_amdgcn_readfirstlane(tile[1 + rt]) * 4 + ct; u.ka = 0; u.kb = 0; u.nt = 4; u.kind = ct; return true; } };
struct EpiM2 { bf16* y2;
    __device__ __forceinline__ void operator()(const AccT& acc, const pg8::Unit& u, int wr, int wc, int, int) const { const int l_ = lane_id(), fr = l_ & 15, fq = l_ >> 4;
        const int wid = wr * 4 + wc, colw = u.kind * 256 + wc * 64;
        EPI_FOR_AM store_rows16(pack8(acc[ai][0][m][0], acc[ai][0][m][1]), pack8(acc[ai][1][m][0], acc[ai][1][m][1]), y2 + (size_t)EPI_ROW0(u, ai, m) * D + colw, D, wid, l_);
    } };

struct RmId { __device__ __forceinline__ int operator()(int n) const { return n; } };
struct RmRope { __device__ __forceinline__ int operator()(int n) const { const int hl = n & 63; return n < 1536 ? (n & ~63) + (hl < 32 ? 2 * hl : 2 * (hl - 32) + 1) : n; } };
struct RmGU { int base; __device__ __forceinline__ int operator()(int n) const { const int f = n & 127; return base + (n >> 7) * 256 + 64 * (f >> 5) + (f & 31); } };
template <class RM>
__device__ __forceinline__ void tr_matrix(const float* W, int ldw, int K_, int N_, bf16* dst, int ldt, int kdst0, RM rm, LAS float* scr, int gw, int NGW, int lane, int& base, float wscale = 1.f, const float* kscale = nullptr) {
    const int nb = N_ / 32, cnt = (K_ / 64) * nb;
    f32x4 v[8], vn[8]; float ks[8], ksn[8];
#define TR_LOAD(it_, V, KS) do { const int k0_ = ((it_) / nb) * 64, n0_ = ((it_) % nb) * 32; _Pragma("unroll") for (int j = 0; j < 8; ++j) { \
        V[j] = *(const f32x4*)(W + (size_t)(k0_ + j * 8 + (lane >> 3)) * ldw + n0_ + (lane & 7) * 4); KS[j] = kscale ? kscale[k0_ + j * 8 + (lane >> 3)] : 1.f; } } while (0)
    int it = ((gw - base) % NGW + NGW) % NGW;
    if (it < cnt) TR_LOAD(it, v, ks);
#pragma unroll 1
    for (; it < cnt; it += NGW) {
        const int k0 = (it / nb) * 64, n0 = (it % nb) * 32;
#pragma unroll
        for (int j = 0; j < 8; ++j) { LAS float* d_ = scr + (j * 8 + (lane >> 3)) * 33 + (lane & 7) * 4; const f32x4 w_ = v[j] * (ks[j] * wscale); d_[0] = w_[0]; d_[1] = w_[1]; d_[2] = w_[2]; d_[3] = w_[3]; }
        if (it + NGW < cnt) TR_LOAD(it + NGW, vn, ksn);
        LDS_WAIT(); asm volatile("" ::: "memory");
        const int c = lane & 7;
#pragma unroll
        for (int j = 0; j < 4; ++j) { const int n = (lane >> 3) + 8 * j; const LAS float* s = scr + (8 * c) * 33 + n;
            u32x4 o; o.x = pk2(s[0 * 33], s[1 * 33]); o.y = pk2(s[2 * 33], s[3 * 33]); o.z = pk2(s[4 * 33], s[5 * 33]); o.w = pk2(s[6 * 33], s[7 * 33]);
            *(u32x4*)(dst + (size_t)rm(n0 + n) * ldt + kdst0 + k0 + 8 * c) = o; }
        LDS_WAIT(); asm volatile("" ::: "memory");
#pragma unroll
        for (int j = 0; j < 8; ++j) { v[j] = vn[j]; ks[j] = ksn[j]; }
    }
#undef TR_LOAD
    base += cnt;
}
template <int PART> __device__ __forceinline__ void wconv_part(const Frame& F, int layer, int gw, int NGW) {
    LAS float* scr = (LAS float*)F.lds + F.wave * (64 * 33);
    bf16* W = (bf16*)(F.ws + WS_W); int base = 0;
#define SRC(idx, per_layer) ((const float*)arg_ptr<idx>() + (size_t)layer * (per_layer))
    if (PART == 0) { tr_matrix(SRC(I_W_IN, (size_t)D * INW), INW, D, INW, W + WO_IN, D, 0, RmRope{}, scr, gw, NGW, F.lane, base, 1.f, SRC(I_NORM_MIX, D)); return; }
    if (PART == 1) for (int b = 0; b < 3; ++b) tr_matrix(SRC(I_W_GATE, (size_t)D * NGATE) + b * 1024, NGATE, D, 1024, W + WO_BCAT, BCAT_LD, b * 1024, RmId{}, scr, gw, NGW, F.lane, base, NEG_LOG2E, SRC(I_NORM_MIX, D));
    if (PART == 1) { tr_matrix(SRC(I_W_UP_A, (size_t)256 * D), D, 256, D, W + WO_BCAT, BCAT_LD, 3072, RmId{}, scr, gw, NGW, F.lane, base);
    tr_matrix(SRC(I_W_UP_B, (size_t)512 * D), D, 512, D, W + WO_BCAT, BCAT_LD, 3328, RmId{}, scr, gw, NGW, F.lane, base);
    tr_matrix(SRC(I_W_OUT, (size_t)D * D), D, D, D, W + WO_OUT, D, 0, RmId{}, scr, gw, NGW, F.lane, base);
    tr_matrix(SRC(I_W_PLE_IN, (size_t)PLE_DIM * D), D, PLE_DIM, D, W + WO_PLE, PLE_LD, 1024, RmId{}, scr, gw, NGW, F.lane, base); }
    if (PART == 2) {
        for (int e = 0; e < NEXP; ++e) tr_matrix(SRC(I_W_ED, (size_t)NEXP * EXP_H * D) + (size_t)e * EXP_H * D, D, EXP_H, D, W + WO_M2 + (size_t)e * D * EXP_H, EXP_H, 0, RmId{}, scr, gw, NGW, F.lane, base);
        tr_matrix(SRC(I_W_PLE_GATE, (size_t)D * D), D, D, D, W + WO_PLE, PLE_LD, 0, RmId{}, scr, gw, NGW, F.lane, base, NEG_LOG2E, SRC(I_NORM_PLE, D));
        return;
    }
    for (int e = 0; e < NEXP; ++e) {
        tr_matrix(SRC(I_W_EG, (size_t)NEXP * D * EXP_H) + (size_t)e * D * EXP_H, EXP_H, D, EXP_H, W + WO_M1, D, 0, RmGU{e * 512}, scr, gw, NGW, F.lane, base, 1.f, SRC(I_NORM_MOE, D));
        tr_matrix(SRC(I_W_EU, (size_t)NEXP * D * EXP_H) + (size_t)e * D * EXP_H, EXP_H, D, EXP_H, W + WO_M1, D, 0, RmGU{e * 512 + 32}, scr, gw, NGW, F.lane, base, 1.f, SRC(I_NORM_MOE, D));
    }
    {
        const float* wp = SRC(I_W_POOL, (size_t)4 * 128 * 128); const float* ps = SRC(I_POOL_SCALE, 512); const float* wc = SRC(I_W_UP_C, (size_t)512 * D);
        for (int it = ((gw - base) % NGW + NGW) % NGW; it < 1024; it += NGW) {
            const int kc = it >> 4, n = (it & 15) * 64 + F.lane, g = kc >> 4, kl0 = (kc & 15) * 8;
            const float ps0 = ps[g * 128 + F.lane], ps1 = ps[g * 128 + 64 + F.lane];
            float al[8], ah[8], a[8];
#pragma unroll
            for (int q = 0; q < 8; ++q) { al[q] = wp[(size_t)(g * 128 + kl0 + q) * 128 + F.lane] * ps0; ah[q] = wp[(size_t)(g * 128 + kl0 + q) * 128 + 64 + F.lane] * ps1; a[q] = 0.f; }
            float bv[16], bvn[16];
#pragma unroll
            for (int j = 0; j < 16; ++j) bv[j] = wc[(size_t)(g * 128 + j) * D + n];
#pragma unroll 1
            for (int d0 = 0; d0 < 128; d0 += 16) {
                if (d0 + 16 < 128) {
#pragma unroll
                    for (int j = 0; j < 16; ++j) bvn[j] = wc[(size_t)(g * 128 + d0 + 16 + j) * D + n]; }
#pragma unroll
                for (int j = 0; j < 16; ++j)
#pragma unroll
                    for (int q = 0; q < 8; ++q) { const float av = __builtin_bit_cast(float, __builtin_amdgcn_readlane(__builtin_bit_cast(int, d0 < 64 ? al[q] : ah[q]), (d0 + j) & 63)); a[q] += av * bv[j]; }
#pragma unroll
                for (int j = 0; j < 16; ++j) bv[j] = bvn[j];
            }
            u32x4 o; o.x = pk2(a[0], a[1]); o.y = pk2(a[2], a[3]); o.z = pk2(a[4], a[5]); o.w = pk2(a[6], a[7]);
            *(u32x4*)(W + WO_BCAT + (size_t)n * BCAT_LD + 3840 + kc * 8) = o;
        }
    }
#undef SRC
}
__device__ __forceinline__ void ph_wconv(const Frame& F0, int layer) { PHASE_FRAME(F0);
    wconv_part<0>(F, layer, F.wg * NWAVES + F.wave, F.G * NWAVES);
}
__device__ __forceinline__ void ph_ropetab(const Frame& F0) { PHASE_FRAME(F0);
    float* rope = (float*)(F.ws + WS_ROPE); const int* pos = (const int*)arg_ptr<I_POS>();
    const int step = F.G * NTHREADS, i0 = F.wg * NTHREADS + F.tid;
    for (int ib = i0; ib < T * 32; ib += 4 * step) {
        int pv[4];
#pragma unroll
        for (int k = 0; k < 4; ++k) { const int i = ib + k * step; pv[k] = i < T * 32 ? pos[i >> 5] : 0; }
#pragma unroll
        for (int k = 0; k < 4; ++k) { const int i = ib + k * step; if (i < T * 32) { const int j = i & 31;
            const float inv = exp2f(-(float)j * (13.287712379549449f / 32.0f)); const float ang = (float)pv[k] * inv;
            double rev = (double)ang * 0.15915494309189535; rev -= floor(rev); const float fr = (float)rev;
            *(f32x2*)(rope + (size_t)i * 2) = (f32x2){__builtin_amdgcn_cosf(fr), __builtin_amdgcn_sinf(fr)}; } }
    }
}

__device__ __forceinline__ void ph_proj_fast(const Frame& F0, int layer) { PHASE_FRAME(F0);
    const pg8::Gemm g{(const bf16*)(F.ws + WS_HCAT), HC, (const bf16*)(F.ws + WS_W) + WO_IN, D, nullptr};
    pg8::gemm_phase<EpiProj, SchedProj, true>((LAS unsigned char*)F.lds, g, SchedProj{F.G, F.wg}, EpiProj{(bf16*)(F.ws + WS_PROJ), (const float*)(F.ws + WS_ROPE), layer == 0 ? nullptr : (const unsigned long long*)(F.ws + SM_SSQ)}, F.tid);
    constexpr int NBUSY = (T / 256) * (INW / 256) - 4 * 256;
    if (F.G == 256 && F.wg >= NBUSY) wconv_part<1>(F, layer, (F.wg - NBUSY) * NWAVES + F.wave, (F.G - NBUSY) * NWAVES);
    else if (F.G != 256) wconv_part<1>(F, layer, F.wg * NWAVES + F.wave, F.G * NWAVES);
}
__device__ __forceinline__ void ph_g4_fast(const Frame& F0, int layer) { PHASE_FRAME(F0);
    const pg8::Gemm g{(const bf16*)(F.ws + WS_HCAT), HC, (const bf16*)(F.ws + WS_W) + WO_BCAT, BCAT_LD, nullptr};
    pg8::gemm_phase<EpiG4, SchedG4, true>((LAS unsigned char*)F.lds, g, SchedG4{F.G, F.wg}, EpiG4{(bf16*)(F.ws + OV_GT), (bf16*)(F.ws + OV_MERGED), (const float*)arg_ptr<I_B_GATE>() + layer * NGATE, layer == 0 ? nullptr : (const unsigned long long*)(F.ws + SM_SSQ)}, F.tid);
}
__device__ __forceinline__ void ph_g5_fast(const Frame& F0, int layer) { PHASE_FRAME(F0);
    const pg8::Gemm g{(const bf16*)(F.ws + OV_MERGED), D, (const bf16*)(F.ws + WS_W) + WO_OUT, D, nullptr};
    if (layer == 0) pg8::gemm_phase<EpiG5<true>, SchedG5, true>((LAS unsigned char*)F.lds, g, SchedG5{F.G, F.wg}, EpiG5<true>{arg_ptr<I_X>(), (bf16*)F.out, D}, F.tid);
    else pg8::gemm_phase<EpiG5<false>, SchedG5, true>((LAS unsigned char*)F.lds, g, SchedG5{F.G, F.wg}, EpiG5<false>{(const void*)((const bf16*)(F.ws + WS_HCAT) + HC_H), (bf16*)F.out, HC}, F.tid);
}
__device__ __forceinline__ void ph_ple_fast(const Frame& F0, int layer) { PHASE_FRAME(F0);
    const pg8::Gemm g{(const bf16*)F.out, D, (const bf16*)(F.ws + WS_W) + WO_PLE, PLE_LD, nullptr};
    const bool last = layer == DEPTH - 1;
    pg8::gemm_phase<EpiPle, SchedPle, true>((LAS unsigned char*)F.lds, g, SchedPle{F.G, F.wg}, EpiPle{(const bf16*)(F.ws + OV_GT), (const bf16*)F.out, last ? (bf16*)(F.ws + OV_X3) : (bf16*)(F.ws + WS_HCAT) + HC_H, last ? D : HC,
        (const float*)(F.ws + SM_RSTD_PLE), last ? nullptr : (unsigned long long*)(F.ws + SM_SSQ)}, F.tid);
}
__device__ __forceinline__ void ph_m1_fast(const Frame& F0, int layer) { PHASE_FRAME(F0);
    const pg8::Gemm g{(const bf16*)F.out, D, (const bf16*)(F.ws + WS_W) + WO_M1, D, (const int*)(F.ws + SM_ROWTOK)};
    { const int* tg = (const int*)(F.ws + SM_TILE); LAS int* tl = (LAS int*)((LAS unsigned char*)F.lds + LDS_TILE_OFF); if (F.tid < 161) tl[F.tid] = tg[F.tid]; __syncthreads(); }
    pg8::gemm_phase<EpiM1, SchedM1, true, true>((LAS unsigned char*)F.lds, g, SchedM1{F.G, F.wg, (const LAS int*)((LAS unsigned char*)F.lds + LDS_TILE_OFF)}, EpiM1{(bf16*)(F.ws + OV_HID), (const float*)(F.ws + SM_WROW)}, F.tid);
    {   const pg8::Gemm gp{(const bf16*)F.out + (size_t)T * D, D, (const bf16*)(F.ws + WS_W) + WO_PLE, PLE_LD, nullptr};
        const bool std_ = F.G == 256;
        if (!std_ || F.wg >= 32) pg8::gemm_phase<EpiPin, SchedPin, true>((LAS unsigned char*)F.lds, gp, SchedPin{std_ ? F.G - 32 : F.G, std_ ? F.wg - 32 : F.wg}, EpiPin{(bf16*)(F.ws + OV_GT)}, F.tid); }
    if (F.G == 256 && F.wg >= 64) { wconv_part<2>(F, layer, (F.wg - 64) * NWAVES + F.wave, (F.G - 64) * NWAVES); if (layer + 1 < DEPTH) wconv_part<0>(F, layer + 1, (F.wg - 64) * NWAVES + F.wave, (F.G - 64) * NWAVES); }
    else if (F.G != 256) { wconv_part<2>(F, layer, F.wg * NWAVES + F.wave, F.G * NWAVES); if (layer + 1 < DEPTH) wconv_part<0>(F, layer + 1, F.wg * NWAVES + F.wave, F.G * NWAVES); }
}
__device__ __forceinline__ void ph_m2_fast(const Frame& F0) { PHASE_FRAME(F0);
    const pg8::Gemm g{(const bf16*)(F.ws + OV_HID), EXP_H, (const bf16*)(F.ws + WS_W) + WO_M2, EXP_H, nullptr};
    { const int* tg = (const int*)(F.ws + SM_TILE); LAS int* tl = (LAS int*)((LAS unsigned char*)F.lds + LDS_TILE_OFF); if (F.tid < 161) tl[F.tid] = tg[F.tid]; __syncthreads(); }
    pg8::gemm_phase<EpiM2, SchedM2, true>((LAS unsigned char*)F.lds, g, SchedM2{F.G, F.wg, (const LAS int*)((LAS unsigned char*)F.lds + LDS_TILE_OFF)}, EpiM2{(bf16*)(F.ws + OV_Y2)}, F.tid);
}

constexpr size_t SM_CHUNK = WS_SMALL + 720 * 1024;
__device__ __forceinline__ int wave_sum_i(int v) {
#pragma unroll
    for (int o = 1; o < 64; o <<= 1) v += __shfl_xor(v, o);
    return v;
}
__device__ __forceinline__ void ph_route2(const Frame& F0, int layer) { PHASE_FRAME(F0);
    const float* g = (const float*)arg_ptr<I_NORM_MOE>() + layer * D;
    const float* wrg = (const float*)arg_ptr<I_W_RG>() + (size_t)layer * D * 4; const float* brg = (const float*)arg_ptr<I_B_RG>() + layer * 4;
    const float* wre = (const float*)arg_ptr<I_W_RE>() + (size_t)layer * 4 * D * 4; const float* bre = (const float*)arg_ptr<I_B_RE>() + layer * 16;
    bf16* hmb = (bf16*)(F.ws + OV_HM); int* eid = (int*)(F.ws + SM_EID); float* wgt = (float*)(F.ws + SM_WGT); int* chunk = (int*)(F.ws + SM_CHUNK);
    {
        const float* p = (const float*)arg_ptr<I_P>() + (size_t)layer * T * PLE_DIM; bf16* pob = (bf16*)F.out + (size_t)T * D; f32x4 pv8[8];
#pragma unroll
        for (int q = 0; q < 8; ++q) pv8[q] = *(const f32x4*)(p + (size_t)(F.wg * 64 + F.wave * 8 + q) * PLE_DIM + F.lane * 4);
#pragma unroll
        for (int q = 0; q < 8; ++q) { u32x2 po; po.x = pk2(pv8[q][0], pv8[q][1]); po.y = pk2(pv8[q][2], pv8[q][3]); *(u32x2*)(pob + (size_t)(F.wg * 64 + F.wave * 8 + q) * D + F.lane * 4) = po; } }
    LAS float* Wl = (LAS float*)F.lds;
    LAS int* cnt = (LAS int*)(F.lds + 5 * 1024 * 4);
    const int tw0 = F.wg * 64 + F.wave * 8;
    unsigned xw[4][8]; f32x2 gk[8];
#pragma unroll
    for (int i = 0; i < 8; ++i) {
#pragma unroll
        for (int q = 0; q < 4; ++q) xw[q][i] = *(const unsigned*)((const bf16*)F.out + (size_t)(tw0 + q) * D + i * 128 + 2 * F.lane);
        gk[i] = *(const f32x2*)(g + i * 128 + 2 * F.lane); }
    for (int i = F.tid; i < 1024; i += NTHREADS) { *(LAS f32x4*)(Wl + (size_t)i * 4) = *(const f32x4*)(wrg + (size_t)i * 4);
#pragma unroll
        for (int gg = 0; gg < 4; ++gg) *(LAS f32x4*)(Wl + ((size_t)(1 + gg) * 1024 + i) * 4) = *(const f32x4*)(wre + ((size_t)gg * D + i) * 4); }
    if (F.tid < 16) cnt[F.tid] = 0;
    __syncthreads();
#pragma unroll 1
    for (int pass = 0; pass < 2; ++pass) {
        const int tk = tw0 + pass * 4;
        float a20[20];
#pragma unroll
        for (int i = 0; i < 20; ++i) a20[i] = 0.f;
#pragma unroll
        for (int i = 0; i < 8; ++i) { const int k = i * 128 + 2 * F.lane;
            const f32x4 w0 = *(const LAS f32x4*)(Wl + (size_t)k * 4), w1 = *(const LAS f32x4*)(Wl + (size_t)(k + 1) * 4);
#pragma unroll
            for (int q = 0; q < 4; ++q) { const float x0 = bflo(xw[q][i]), x1 = bfhi(xw[q][i]); a20[q * 5] += x0 * x0 + x1 * x1; const float y0 = x0 * gk[i][0], y1 = x1 * gk[i][1];
#pragma unroll
                for (int e = 0; e < 4; ++e) a20[q * 5 + 1 + e] += y0 * w0[e] + y1 * w1[e]; } }
        float u5[5];
        {   float w10[10];
#pragma unroll
            for (int i = 0; i < 10; ++i) { const float lo = a20[i], hi_ = a20[10 + i]; const bool up = (F.lane & 32) != 0; const float keep = up ? hi_ : lo, send = up ? lo : hi_; w10[i] = keep + __shfl_xor(send, 32); }
#pragma unroll
            for (int i = 0; i < 5; ++i) { const bool up = (F.lane & 16) != 0; const float keep = up ? w10[i + 5] : w10[i], send = up ? w10[i] : w10[i + 5]; u5[i] = keep + __shfl_xor(send, 16); } }
#pragma unroll
        for (int i = 0; i < 5; ++i) { float v = u5[i]; v += __shfl_xor(v, 8); v += __shfl_xor(v, 4); v += __shfl_xor(v, 2); v += __shfl_xor(v, 1); u5[i] = v; }
        const float rsq = 1.f / sqrtf(u5[0] * (1.f / D) + EPS);
        float lg[4];
#pragma unroll
        for (int e = 0; e < 4; ++e) lg[e] = u5[1 + e] * rsq + brg[e];
        int gi = 0; float mx = lg[0];
#pragma unroll
        for (int e = 1; e < 4; ++e) if (lg[e] > mx) { mx = lg[e]; gi = e; }
        float den = 0.f;
#pragma unroll
        for (int e = 0; e < 4; ++e) den += __expf(lg[e] - mx);
        const float p1 = 1.f / den;
        float rs[4]; int gq[4];
#pragma unroll
        for (int q = 0; q < 4; ++q) { rs[q] = __builtin_bit_cast(float, __builtin_amdgcn_readlane(__builtin_bit_cast(int, rsq), q * 16)); gq[q] = __builtin_amdgcn_readlane(gi, q * 16); }
        float a16[16];
#pragma unroll
        for (int i = 0; i < 16; ++i) a16[i] = 0.f;
#pragma unroll
        for (int i = 0; i < 8; ++i) { const int k = i * 128 + 2 * F.lane;
#pragma unroll
            for (int q = 0; q < 4; ++q) { const LAS float* wq = Wl + ((size_t)(1 + gq[q]) * 1024 + k) * 4; const f32x4 w0 = *(const LAS f32x4*)wq, w1 = *(const LAS f32x4*)(wq + 4);
                const float y0 = bflo(xw[q][i]) * gk[i][0], y1 = bfhi(xw[q][i]) * gk[i][1];
#pragma unroll
                for (int e = 0; e < 4; ++e) a16[q * 4 + e] += y0 * w0[e] + y1 * w1[e]; } }
        float u4[4];
        {   float w8[8];
#pragma unroll
            for (int i = 0; i < 8; ++i) { const float lo = a16[i], hi_ = a16[8 + i]; const bool up = (F.lane & 32) != 0; const float keep = up ? hi_ : lo, send = up ? lo : hi_; w8[i] = keep + __shfl_xor(send, 32); }
#pragma unroll
            for (int i = 0; i < 4; ++i) { const bool up = (F.lane & 16) != 0; const float keep = up ? w8[i + 4] : w8[i], send = up ? w8[i] : w8[i + 4]; u4[i] = keep + __shfl_xor(send, 16); } }
#pragma unroll
        for (int i = 0; i < 4; ++i) { float v = u4[i]; v += __shfl_xor(v, 8); v += __shfl_xor(v, 4); v += __shfl_xor(v, 2); v += __shfl_xor(v, 1); u4[i] = v; }
        if ((F.lane & 15) == 0) {
            const int q = F.lane >> 4;
            float ls[4];
#pragma unroll
            for (int e = 0; e < 4; ++e) ls[e] = u4[e] * rsq + bre[gi * 4 + e];
            int i0 = 0; float v0 = ls[0];
#pragma unroll
            for (int e = 1; e < 4; ++e) if (ls[e] > v0) { v0 = ls[e]; i0 = e; }
            int i1 = -1; float v1 = -3.0e38f;
#pragma unroll
            for (int e = 0; e < 4; ++e) if (e != i0 && ls[e] > v1) { v1 = ls[e]; i1 = e; }
            const float ex = __expf(v1 - v0), w0_ = p1 / (1.f + ex), w1_ = p1 * ex / (1.f + ex);
            const int t = tk + q, ea = gi * 4 + i0, eb = gi * 4 + i1;
            eid[t * 2 + 0] = ea; eid[t * 2 + 1] = eb; wgt[t * 2 + 0] = w0_; wgt[t * 2 + 1] = w1_; ((float*)(F.ws + SM_RSTD_MOE))[t] = rsq;
            __hip_atomic_fetch_add(&cnt[ea], 1, __ATOMIC_RELAXED, __HIP_MEMORY_SCOPE_WORKGROUP); __hip_atomic_fetch_add(&cnt[eb], 1, __ATOMIC_RELAXED, __HIP_MEMORY_SCOPE_WORKGROUP);
        }
        if (pass == 0) {
#pragma unroll
            for (int i = 0; i < 8; ++i)
#pragma unroll
                for (int q = 0; q < 4; ++q) xw[q][i] = *(const unsigned*)((const bf16*)F.out + (size_t)(tw0 + 4 + q) * D + i * 128 + 2 * F.lane); }
    }
    __syncthreads();
    if (F.tid < 16) chunk[F.wg * 16 + F.tid] = cnt[F.tid];
}
__device__ __forceinline__ void ph_scatter2(const Frame& F0) { PHASE_FRAME(F0);
    const int* eid = (const int*)(F.ws + SM_EID); const float* wgt = (const float*)(F.ws + SM_WGT); const int* chunk = (const int*)(F.ws + SM_CHUNK);
    int* rowtok = (int*)(F.ws + SM_ROWTOK); float* wrow = (float*)(F.ws + SM_WROW); int* tile = (int*)(F.ws + SM_TILE);
    LAS int* L = (LAS int*)F.lds;
    const int t0 = F.wg * 64;
    int e0 = 0, e1 = 0; float wg0 = 0.f, wg1 = 0.f, r0 = 0.f, r1 = 0.f;
    if (F.wave == 0) { const float* rstd = (const float*)(F.ws + SM_RSTD_MOE); e0 = eid[t0 * 2 + F.lane]; e1 = eid[t0 * 2 + 64 + F.lane]; wg0 = wgt[t0 * 2 + F.lane]; wg1 = wgt[t0 * 2 + 64 + F.lane]; r0 = rstd[t0 + (F.lane >> 1)]; r1 = rstd[t0 + 32 + (F.lane >> 1)]; }
#pragma unroll
    for (int ee = 0; ee < 2; ++ee) { const int e = 2 * F.wave + ee; int ts = 0, ps = 0;
        for (int ch = F.lane; ch < F.G; ch += 64) { const int v = chunk[ch * 16 + e]; ts += v; ps += (ch < F.wg) ? v : 0; }
        ts = wave_sum_i(ts); ps = wave_sum_i(ps);
        if (F.lane == 0) { L[e] = ts; L[16 + e] = ps; } }
    __syncthreads();
    if (F.tid == 0) { int b = 0;
        for (int e = 0; e < NEXP; ++e) { L[32 + e] = b; const int ntl = (L[e] + 255) >> 8; if (F.wg == 0) for (int q = 0; q < ntl; ++q) tile[1 + (b >> 8) + q] = e; b += ntl << 8; }
        if (F.wg == 0) tile[0] = b >> 8; }
    __syncthreads();
    if (F.wave == 0) {
        int p0 = 0, p1 = 0;
        const unsigned long long below = (1ull << F.lane) - 1ull;
#pragma unroll
        for (int e = 0; e < NEXP; ++e) { const unsigned long long b0 = __ballot(e0 == e), b1 = __ballot(e1 == e);
            if (e0 == e) p0 = __popcll(b0 & below); if (e1 == e) p1 = __popcll(b0) + __popcll(b1 & below); }
        const int s0 = L[32 + e0] + L[16 + e0] + p0, s1 = L[32 + e1] + L[16 + e1] + p1;
        L[64 + F.lane] = s0; L[128 + F.lane] = s1;
        ((int*)(F.ws + SM_SLOT2))[t0 * 2 + F.lane] = s0; ((int*)(F.ws + SM_SLOT2))[t0 * 2 + 64 + F.lane] = s1;
        rowtok[s0] = t0 + (F.lane >> 1); *(f32x2*)(wrow + 2 * (size_t)s0) = (f32x2){wg0 * r0, r0}; rowtok[s1] = t0 + 32 + (F.lane >> 1); *(f32x2*)(wrow + 2 * (size_t)s1) = (f32x2){wg1 * r1, r1};
    }
    __syncthreads();
    for (int e = F.wg; e < NEXP; e += F.G) { const int b = L[32 + e], n = L[e], np = ((n + 255) >> 8) << 8; for (int s = n + F.tid; s < np; s += NTHREADS) { rowtok[b + s] = 0; *(f32x2*)(wrow + 2 * (size_t)(b + s)) = (f32x2){0.f, 0.f}; } }
}
__device__ __forceinline__ void ph_e_fast(const Frame& F0, int layer) { PHASE_FRAME(F0);
    const bf16* y2 = (const bf16*)(F.ws + OV_Y2); const int* slot2 = (const int*)(F.ws + SM_SLOT2);
    u32x2 xw[2][4], ya[2][4], yb[2][4], xwn[2][4], yan[2][4], ybn[2][4];
#define E_LOAD(t0_, XW, YA, YB) do { _Pragma("unroll") for (int r = 0; r < 2; ++r) { const size_t t = (size_t)(t0_) + r; \
        const size_t sa = (size_t)__builtin_amdgcn_readfirstlane(slot2[t * 2]), sb = (size_t)__builtin_amdgcn_readfirstlane(slot2[t * 2 + 1]); \
        _Pragma("unroll") for (int j = 0; j < 4; ++j) { const int k = j * 256 + F.lane * 4; XW[r][j] = *(const u32x2*)((const bf16*)F.out + t * D + k); YA[r][j] = *(const u32x2*)(y2 + sa * D + k); YB[r][j] = *(const u32x2*)(y2 + sb * D + k); } } } while (0)
    const int tstep = F.G * NWAVES * 2; int t0 = (F.wg * NWAVES + F.wave) * 2;
    if (t0 < T) E_LOAD(t0, xw, ya, yb);
#pragma unroll 1
    for (; t0 < T; t0 += tstep) {
        const bool has_next = t0 + tstep < T;
        if (has_next) E_LOAD(t0 + tstep, xwn, yan, ybn);
#pragma unroll
        for (int r = 0; r < 2; ++r) { const size_t t = t0 + r; float s = 0.f; f32x4 xv[4];
#pragma unroll
            for (int j = 0; j < 4; ++j) { f32x4 v = (f32x4){bflo(xw[r][j].x), bfhi(xw[r][j].x), bflo(xw[r][j].y), bfhi(xw[r][j].y)};
                v[0] += bflo(ya[r][j].x) + bflo(yb[r][j].x); v[1] += bfhi(ya[r][j].x) + bfhi(yb[r][j].x); v[2] += bflo(ya[r][j].y) + bflo(yb[r][j].y); v[3] += bfhi(ya[r][j].y) + bfhi(yb[r][j].y);
                xv[j] = v; s += (v[0] * v[0] + v[1] * v[1]) + (v[2] * v[2] + v[3] * v[3]); u32x2 xo; xo.x = pk2(v[0], v[1]); xo.y = pk2(v[2], v[3]); *(u32x2*)((bf16*)F.out + t * D + j * 256 + F.lane * 4) = xo; }
            const float rr = 1.f / sqrtf(wave_sum(s) * (1.f / D) + EPS);
            if (F.lane == 0) { ((float*)(F.ws + SM_RSTD_PLE))[t] = rr;
                if (layer + 1 < DEPTH) ((unsigned long long*)(F.ws + SM_SSQ))[t] = 0ull; }
        }
        if (has_next) {
#pragma unroll
            for (int r = 0; r < 2; ++r) {
#pragma unroll
                for (int j = 0; j < 4; ++j) { xw[r][j] = xwn[r][j]; ya[r][j] = yan[r][j]; yb[r][j] = ybn[r][j]; } } }
    }
#undef E_LOAD
}


typedef float f32x16 __attribute__((ext_vector_type(16)));
typedef short s16x4 __attribute__((ext_vector_type(4)));
#define MFMA32(a, b, c) __builtin_amdgcn_mfma_f32_32x32x16_bf16((a), (b), (c), 0, 0, 0)
constexpr int AT_K = 0, AT_V = 49152, AT_OST = 98304, AT_FLAG = 131072;
constexpr float NEG_BIG = -1.0e30f;
#ifndef SB_EARLY_EXIT
#define SB_EARLY_EXIT 1
#endif
constexpr float SB_EXIT_THR = 160.0f;

__device__ __forceinline__ int crow(int r, int hi) { return (r & 3) + 8 * (r >> 2) + 4 * hi; }
template <int S> __device__ __forceinline__ bf16x8 pack_step(const f32x16& x) {
    u32x4 p; p.x = cvt_pk_bf16(x[8 * S], x[8 * S + 1]); p.y = cvt_pk_bf16(x[8 * S + 2], x[8 * S + 3]); p.z = cvt_pk_bf16(x[8 * S + 4], x[8 * S + 5]); p.w = cvt_pk_bf16(x[8 * S + 6], x[8 * S + 7]);
    return __builtin_bit_cast(bf16x8, p); }
__device__ __forceinline__ void glds16(const void* gsrc, LAS unsigned char* dst) { __builtin_amdgcn_global_load_lds((const unsigned*)gsrc, (LAS unsigned*)dst, 16, 0, 0); }
typedef short v4i16_t __attribute__((ext_vector_type(4)));
__device__ __forceinline__ s16x4 vtr(const LAS unsigned char* p) { return __builtin_bit_cast(s16x4, __builtin_amdgcn_ds_read_tr16_b64_v4i16((LAS v4i16_t*)p)); }
#define AT_WAITBAR() asm volatile("s_waitcnt vmcnt(0) lgkmcnt(0)\n\ts_barrier" ::: "memory")

__device__ __forceinline__ void at_qkt(f32x16& p0, f32x16& p1, const LAS unsigned char* kt, const bf16x8 (&qr)[4], int r32, int hi) {
    const LAS unsigned char* kb = kt + r32 * 128; const int x = r32 & 7;
    const f32x16 zero = {0.f, 0.f, 0.f, 0.f, 0.f, 0.f, 0.f, 0.f, 0.f, 0.f, 0.f, 0.f, 0.f, 0.f, 0.f, 0.f};
#pragma unroll
    for (int d0 = 0; d0 < 4; ++d0) { const int off = ((2 * d0 + hi) ^ x) * 16; const bf16x8 b0 = *(const LAS bf16x8*)(kb + off), b1 = *(const LAS bf16x8*)(kb + 4096 + off);
        p0 = MFMA32(b0, qr[d0], d0 == 0 ? zero : p0); p1 = MFMA32(b1, qr[d0], d0 == 0 ? zero : p1); }
}
__device__ __forceinline__ void at_pv(f32x16& o0, f32x16& o1, const LAS unsigned char* vt, int lane, int hi, bf16x8 pa0, bf16x8 pa1, bf16x8 pa2, bf16x8 pa3) {
    const LAS unsigned char* vp = vt + ((lane >> 4) & 1) * 32 + (lane & 3) * 8 + (4 * hi + ((lane & 15) >> 2)) * 64;
#define AT_VF(off) ({ const s16x4 lo_ = vtr(vp + (off)), hi_ = vtr(vp + (off) + 512); (bf16x8){lo_[0], lo_[1], lo_[2], lo_[3], hi_[0], hi_[1], hi_[2], hi_[3]}; })
    o0 = MFMA32(pa0, AT_VF(0), o0);    o0 = MFMA32(pa1, AT_VF(1024), o0); o0 = MFMA32(pa2, AT_VF(2048), o0); o0 = MFMA32(pa3, AT_VF(3072), o0);
    o1 = MFMA32(pa0, AT_VF(4096), o1); o1 = MFMA32(pa1, AT_VF(5120), o1); o1 = MFMA32(pa2, AT_VF(6144), o1); o1 = MFMA32(pa3, AT_VF(7168), o1);
#undef AT_VF
}
template <class RowPtr>
__device__ __forceinline__ void at_store_o(const f32x16& o0, const f32x16& o1, const float (&sc)[16], LAS unsigned char* lds, int wid, int lane, RowPtr rowptr) {
    const int r32 = lane & 31, hi = lane >> 5; LAS bf16* stg = (LAS bf16*)(lds + AT_OST + wid * 4096);
#pragma unroll
    for (int r = 0; r < 16; ++r) { const int orow = crow(r, hi); const unsigned pk = cvt_pk_bf16(o0[r] * sc[r], o1[r] * sc[r]); stg[orow * 64 + r32] = (bf16)(pk & 0xffffu); stg[orow * 64 + 32 + r32] = (bf16)(pk >> 16); }
    LDS_WAIT();
#pragma unroll
    for (int i = 0; i < 4; ++i) { const int row = i * 8 + (lane >> 3), ch = lane & 7; const u32x4 v = *(const LAS u32x4*)(stg + row * 64 + ch * 8); *(u32x4*)(rowptr(row) + ch * 8) = v; }
}

struct SbRow { bf16* base; __device__ __forceinline__ bf16* operator()(int row) const { return base + (size_t)row * HC; } };
__device__ __forceinline__ void sb_unit(const Frame& F, int b, int h, int qb, const bf16* proj, bf16* hc) {
    LAS unsigned char* lds = (LAS unsigned char*)lds_raw;
    const int lane = F.lane, r32 = lane & 31, hi = lane >> 5, wid = F.wave;
    const size_t rowbase = (size_t)b * SEQ; const int q0 = qb * 256;
    const bf16* Qw = proj + PJ_HM(36 + h, rowbase + q0 + wid * 32);
    const bf16* ksrc = proj + PJ_HM(44 + h, rowbase + 8 * wid + (lane >> 3)) + (((lane & 7) ^ ((lane >> 3) & 7)) * 8);
    const bf16* vsrc = proj + PJ_HM(52 + h, rowbase + 16 * (wid & 3) + (lane >> 2)) + (wid >> 2) * 32 + (lane & 3) * 8;
#define SB_DMA(t, slot) do { glds16(ksrc + (size_t)(t) * 64 * 64, lds + AT_K + (slot) * 8192 + wid * 1024); glds16(vsrc + (size_t)(t) * 64 * 64, lds + AT_V + (slot) * 8192 + wid * 1024); } while (0)
    bf16x8 qr[4];
#pragma unroll
    for (int d0 = 0; d0 < 4; ++d0) qr[d0] = *(const bf16x8*)(Qw + (size_t)r32 * 64 + d0 * 16 + hi * 8);
    bf16x8 tri0, tri1, ones;
#pragma unroll
    for (int j = 0; j < 8; ++j) { const int k0 = 8 * (j >> 2) + 4 * hi + (j & 3); tri0[j] = (k0 >= r32) ? (short)0x3F80 : (short)0; tri1[j] = (16 + k0 >= r32) ? (short)0x3F80 : (short)0; ones[j] = (short)0x3F80; }
    const int NT = 4 * (qb + 1), jd = 4 * qb + (wid >> 1), qpos = q0 + wid * 32 + r32;
    f32x16 o0, o1;
#pragma unroll
    for (int r = 0; r < 16; ++r) { o0[r] = 0.f; o1[r] = 0.f; }
    float carry = 0.f;
    SB_DMA(NT - 1, 0); AT_WAITBAR();
    int cur = 0; bool wdone = false;
    for (int t = NT - 1; t >= 0; --t) {
        if (t > 0) SB_DMA(t - 1, cur ^ 1);
        if (t <= jd && !wdone) {
            f32x16 z0, z1;
            at_qkt(z0, z1, lds + AT_K + cur * 8192, qr, r32, hi);
            if (t == jd) { const int kb_ = 64 * t + 4 * hi;
#pragma unroll
                for (int r = 0; r < 16; ++r) { const int kv = kb_ + (r & 3) + 8 * (r >> 2); if (kv >= qpos) z0[r] = NEG_BIG; if (kv + 32 >= qpos) z1[r] = NEG_BIG; } }
            f32x16 s0, s1;
#pragma unroll
            for (int r = 0; r < 16; ++r) { z0[r] = __builtin_amdgcn_fmed3f(z0[r], 126.f, -3.0e38f); z1[r] = __builtin_amdgcn_fmed3f(z1[r], 126.f, -3.0e38f);
                s0[r] = __builtin_amdgcn_logf(1.f + __builtin_amdgcn_exp2f(z0[r])); s1[r] = __builtin_amdgcn_logf(1.f + __builtin_amdgcn_exp2f(z1[r])); }
            const bf16x8 x0a = pack_step<0>(s0), x0b = pack_step<1>(s0), x1a = pack_step<0>(s1), x1b = pack_step<1>(s1);
            f32x16 T1, y1, y0;
#pragma unroll
            for (int r = 0; r < 16; ++r) { T1[r] = carry; y1[r] = carry - z1[r]; }
            T1 = MFMA32(ones, x1a, T1); T1 = MFMA32(ones, x1b, T1);
            y1 = MFMA32(tri0, x1a, y1); y1 = MFMA32(tri1, x1b, y1);
#pragma unroll
            for (int r = 0; r < 16; ++r) y0[r] = T1[r] - z0[r];
            y0 = MFMA32(tri0, x0a, y0); y0 = MFMA32(tri1, x0b, y0);
            T1 = MFMA32(ones, x0a, T1); T1 = MFMA32(ones, x0b, T1); carry = T1[0];
#pragma unroll
            for (int r = 0; r < 16; ++r) { y0[r] = __builtin_amdgcn_exp2f(-y0[r]); y1[r] = __builtin_amdgcn_exp2f(-y1[r]); }
            at_pv(o0, o1, lds + AT_V + cur * 8192, lane, hi, pack_step<0>(y0), pack_step<1>(y0), pack_step<0>(y1), pack_step<1>(y1));
        }
        if (SB_EARLY_EXIT) { wdone = __all(carry > SB_EXIT_THR) != 0; if (lane == 0) ((LAS int*)(lds + AT_FLAG))[(t & 1) * 8 + wid] = wdone ? 1 : 0; }
        AT_WAITBAR();
        if (SB_EARLY_EXIT) { const LAS int* fl = (const LAS int*)(lds + AT_FLAG) + (t & 1) * 8; const int all = fl[0] & fl[1] & fl[2] & fl[3] & fl[4] & fl[5] & fl[6] & fl[7];
            if (__builtin_amdgcn_readfirstlane(all)) break; }
        cur ^= 1;
    }
#undef SB_DMA
    float one[16];
#pragma unroll
    for (int r = 0; r < 16; ++r) one[r] = 1.f;
    at_store_o(o0, o1, one, lds, wid, lane, SbRow{hc + (rowbase + q0 + wid * 32) * HC + HC_OB + h * 64});
    AT_WAITBAR();
}
__device__ __forceinline__ void ph_sb_fast(const Frame& F0) { PHASE_FRAME(F0);
    const bf16* proj = (const bf16*)(F.ws + WS_PROJ); bf16* hc = (bf16*)(F.ws + WS_HCAT);
    for (int idx0 = F.wg; idx0 < 256; idx0 += F.G) { const int idx = F.G == 256 ? xcd_remap(idx0, 256) : idx0, bh = idx >> 3, s = idx & 7;
        sb_unit(F, bh >> 3, bh & 7, 15 - s, proj, hc); sb_unit(F, bh >> 3, bh & 7, s, proj, hc); }
}

struct DilRow { bf16* base; size_t stride; __device__ __forceinline__ bf16* operator()(int row) const { return base + (size_t)row * stride; } };
struct DilUnit { int b, gj, res, blk, d, l0; size_t rowbase, prow; };
__device__ __forceinline__ DilUnit dil_decode(int u) { DilUnit U; const int x = u & 15, bgj = u >> 4; U.gj = bgj % 12; U.b = bgj / 12; const int g = U.gj >> 2;
    U.res = g == 0 ? 0 : (g == 1 ? (x >> 2) : x); U.blk = g == 0 ? x : (g == 1 ? (x & 3) : 0); U.d = (g == 0) ? 1 : (g == 1 ? 4 : 16); U.l0 = U.blk * 256; U.rowbase = (size_t)U.b * SEQ; U.prow = U.rowbase + (size_t)U.res * (SEQ / U.d); return U; }
__device__ __forceinline__ void dil_issue_k(const DilUnit& U, const bf16* proj, LAS unsigned char* lds, int wid, int lane) {
#pragma unroll 1
    for (int tile = 0; tile < 6; ++tile) { int lk = U.l0 - 128 + tile * 64 + 8 * wid + (lane >> 3); lk = lk < 0 ? 0 : lk;
        glds16(proj + PJ_HM(12 + U.gj, U.prow + lk) + (((lane & 7) ^ ((lane >> 3) & 7)) * 8), lds + AT_K + tile * 8192 + wid * 1024); } }
__device__ __forceinline__ void dil_issue_v(const DilUnit& U, const bf16* proj, LAS unsigned char* lds, int wid, int lane) {
#pragma unroll 1
    for (int tile = 0; tile < 6; ++tile) { int lv = U.l0 - 128 + tile * 64 + 16 * (wid & 3) + (lane >> 2); lv = lv < 0 ? 0 : lv;
        glds16(proj + PJ_HM(24 + U.gj, U.prow + lv) + (wid >> 2) * 32 + (lane & 3) * 8, lds + AT_V + tile * 8192 + wid * 1024); } }
__device__ __forceinline__ void dil_load_q(const DilUnit& U, const bf16* proj, bf16x8 (&q)[4], int wid, int r32, int hi) {
    const bf16* qp = proj + PJ_HM(U.gj, U.prow + U.l0 + 32 * wid + r32);
#pragma unroll
    for (int d0 = 0; d0 < 4; ++d0) q[d0] = *(const bf16x8*)(qp + d0 * 16 + hi * 8); }
#define AT_BAR() asm volatile("s_waitcnt lgkmcnt(0)\n\ts_barrier" ::: "memory")
__device__ __forceinline__ void ph_dil_fast(const Frame& F0) { PHASE_FRAME(F0);
    bf16* proj = (bf16*)(F.ws + WS_PROJ); float* lse = (float*)(F.ws + WS_LSE);
    LAS unsigned char* lds = (LAS unsigned char*)lds_raw;
    const int lane = F.lane, r32 = lane & 31, hi = lane >> 5, wid = F.wave;
    const int NU = BATCH * 12 * 16;
    if (F.wg >= NU) return;
    const int c_ = F.G == 256 ? xcd_remap(F.wg, 256) : F.wg;
    DilUnit U = dil_decode(c_);
    bf16x8 qr[4], qn[4];
    dil_load_q(U, proj, qr, wid, r32, hi);
    asm volatile("s_waitcnt vmcnt(0)" : "+v"(qr[0]), "+v"(qr[1]), "+v"(qr[2]), "+v"(qr[3]) :: "memory");
    dil_issue_k(U, proj, lds, wid, lane); dil_issue_v(U, proj, lds, wid, lane);
#pragma unroll 1
    for (int u = c_; u < NU; u += F.G) {
        const bool has_next = u + F.G < NU; DilUnit UN = U;
        asm volatile("s_waitcnt vmcnt(6)" ::: "memory"); AT_BAR();
        if (has_next) { UN = dil_decode(u + F.G); dil_load_q(UN, proj, qn, wid, r32, hi); }
        const int l0 = U.l0, qloc = 32 * wid + r32, tb = wid >> 1, kmin = (128 - l0) > qloc ? (128 - l0) : qloc, kmax = qloc + 128;
        f32x16 za[3], zb[3]; float m = NEG_BIG;
#pragma unroll
        for (int ti = 0; ti < 3; ++ti) {
            at_qkt(za[ti], zb[ti], lds + AT_K + (tb + ti) * 8192, qr, r32, hi);
            const int thr_lo = kmin - 64 * (tb + ti) - 4 * hi, thr_hi = kmax - 64 * (tb + ti) - 4 * hi;
            if (ti == 0 || l0 == 0) {
#pragma unroll
                for (int r = 0; r < 16; ++r) { const int C = (r & 3) + 8 * (r >> 2); za[ti][r] = (C >= thr_lo) ? za[ti][r] : NEG_BIG; zb[ti][r] = (C + 32 >= thr_lo) ? zb[ti][r] : NEG_BIG; } }
            if (ti == 2) {
#pragma unroll
                for (int r = 0; r < 16; ++r) { const int C = (r & 3) + 8 * (r >> 2); za[ti][r] = (C <= thr_hi) ? za[ti][r] : NEG_BIG; zb[ti][r] = (C + 32 <= thr_hi) ? zb[ti][r] : NEG_BIG; } }
#pragma unroll
            for (int r = 0; r < 16; r += 2) m = fmaxf(fmaxf(m, fmaxf(za[ti][r], zb[ti][r])), fmaxf(za[ti][r + 1], zb[ti][r + 1]));
        }
        AT_BAR();
        asm volatile("s_waitcnt vmcnt(0)" : "+v"(qn[0]), "+v"(qn[1]), "+v"(qn[2]), "+v"(qn[3]) :: "memory");
        if (has_next) dil_issue_k(UN, proj, lds, wid, lane);
        m = fmaxf(m, __shfl_xor(m, 32));
        float l = 0.f;
#pragma unroll
        for (int ti = 0; ti < 3; ++ti)
#pragma unroll
            for (int r = 0; r < 16; ++r) { za[ti][r] = __builtin_amdgcn_exp2f(za[ti][r] - m); zb[ti][r] = __builtin_amdgcn_exp2f(zb[ti][r] - m); l += za[ti][r] + zb[ti][r]; }
        l += __shfl_xor(l, 32);
        AT_BAR();
        f32x16 o0, o1;
#pragma unroll
        for (int r = 0; r < 16; ++r) { o0[r] = 0.f; o1[r] = 0.f; }
#pragma unroll
        for (int ti = 0; ti < 3; ++ti) at_pv(o0, o1, lds + AT_V + (tb + ti) * 8192, lane, hi, pack_step<0>(za[ti]), pack_step<1>(za[ti]), pack_step<0>(zb[ti]), pack_step<1>(zb[ti]));
        AT_BAR();
        const size_t qrow = U.rowbase + (size_t)(l0 + qloc) * U.d + U.res;
        LAS float* lsc = (LAS float*)(lds + AT_OST + wid * 4096);
        if (hi == 0) { lsc[r32] = 1.f / l; lse[qrow * 12 + U.gj] = m + __builtin_amdgcn_logf(l); }
        LDS_WAIT();
        float sc[16];
#pragma unroll
        for (int r = 0; r < 16; ++r) sc[r] = lsc[crow(r, hi)];
        LDS_WAIT();
        at_store_o(o0, o1, sc, lds, wid, lane, DilRow{proj + PJ_HM(U.gj, U.prow + l0 + 32 * wid), (size_t)64});
        if (has_next) { dil_issue_v(UN, proj, lds, wid, lane);
#pragma unroll
            for (int d0 = 0; d0 < 4; ++d0) qr[d0] = qn[d0]; U = UN; }
    }
    AT_WAITBAR();
}
template <int W> __device__ __forceinline__ void pool_item(const bf16* uc, bf16* hc, int t0, int s0, int c) {
    unsigned uv[32 + W - 1];
#pragma unroll
    for (int k = 0; k < 32 + W - 1; ++k) { const int dt = k - (W - 1); uv[k] = (s0 + dt >= 0) ? *(const unsigned*)(uc + (size_t)(t0 + dt) * 512 + c) : 0u; }
    float sa = 0.f, sb = 0.f;
#pragma unroll
    for (int k = 0; k < W - 1; ++k) { sa += bflo(uv[k]); sb += bfhi(uv[k]); }
#pragma unroll
    for (int tt = 0; tt < 32; ++tt) { const int s = s0 + tt; const unsigned u = uv[tt + W - 1]; const float ua = bflo(u), ub = bfhi(u);
        sa += ua; sb += ub;
        const float rc = 1.f / (float)((s + 1 < W) ? s + 1 : W);
        *(unsigned*)(hc + (size_t)(t0 + tt) * HC + HC_PL + c) = pk2(sa * rc - ua, sb * rc - ub);
        sa -= bflo(uv[tt]); sb -= bfhi(uv[tt]); }
}
__device__ __forceinline__ void ph_pool_fast(const Frame& F0) { PHASE_FRAME(F0);
    const bf16* uc = (const bf16*)(F.ws + WS_PROJ) + PJ_UC; bf16* hc = (bf16*)(F.ws + WS_HCAT);
    for (int i = F.wg * NTHREADS + F.tid; i < (T / 32) * 256; i += F.G * NTHREADS) {
        const int cp = i & 255, chunk = i >> 8, c = cp * 2, g = __builtin_amdgcn_readfirstlane(c >> 7), t0 = chunk * 32, s0 = t0 % SEQ;
        if (g == 0) pool_item<2>(uc, hc, t0, s0, c); else if (g == 1) pool_item<4>(uc, hc, t0, s0, c); else if (g == 2) pool_item<8>(uc, hc, t0, s0, c); else pool_item<16>(uc, hc, t0, s0, c);
    }
}

typedef __attribute__((address_space(1))) unsigned gu32;
#define RLX_AGENT __ATOMIC_RELAXED, __HIP_MEMORY_SCOPE_AGENT
#define XB_TMO      128
#define XB_XCNT(j)  (256  + 64 * (j))
#define XB_XSUB(j)  (1280 + 64 * (j))
#define XB_XGEN(j)  (2304 + 64 * (j))
#define XB_TOP      3328
#define XB_TOPGEN   3392
#define XCD_BAR_WORDS 3456
#define XB_SPIN_CAP (1u << 18)
__device__ __forceinline__ unsigned xb_ld(unsigned* p)              { return __hip_atomic_load(p, __ATOMIC_RELAXED, __HIP_MEMORY_SCOPE_AGENT); }
__device__ __forceinline__ unsigned xb_add(unsigned* p, unsigned v) { return __hip_atomic_fetch_add(p, v, __ATOMIC_RELAXED, __HIP_MEMORY_SCOPE_AGENT); }
__device__ __forceinline__ unsigned xb_xcc_id() { return (unsigned)__builtin_amdgcn_s_getreg((3 << 11) | 20) & 0xFu; }
#define XB_SPIN(cond, bar) do { unsigned _sp = 0; while (cond) { __builtin_amdgcn_s_sleep(1); \
    if ((++_sp & 255u) == 0u) { if (xb_ld(&(bar)[XB_TMO])) break; if (_sp > XB_SPIN_CAP) { atomicAdd(&(bar)[XB_TMO], 1u); break; } } } } while (0)
struct XcdBarrier { unsigned* bar; unsigned x; volatile LAS unsigned* st; };
__device__ __forceinline__ XcdBarrier xcd_barrier_post(unsigned* bar, volatile LAS unsigned* st, bool t0) {
    XcdBarrier b; b.bar = bar; b.x = xb_xcc_id(); b.st = st;
    if (t0) (void)xb_add(&bar[XB_XCNT(b.x)], 1u);
    return b;
}
__device__ __forceinline__ void xcd_barrier_complete(unsigned* bar, unsigned x, unsigned& nloc, unsigned& nx) {
    const unsigned G = gridDim.x * gridDim.y * gridDim.z;
    unsigned sum, cnt, mine, sp = 0u;
    for (;;) {
        sum = 0u; cnt = 0u; mine = 0u;
#pragma unroll
        for (unsigned j = 0; j < 16; ++j) { const unsigned c = xb_ld(&bar[XB_XCNT(j)]); sum += c; cnt += (c > 0u) ? 1u : 0u; mine = (j == x) ? c : mine; }
        if (sum == G) break;
        __builtin_amdgcn_s_sleep(1);
        if ((++sp & 255u) == 0u) { if (xb_ld(&bar[XB_TMO])) break; if (sp > XB_SPIN_CAP) { atomicAdd(&bar[XB_TMO], 1u); break; } }
    }
    nloc = mine > 0u ? mine : 1u; nx = cnt > 0u ? cnt : 1u;
}
__device__ __forceinline__ void xcd_barrier(const XcdBarrier& b, bool t0) {
    asm volatile("s_waitcnt vmcnt(0)" ::: "memory");
    __syncthreads();
    if (t0) {
        unsigned* bar = b.bar;
        __builtin_amdgcn_s_waitcnt(0);
        unsigned nloc = b.st[0], nx = b.st[1];
        if (nloc == 0u) { xcd_barrier_complete(bar, b.x, nloc, nx); b.st[0] = nloc; b.st[1] = nx; }
        const unsigned old = xb_add(&bar[XB_XSUB(b.x)], 1u);
        const unsigned gen = old / nloc;
        if (old + 1u == (gen + 1u) * nloc) {
            __builtin_amdgcn_fence(__ATOMIC_RELEASE, "agent");
            asm volatile("s_waitcnt vmcnt(0)" ::: "memory");
            const unsigned og = xb_add(&bar[XB_TOP], 1u);
            const unsigned tg = og / nx;
            if (og + 1u == (tg + 1u) * nx) xb_add(&bar[XB_TOPGEN], 1u);
            else XB_SPIN(xb_ld(&bar[XB_TOPGEN]) == tg, bar);
            __builtin_amdgcn_fence(__ATOMIC_ACQUIRE, "agent");
            xb_add(&bar[XB_XGEN(b.x)], 1u);
            asm volatile("s_waitcnt vmcnt(0)" ::: "memory");
        } else {
            XB_SPIN(xb_ld(&bar[XB_XGEN(b.x)]) == gen, bar);
            __builtin_amdgcn_fence(__ATOMIC_ACQUIRE, "agent");
            asm volatile("s_waitcnt vmcnt(0)" ::: "memory");
        }
    }
    __syncthreads();
}

#define USE_FAST_DIL 1
#define USE_FAST_SB 1
#define USE_FAST_POOL 1
constexpr int LDS_BYTES = 163840, MISC_OFF = 131072 + 320;
constexpr int CW_BAR = 4096;

__global__ void __launch_bounds__(NTHREADS, 2) mega(Args args) {
    Frame F{}; F.wave = __builtin_amdgcn_readfirstlane((int)threadIdx.x >> 6);
    volatile LAS unsigned* MISC = (volatile LAS unsigned*)((LAS unsigned char*)lds_raw + MISC_OFF);
    if (threadIdx.x < 32) MISC[threadIdx.x] = 0u;
    __syncthreads();
    (void)xcd_barrier_post((unsigned*)((unsigned char*)arg_ptr<26>() + WS_CTL) + CW_BAR, MISC + 8, threadIdx.x == 0);
#define GRID_BAR() do { XcdBarrier b_; b_.bar = (unsigned*)((unsigned char*)arg_ptr<26>() + WS_CTL) + CW_BAR; b_.x = xb_xcc_id(); b_.st = MISC + 8; xcd_barrier(b_, F.wave == 0 && lane_id() == 0); } while (0)
#define LAYER_PROGRAM(layer) do { \
        if (layer == 0) { ph_wconv(F, layer); ph_norm1(F, layer); ph_ropetab(F); \
        GRID_BAR(); } \
        ph_proj_fast(F, layer); \
        GRID_BAR(); \
        if (USE_FAST_DIL) ph_dil_fast(F); else ph_dil_naive(F); if (USE_FAST_SB) ph_sb_fast(F); else ph_sb_naive(F); if (USE_FAST_POOL) ph_pool_fast(F); else ph_pool_naive(F); \
        GRID_BAR(); \
        ph_comb_naive(F, layer); \
        GRID_BAR(); \
        ph_g4_fast(F, layer); \
        GRID_BAR(); \
        ph_g5_fast(F, layer); \
        GRID_BAR(); \
        ph_route2(F, layer); \
        GRID_BAR(); \
        ph_scatter2(F); \
        GRID_BAR(); \
        ph_m1_fast(F, layer); \
        GRID_BAR(); \
        ph_m2_fast(F); \
        GRID_BAR(); \
        ph_e_fast(F, layer); \
        GRID_BAR(); \
        ph_ple_fast(F, layer); \
        GRID_BAR(); \
     \
    } while (0)
    LAYER_PROGRAM(0);
    LAYER_PROGRAM(1);
    ph_final(F);
}

extern "C" void kernel_launch(void* const* d_in, const int* in_sizes, int n_in, void* d_out, int out_size, void* d_ws, size_t ws_size, hipStream_t stream) {
    static int grid = 0;
    if (grid == 0) {
        if (n_in != N_IN || out_size != T * D || ws_size < WS_END) { fprintf(stderr, "kernel_launch: unexpected shapes n_in %d out %d ws %zu\n", n_in, out_size, ws_size); grid = -1; return; }
        int dev = 0, cus = 0, per_cu = 0;
        (void)hipGetDevice(&dev); (void)hipDeviceGetAttribute(&cus, hipDeviceAttributeMultiprocessorCount, dev);
        if (hipFuncSetAttribute((const void*)mega, hipFuncAttributeMaxDynamicSharedMemorySize, LDS_BYTES) != hipSuccess) { fprintf(stderr, "kernel_launch: hipFuncSetAttribute failed\n"); grid = -1; return; }
        if (hipOccupancyMaxActiveBlocksPerMultiprocessor(&per_cu, (const void*)mega, NTHREADS, LDS_BYTES) != hipSuccess || per_cu < 1) { fprintf(stderr, "kernel_launch: occupancy query says %d blocks per CU\n", per_cu); grid = -1; return; }
        (void)hipGetLastError();
        if (cus < 256) { fprintf(stderr, "kernel_launch: needs >= 256 CUs\n"); grid = -1; return; }
        grid = 256;
    }
    if (grid < 0) return;
    (void)hipMemsetAsync((char*)d_ws + WS_CTL, 0, 32 * 1024, stream);
    Args a{};
    for (int i = 0; i < N_IN; ++i) a.in[i] = d_in[i];
    a.out = (float*)d_out; a.ws = (unsigned char*)d_ws;
    void* kargs[] = {&a};
    hipError_t e = hipLaunchCooperativeKernel((const void*)mega, dim3(grid), dim3(NTHREADS), kargs, LDS_BYTES, stream);
    if (e != hipSuccess) fprintf(stderr, "kernel_launch: cooperative launch failed: %s (grid %d)\n", hipGetErrorString(e), grid);
}
```

```cpp
#include <hip/hip_runtime.h>
#include <cstdio>
#include <cstdint>

constexpr int BATCH = 4, SEQ = 4096, T = BATCH * SEQ, D = 1024, DEPTH = 2;
constexpr int INW = 4352, C_QA = 0, C_KA = 768, C_VA = 1536, C_QB = 2304, C_KB = 2816, C_VB = 3328, C_UC = 3840;
#define PJ_HM(ch, row) (((size_t)(ch) * T + (size_t)(row)) * 64)
constexpr size_t PJ_UC = (size_t)60 * 16384 * 64;
constexpr int HC = 2304, HC_H = 0, HC_OA = 1024, HC_OB = 1280, HC_PL = 1792;
constexpr int NGATE = 3072, PLE_DIM = 256, EXP_H = 256, NEXP = 16;
constexpr float EPS = 1e-6f;
constexpr float C2 = 0.125f * 1.4426950408889634f;
constexpr int NTHREADS = 512, NWAVES = 8;

enum { I_X = 0, I_P, I_POS, I_NORM_MIX, I_W_IN, I_W_GATE, I_B_GATE, I_W_POOL, I_POOL_SCALE, I_W_UP_A, I_W_UP_B, I_W_UP_C, I_W_OUT, I_NORM_MOE,
       I_W_RG, I_B_RG, I_W_RE, I_B_RE, I_W_EG, I_W_EU, I_W_ED, I_NORM_PLE, I_W_PLE_IN, I_W_PLE_GATE, I_NORM_FINAL, N_IN };

constexpr size_t MiB = 1u << 20;
constexpr size_t WS_CTL = 0;
constexpr size_t WS_SMALL = 1 * MiB;
constexpr size_t WS_HCAT = 2 * MiB;
constexpr size_t WS_PROJ = 74 * MiB;
constexpr size_t WS_W = 210 * MiB;
constexpr size_t WS_ROPE = 256 * MiB;
constexpr size_t WS_LSE = 260 * MiB;
constexpr size_t WS_YCPRE = 262 * MiB;
constexpr size_t WS_END = 278 * MiB;
constexpr size_t OV_X3 = WS_PROJ + 32 * MiB;
constexpr size_t OV_GATES = WS_PROJ, OV_MERGED = WS_PROJ + 96 * MiB, OV_PLEG = WS_PROJ + 96 * MiB;
constexpr size_t SM_EID = WS_SMALL, SM_WGT = WS_SMALL + 128 * 1024;
constexpr size_t SM_RSTD_MOE = WS_LSE + 1 * MiB, SM_RSTD_PLE = SM_RSTD_MOE + 64 * 1024;
constexpr size_t SM_SSQ = WS_LSE + 2 * MiB;
__device__ __forceinline__ unsigned long long ssq_fix(float ps) { ps = __builtin_amdgcn_fmed3f(ps, 0.f, 2.0e9f); const unsigned hi = (unsigned)ps; const unsigned lo = (unsigned)((ps - (float)hi) * 4294967296.f); return ((unsigned long long)hi << 32) | lo; }
__device__ __forceinline__ float ssq_val(unsigned long long v) { return (float)(unsigned)(v >> 32) + (float)(unsigned)v * 2.3283064365386963e-10f; }

typedef unsigned short bf16;
typedef float f32x4 __attribute__((ext_vector_type(4)));
typedef unsigned u32x2 __attribute__((ext_vector_type(2)));
typedef unsigned u32x4 __attribute__((ext_vector_type(4)));

__device__ __forceinline__ unsigned f2bf(float f) { unsigned u = __builtin_bit_cast(unsigned, f); return (u + 0x7fffu + ((u >> 16) & 1u)) >> 16; }
__device__ __forceinline__ float bf2f(unsigned h) { return __builtin_bit_cast(float, h << 16); }
__device__ __forceinline__ unsigned pk2(float lo, float hi) { return f2bf(lo) | (f2bf(hi) << 16); }
__device__ __forceinline__ float bflo(unsigned w) { return __builtin_bit_cast(float, w << 16); }
__device__ __forceinline__ float bfhi(unsigned w) { return __builtin_bit_cast(float, w & 0xffff0000u); }
__device__ __forceinline__ float wave_sum(float v) {
#pragma unroll
    for (int o = 1; o < 64; o <<= 1) v += __shfl_xor(v, o);
    return v;
}
__device__ __forceinline__ float sigmoidf_(float x) { return 1.f / (1.f + __expf(-x)); }

struct Args { const void* in[N_IN]; float* out; unsigned char* ws; int ph_lo, ph_hi; };

struct Frame {
    int tid, lane, wave, wg, G;
    float* out; unsigned char* ws;
    float* lds;
};
extern __shared__ __attribute__((aligned(16))) unsigned char lds_raw[];
template <int I> __device__ __forceinline__ const void* arg_ptr() {
    const void* p; asm volatile("s_load_dwordx2 %0, %1, %2\n\ts_waitcnt lgkmcnt(0)" : "=s"(p) : "s"(__builtin_amdgcn_kernarg_segment_ptr()), "i"(I * 8) : "memory"); return p; }
static_assert(N_IN == 25, "Args layout: in[25] at 0, out at 200, ws at 208");

__device__ __forceinline__ int lane_id() { int l; asm volatile("v_mbcnt_lo_u32_b32 %0, -1, 0\n\tv_mbcnt_hi_u32_b32 %0, -1, %0" : "=v"(l)); return l; }
#define PHASE_FRAME(F0) Frame F; F.wave = (F0).wave; asm volatile("" : "+s"(F.wave)); F.lane = lane_id(); asm volatile("" : "+v"(F.lane)); F.tid = F.wave * 64 + F.lane; F.wg = blockIdx.x; F.G = gridDim.x; \
    F.out = (float*)arg_ptr<25>(); F.ws = (unsigned char*)arg_ptr<26>(); F.lds = (float*)lds_raw
__device__ __forceinline__ void norm_row_bf16(const float* xrow, const float* g, bf16* orow, int lane) {
    f32x4 v[4]; float s = 0.f;
#pragma unroll
    for (int j = 0; j < 4; ++j) { v[j] = *(const f32x4*)(xrow + j * 256 + lane * 4); s += (v[j][0] * v[j][0] + v[j][1] * v[j][1]) + (v[j][2] * v[j][2] + v[j][3] * v[j][3]); }
    const float r = 1.f / sqrtf(wave_sum(s) * (1.f / D) + EPS);
#pragma unroll
    for (int j = 0; j < 4; ++j) { const f32x4 gg = *(const f32x4*)(g + j * 256 + lane * 4); u32x2 o; o.x = pk2(v[j][0] * r * gg[0], v[j][1] * r * gg[1]); o.y = pk2(v[j][2] * r * gg[2], v[j][3] * r * gg[3]);
        *(u32x2*)(orow + j * 256 + lane * 4) = o; }
}

__device__ __forceinline__ void naive_tile(float (&acc)[8][4], const bf16* A, int lda, const float* B, int ldb, int m0, int n0, int K, float* lds, int tid) {
    float* As = lds;
    float* Bs = lds + 16 * 132;
    const int tx = tid & 31, ty = tid >> 5;
    const int ar = tid >> 2, ak = (tid & 3) * 4;
    const int bk = tid >> 5, bn = (tid & 31) * 4;
    for (int k0 = 0; k0 < K; k0 += 16) {
        const u32x2 av = *(const u32x2*)(A + (size_t)(m0 + ar) * lda + k0 + ak);
        const f32x4 bv = *(const f32x4*)(B + (size_t)(k0 + bk) * ldb + n0 + bn);
        __syncthreads();
        As[(ak + 0) * 132 + ar] = bflo(av.x); As[(ak + 1) * 132 + ar] = bfhi(av.x);
        As[(ak + 2) * 132 + ar] = bflo(av.y); As[(ak + 3) * 132 + ar] = bfhi(av.y);
        *(f32x4*)(Bs + bk * 132 + bn) = bv;
        __syncthreads();
#pragma unroll 4
        for (int k = 0; k < 16; ++k) {
            const f32x4 a0 = *(const f32x4*)(As + k * 132 + ty * 8), a1 = *(const f32x4*)(As + k * 132 + ty * 8 + 4);
            const f32x4 b = *(const f32x4*)(Bs + k * 132 + tx * 4);
            const float a[8] = {a0.x, a0.y, a0.z, a0.w, a1.x, a1.y, a1.z, a1.w};
#pragma unroll
            for (int i = 0; i < 8; ++i) { acc[i][0] += a[i] * b.x; acc[i][1] += a[i] * b.y; acc[i][2] += a[i] * b.z; acc[i][3] += a[i] * b.w; }
        }
    }
}
#define ZERO_ACC(acc) _Pragma("unroll") for (int i_ = 0; i_ < 8; ++i_) _Pragma("unroll") for (int j_ = 0; j_ < 4; ++j_) acc[i_][j_] = 0.f

__device__ __forceinline__ const float* xin(const Frame& F, int layer) { return layer == 0 ? (const float*)arg_ptr<I_X>() : F.out; }

template <bool XF32> __device__ __forceinline__ void norm1_rows(const Frame& F, const void* xsrc, unsigned long long* rstd, bf16* hc) {
    f32x4 v[4][4], vn[4][4];
#define N1_LOAD(t0_, V) do { _Pragma("unroll") for (int r = 0; r < 4; ++r) _Pragma("unroll") for (int j = 0; j < 4; ++j) { const size_t off = (size_t)((t0_) + r) * D + j * 256 + F.lane * 4; \
        if (XF32) V[r][j] = *(const f32x4*)((const float*)xsrc + off); \
        else { const u32x2 w = *(const u32x2*)((const bf16*)xsrc + off); V[r][j] = (f32x4){bflo(w.x), bfhi(w.x), bflo(w.y), bfhi(w.y)}; } } } while (0)
    const int tstep = F.G * NWAVES * 4; int t0 = (F.wg * NWAVES + F.wave) * 4;
    if (t0 < T) N1_LOAD(t0, v);
#pragma unroll 1
    for (; t0 < T; t0 += tstep) {
        const bool has_next = t0 + tstep < T;
        if (has_next) N1_LOAD(t0 + tstep, vn);
#pragma unroll
        for (int r = 0; r < 4; ++r) { float sq = 0.f;
#pragma unroll
            for (int j = 0; j < 4; ++j) sq += (v[r][j][0] * v[r][j][0] + v[r][j][1] * v[r][j][1]) + (v[r][j][2] * v[r][j][2] + v[r][j][3] * v[r][j][3]);
            const float rr = 1.f / sqrtf(wave_sum(sq) * (1.f / D) + EPS);
#pragma unroll
            for (int j = 0; j < 4; ++j) { u32x2 o; o.x = pk2(v[r][j][0] * rr, v[r][j][1] * rr); o.y = pk2(v[r][j][2] * rr, v[r][j][3] * rr);
                *(u32x2*)(hc + (size_t)(t0 + r) * HC + HC_H + j * 256 + F.lane * 4) = o; } }
        if (has_next) {
#pragma unroll
            for (int r = 0; r < 4; ++r)
#pragma unroll
                for (int j = 0; j < 4; ++j) v[r][j] = vn[r][j]; }
    }
#undef N1_LOAD
}
__device__ __forceinline__ void ph_norm1(const Frame& F0, int layer) { PHASE_FRAME(F0);
    unsigned long long* rstd = (unsigned long long*)(F.ws + SM_SSQ);
    bf16* hc = (bf16*)(F.ws + WS_HCAT);
    if (layer == 0) norm1_rows<true>(F, arg_ptr<I_X>(), rstd, hc); else norm1_rows<false>(F, (const void*)F.out, rstd, hc);
}

__device__ __forceinline__ void ph_proj_naive(const Frame& F0, int layer) { PHASE_FRAME(F0);
    const bf16* hc = (const bf16*)(F.ws + WS_HCAT); bf16* proj = (bf16*)(F.ws + WS_PROJ);
    const float* W = (const float*)arg_ptr<I_W_IN>() + (size_t)layer * D * INW;
    const int ntn = INW / 128, ntiles = (T / 128) * ntn;
    for (int it = F.wg; it < ntiles; it += F.G) {
        const int m0 = (it / ntn) * 128, n0 = (it % ntn) * 128;
        float acc[8][4]; ZERO_ACC(acc);
        naive_tile(acc, hc + HC_H, HC, W, INW, m0, n0, D, F.lds, F.tid);
        const int tx = F.tid & 31, ty = F.tid >> 5;
#pragma unroll
        for (int i = 0; i < 8; ++i) { u32x2 o; o.x = pk2(acc[i][0], acc[i][1]); o.y = pk2(acc[i][2], acc[i][3]);
            *(u32x2*)(proj + (size_t)(m0 + ty * 8 + i) * INW + n0 + tx * 4) = o; }
    }
}

__device__ __forceinline__ void ph_rope_naive(const Frame& F0) { PHASE_FRAME(F0);
    bf16* proj = (bf16*)(F.ws + WS_PROJ); const int* pos = (const int*)arg_ptr<I_POS>();
    const int j = F.lane & 31, sub = F.lane >> 5;
    const float inv = exp2f(-(float)j * (13.287712379549449f / 32.0f));
    const long nitems = (long)T * 24 / 2;
    for (long it = (long)F.wg * NWAVES + F.wave; it < nitems; it += (long)F.G * NWAVES) {
        const long th = it * 2 + sub; const int t = (int)(th / 24), hh = (int)(th % 24);
        const int c0 = (hh < 12 ? C_QA : C_KA - 768) + hh * 64;
        bf16* p = proj + (size_t)t * INW + c0;
        const float t1 = bf2f(p[j]), t2 = bf2f(p[j + 32]);
        const float ang = (float)pos[t] * inv;
        double rev = (double)ang * 0.15915494309189535; rev -= floor(rev);
        const float fr = (float)rev;
        const float sn = __builtin_amdgcn_sinf(fr), cs = __builtin_amdgcn_cosf(fr);
        const float sc = hh < 12 ? C2 : 1.0f;
        const float r1 = (t1 * cs - t2 * sn) * sc, r2 = (t2 * cs + t1 * sn) * sc;
        *(unsigned*)(p + 2 * j) = pk2(r1, r2);
    }
    const long nq = (long)T * 512 / 2;
    for (long i = (long)F.wg * NTHREADS + F.tid; i < nq; i += (long)F.G * NTHREADS) {
        const int t = (int)(i / 256), c = (int)(i % 256) * 2;
        unsigned* p = (unsigned*)(proj + (size_t)t * INW + C_QB + c); const unsigned w = *p; *p = pk2(bflo(w) * C2, bfhi(w) * C2);
    }
}

__device__ __forceinline__ void ph_dil_naive(const Frame& F0) { PHASE_FRAME(F0);
    bf16* proj = (bf16*)(F.ws + WS_PROJ); float* lse = (float*)(F.ws + WS_LSE);
    const long n = (long)T * 12;
    for (long i = (long)F.wg * NTHREADS + F.tid; i < n; i += (long)F.G * NTHREADS) {
        const int gj = (int)(i / T), tt = (int)(i % T);
        const int g = gj >> 2, b = tt / SEQ, s = tt % SEQ, d = (g == 0) ? 1 : (g == 1 ? 4 : 16);
        const unsigned* qp = (const unsigned*)(proj + (size_t)tt * INW + C_QA + gj * 64);
        float q[64];
#pragma unroll
        for (int c = 0; c < 32; ++c) { const unsigned w = qp[c]; q[2 * c] = bflo(w); q[2 * c + 1] = bfhi(w); }
        float o[64];
#pragma unroll
        for (int c = 0; c < 64; ++c) o[c] = 0.f;
        float m = -1e30f, l = 0.f;
        for (int mm = 0; mm <= 128; ++mm) {
            const int sp = s - mm * d; if (sp < 0) break;
            const size_t row = (size_t)(b * SEQ + sp) * INW;
            const unsigned* kp = (const unsigned*)(proj + row + C_KA + gj * 64);
            const unsigned* vp = (const unsigned*)(proj + row + C_VA + gj * 64);
            float z = 0.f;
#pragma unroll
            for (int c = 0; c < 32; ++c) { const unsigned w = kp[c]; z += q[2 * c] * bflo(w) + q[2 * c + 1] * bfhi(w); }
            const float mn = fmaxf(m, z), a = exp2f(m - mn), pz = exp2f(z - mn);
            l = l * a + pz; m = mn;
#pragma unroll
            for (int c = 0; c < 32; ++c) { const unsigned w = vp[c]; o[2 * c] = o[2 * c] * a + pz * bflo(w); o[2 * c + 1] = o[2 * c + 1] * a + pz * bfhi(w); }
        }
        const float rl = 1.f / l;
        unsigned* op = (unsigned*)(proj + (size_t)tt * INW + C_QA + gj * 64);
#pragma unroll
        for (int c = 0; c < 32; ++c) op[c] = pk2(o[2 * c] * rl, o[2 * c + 1] * rl);
        lse[(size_t)tt * 12 + gj] = m + log2f(l);
    }
}

__device__ __forceinline__ void ph_sb_naive(const Frame& F0) { PHASE_FRAME(F0);
    const bf16* proj = (const bf16*)(F.ws + WS_PROJ); bf16* hc = (bf16*)(F.ws + WS_HCAT);
    const int nitems = BATCH * 8 * (SEQ / 64);
    for (int it = F.wg * NWAVES + F.wave; it < nitems; it += F.G * NWAVES) {
        const int chunk = (SEQ / 64 - 1) - it / (BATCH * 8), bh = it % (BATCH * 8), b = bh >> 3, h = bh & 7;
        const int t = chunk * 64 + F.lane;
        const unsigned* qp = (const unsigned*)(proj + (size_t)(b * SEQ + t) * INW + C_QB + h * 64);
        float q[64], o[64];
#pragma unroll
        for (int c = 0; c < 32; ++c) { const unsigned w = qp[c]; q[2 * c] = bflo(w); q[2 * c + 1] = bfhi(w); }
#pragma unroll
        for (int c = 0; c < 64; ++c) o[c] = 0.f;
        float carry = 0.f;
        for (int s = chunk * 64 + 62; s >= 0; --s) {
            const size_t row = (size_t)(b * SEQ + s) * INW;
            const unsigned* kp = (const unsigned*)(proj + row + C_KB + h * 64);
            const unsigned* vp = (const unsigned*)(proj + row + C_VB + h * 64);
            float z = 0.f;
#pragma unroll
            for (int c = 0; c < 32; ++c) { const unsigned w = kp[c]; z += q[2 * c] * bflo(w) + q[2 * c + 1] * bfhi(w); }
            const float sp = (z > 30.f) ? z : log2f(1.f + exp2f(z));
            float a = exp2f(z - sp - carry);
            const bool act = s < t;
            a = act ? a : 0.f; carry += act ? sp : 0.f;
#pragma unroll
            for (int c = 0; c < 32; ++c) { const unsigned w = vp[c]; o[2 * c] += a * bflo(w); o[2 * c + 1] += a * bfhi(w); }
        }
        unsigned* op = (unsigned*)(hc + (size_t)(b * SEQ + t) * HC + HC_OB + h * 64);
#pragma unroll
        for (int c = 0; c < 32; ++c) op[c] = pk2(o[2 * c], o[2 * c + 1]);
    }
}

__device__ __forceinline__ void ph_pool_naive(const Frame& F0) { PHASE_FRAME(F0);
    const bf16* proj = (const bf16*)(F.ws + WS_PROJ); bf16* hc = (bf16*)(F.ws + WS_HCAT);
    const long n = (long)T * 512;
    for (long i = (long)F.wg * NTHREADS + F.tid; i < n; i += (long)F.G * NTHREADS) {
        const int t = (int)(i / 512), c = (int)(i % 512), g = c >> 7, w = 2 << g, s = t % SEQ;
        const int cnt = (s + 1 < w) ? s + 1 : w;
        float sum = 0.f;
        for (int k = 0; k < cnt; ++k) sum += bf2f(proj[(size_t)(t - k) * INW + C_UC + c]);
        const float u = bf2f(proj[(size_t)t * INW + C_UC + c]);
        hc[(size_t)t * HC + HC_PL + c] = (bf16)f2bf(sum / (float)cnt - u);
    }
}

__device__ __forceinline__ void ph_comb_naive(const Frame& F0, int layer) { PHASE_FRAME(F0);
    const bf16* proj = (const bf16*)(F.ws + WS_PROJ); bf16* hc = (bf16*)(F.ws + WS_HCAT); const float* lse = (const float*)(F.ws + WS_LSE);
    float l0, l1, l2, n0, n1, n2; u32x4 a, b_, d_, na, nb, nd;
#define COMB_LOAD(i_, L0, L1, L2, A, B, DD) do { const int t = (i_) >> 5, c = ((i_) & 31) * 8, j = c >> 6, s_ = t & (SEQ - 1), bb = t - s_, cl = c & 63; \
        L0 = lse[(size_t)t * 12 + j]; L1 = lse[(size_t)t * 12 + 4 + j]; L2 = lse[(size_t)t * 12 + 8 + j]; \
        A = *(const u32x4*)(proj + PJ_HM(j, t) + cl); B = *(const u32x4*)(proj + PJ_HM(4 + j, bb + (s_ & 3) * (SEQ / 4) + (s_ >> 2)) + cl); DD = *(const u32x4*)(proj + PJ_HM(8 + j, bb + (s_ & 15) * (SEQ / 16) + (s_ >> 4)) + cl); } while (0)
    const int step = F.G * NTHREADS; int i = F.wg * NTHREADS + F.tid;
    if (i < T * 32) COMB_LOAD(i, l0, l1, l2, a, b_, d_);
#pragma unroll 1
    for (; i < T * 32; i += step) {
        const bool has_next = i + step < T * 32;
        if (has_next) COMB_LOAD(i + step, n0, n1, n2, na, nb, nd);
        const int t = i >> 5, c = (i & 31) * 8;
        const float mx = fmaxf(l0, fmaxf(l1, l2)), e0 = exp2f(l0 - mx), e1 = exp2f(l1 - mx), e2 = exp2f(l2 - mx), rs = 1.f / (e0 + e1 + e2);
        u32x4 o;
#pragma unroll
        for (int q = 0; q < 4; ++q) o[q] = pk2((e0 * bflo(a[q]) + e1 * bflo(b_[q]) + e2 * bflo(d_[q])) * rs, (e0 * bfhi(a[q]) + e1 * bfhi(b_[q]) + e2 * bfhi(d_[q])) * rs);
        *(u32x4*)(hc + (size_t)t * HC + HC_OA + c) = o;
        if (has_next) { l0 = n0; l1 = n1; l2 = n2; a = na; b_ = nb; d_ = nd; }
    }
#undef COMB_LOAD
}
__device__ __forceinline__ void ph_ycpre_naive(const Frame& F0, int layer) { PHASE_FRAME(F0);
    bf16* hc = (bf16*)(F.ws + WS_HCAT);
    const float* wp = (const float*)arg_ptr<I_W_POOL>() + (size_t)layer * 4 * 128 * 128; const float* ps = (const float*)arg_ptr<I_POOL_SCALE>() + layer * 512;
    bf16* yc = (bf16*)(F.ws + WS_YCPRE);
    const long n2 = (long)T * 512;
    for (long i = (long)F.wg * NTHREADS + F.tid; i < n2; i += (long)F.G * NTHREADS) {
        const int t = (int)(i / 512), c = (int)(i % 512), g = c >> 7, dd = c & 127;
        const bf16* pl = hc + (size_t)t * HC + HC_PL + g * 128; const float* w = wp + (size_t)g * 128 * 128 + dd;
        float s = 0.f;
        for (int k = 0; k < 128; ++k) s += bf2f(pl[k]) * w[k * 128];
        yc[(size_t)t * 512 + c] = (bf16)f2bf(s * ps[c]);
    }
}

__device__ __forceinline__ void ph_g4_naive(const Frame& F0, int layer) { PHASE_FRAME(F0);
    const bf16* hc = (const bf16*)(F.ws + WS_HCAT); const bf16* yc = (const bf16*)(F.ws + WS_YCPRE); bf16* mg = (bf16*)(F.ws + OV_MERGED);
    const float* wg = (const float*)arg_ptr<I_W_GATE>() + (size_t)layer * D * NGATE; const float* bg = (const float*)arg_ptr<I_B_GATE>() + layer * NGATE;
    const float* wa = (const float*)arg_ptr<I_W_UP_A>() + (size_t)layer * 256 * D; const float* wb = (const float*)arg_ptr<I_W_UP_B>() + (size_t)layer * 512 * D;
    const float* wc = (const float*)arg_ptr<I_W_UP_C>() + (size_t)layer * 512 * D;
    const int ntiles = (T / 128) * 8; const int tx = F.tid & 31, ty = F.tid >> 5;
    for (int it = F.wg; it < ntiles; it += F.G) {
        const int m0 = (it / 8) * 128, n0 = (it % 8) * 128;
        float m[8][4]; ZERO_ACC(m);
#pragma unroll 1
        for (int b = 0; b < 3; ++b) {
            float g[8][4]; ZERO_ACC(g);
            naive_tile(g, hc + HC_H, HC, wg, NGATE, m0, b * 1024 + n0, D, F.lds, F.tid);
            const f32x4 bias = *(const f32x4*)(bg + b * 1024 + n0 + tx * 4);
#pragma unroll
            for (int i = 0; i < 8; ++i) { g[i][0] = sigmoidf_(g[i][0] + bias.x); g[i][1] = sigmoidf_(g[i][1] + bias.y); g[i][2] = sigmoidf_(g[i][2] + bias.z); g[i][3] = sigmoidf_(g[i][3] + bias.w); }
            float acc[8][4]; ZERO_ACC(acc);
            if (b == 0) naive_tile(acc, hc + HC_OA, HC, wa, D, m0, n0, 256, F.lds, F.tid);
            else if (b == 1) naive_tile(acc, hc + HC_OB, HC, wb, D, m0, n0, 512, F.lds, F.tid);
            else naive_tile(acc, yc, 512, wc, D, m0, n0, 512, F.lds, F.tid);
#pragma unroll
            for (int i = 0; i < 8; ++i)
#pragma unroll
                for (int j = 0; j < 4; ++j) m[i][j] += g[i][j] * acc[i][j];
        }
#pragma unroll
        for (int i = 0; i < 8; ++i) { u32x2 o; o.x = pk2(m[i][0], m[i][1]); o.y = pk2(m[i][2], m[i][3]); *(u32x2*)(mg + (size_t)(m0 + ty * 8 + i) * D + n0 + tx * 4) = o; }
    }
}

__device__ __forceinline__ void ph_g5_naive(const Frame& F0, int layer) { PHASE_FRAME(F0);
    const bf16* mg = (const bf16*)(F.ws + OV_MERGED); const float* W = (const float*)arg_ptr<I_W_OUT>() + (size_t)layer * D * D; const float* x = xin(F, layer);
    const int ntiles = (T / 128) * 8; const int tx = F.tid & 31, ty = F.tid >> 5;
    for (int it = F.wg; it < ntiles; it += F.G) {
        const int m0 = (it / 8) * 128, n0 = (it % 8) * 128;
        float acc[8][4]; ZERO_ACC(acc);
        naive_tile(acc, mg, D, W, D, m0, n0, D, F.lds, F.tid);
#pragma unroll
        for (int i = 0; i < 8; ++i) { const size_t off = (size_t)(m0 + ty * 8 + i) * D + n0 + tx * 4; const f32x4 xv = *(const f32x4*)(x + off);
            *(f32x4*)(F.out + off) = (f32x4){xv.x + acc[i][0], xv.y + acc[i][1], xv.z + acc[i][2], xv.w + acc[i][3]}; }
    }
}

__device__ __forceinline__ void ph_route(const Frame& F0, int layer) { PHASE_FRAME(F0);
    const float* g = (const float*)arg_ptr<I_NORM_MOE>() + layer * D;
    const float* wrg = (const float*)arg_ptr<I_W_RG>() + (size_t)layer * D * 4; const float* brg = (const float*)arg_ptr<I_B_RG>() + layer * 4;
    const float* wre = (const float*)arg_ptr<I_W_RE>() + (size_t)layer * 4 * D * 4; const float* bre = (const float*)arg_ptr<I_B_RE>() + layer * 16;
    bf16* hmb = (bf16*)(F.ws + WS_PROJ); int* eid = (int*)(F.ws + SM_EID); float* wgt = (float*)(F.ws + SM_WGT);
    for (int t = F.wg * NWAVES + F.wave; t < T; t += F.G * NWAVES) {
        const float* xr = F.out + (size_t)t * D;
        float s = 0.f;
#pragma unroll
        for (int i = 0; i < 16; ++i) { const float xv = xr[i * 64 + F.lane]; s += xv * xv; }
        const float r = 1.f / sqrtf(wave_sum(s) * (1.f / D) + EPS);
        float lg[4] = {0.f, 0.f, 0.f, 0.f}; float le[16];
#pragma unroll
        for (int e = 0; e < 16; ++e) le[e] = 0.f;
#pragma unroll 2
        for (int i = 0; i < 16; ++i) {
            const int k = i * 64 + F.lane; const float hm = xr[k] * r * g[k];
            hmb[(size_t)t * D + k] = (bf16)f2bf(hm);
            const f32x4 a = *(const f32x4*)(wrg + (size_t)k * 4);
            lg[0] += hm * a.x; lg[1] += hm * a.y; lg[2] += hm * a.z; lg[3] += hm * a.w;
#pragma unroll
            for (int gg = 0; gg < 4; ++gg) { const f32x4 w = *(const f32x4*)(wre + ((size_t)gg * D + k) * 4);
                le[gg * 4 + 0] += hm * w.x; le[gg * 4 + 1] += hm * w.y; le[gg * 4 + 2] += hm * w.z; le[gg * 4 + 3] += hm * w.w; }
        }
#pragma unroll
        for (int e = 0; e < 4; ++e) lg[e] = wave_sum(lg[e]) + brg[e];
#pragma unroll
        for (int e = 0; e < 16; ++e) le[e] = wave_sum(le[e]) + bre[e];
        if (F.lane == 0) {
            int gi = 0; float mx = lg[0];
#pragma unroll
            for (int e = 1; e < 4; ++e) if (lg[e] > mx) { mx = lg[e]; gi = e; }
            float den = 0.f;
#pragma unroll
            for (int e = 0; e < 4; ++e) den += __expf(lg[e] - mx);
            const float p1 = 1.f / den;
            float ls[4];
#pragma unroll
            for (int e = 0; e < 4; ++e) ls[e] = gi == 0 ? le[e] : gi == 1 ? le[4 + e] : gi == 2 ? le[8 + e] : le[12 + e];
            int i0 = 0; float v0 = ls[0];
#pragma unroll
            for (int e = 1; e < 4; ++e) if (ls[e] > v0) { v0 = ls[e]; i0 = e; }
            int i1 = -1; float v1 = -3.0e38f;
#pragma unroll
            for (int e = 0; e < 4; ++e) if (e != i0 && ls[e] > v1) { v1 = ls[e]; i1 = e; }
            const float ex = __expf(v1 - v0), w0 = p1 / (1.f + ex), w1 = p1 * ex / (1.f + ex);
            eid[t * 2 + 0] = gi * 4 + i0; eid[t * 2 + 1] = gi * 4 + i1; wgt[t * 2 + 0] = w0; wgt[t * 2 + 1] = w1;
        }
    }
}

__device__ __forceinline__ void ph_moe_naive(const Frame& F0, int layer) { PHASE_FRAME(F0);
    const bf16* hmb = (const bf16*)(F.ws + WS_PROJ); const int* eid = (const int*)(F.ws + SM_EID); const float* wgt = (const float*)(F.ws + SM_WGT);
    const float* WG = (const float*)arg_ptr<I_W_EG>() + (size_t)layer * NEXP * D * EXP_H; const float* WU = (const float*)arg_ptr<I_W_EU>() + (size_t)layer * NEXP * D * EXP_H;
    const float* WD = (const float*)arg_ptr<I_W_ED>() + (size_t)layer * NEXP * EXP_H * D;
    float* hrow = F.lds; float* hid = F.lds + D;
    for (int t = F.wg; t < T; t += F.G) {
        __syncthreads();
        for (int k = F.tid; k < D; k += NTHREADS) hrow[k] = bf2f(hmb[(size_t)t * D + k]);
        __syncthreads();
        const int slot = F.tid >> 8, f = F.tid & 255, e = eid[t * 2 + slot];
        const float* wg = WG + (size_t)e * D * EXP_H + f; const float* wu = WU + (size_t)e * D * EXP_H + f;
        float a = 0.f, u = 0.f;
#pragma unroll 8
        for (int k = 0; k < D; ++k) { const float h = hrow[k]; a += h * wg[(size_t)k * EXP_H]; u += h * wu[(size_t)k * EXP_H]; }
        const float hv = (a / (1.f + __expf(-a))) * u * wgt[t * 2 + slot];
        hid[slot * 256 + f] = bf2f(f2bf(hv));
        __syncthreads();
        const int e0 = eid[t * 2], e1 = eid[t * 2 + 1];
        const float* d0 = WD + (size_t)e0 * EXP_H * D; const float* d1 = WD + (size_t)e1 * EXP_H * D;
        for (int n = F.tid; n < D; n += NTHREADS) {
            float y = 0.f;
#pragma unroll 8
            for (int ff = 0; ff < 256; ++ff) y += hid[ff] * d0[(size_t)ff * D + n] + hid[256 + ff] * d1[(size_t)ff * D + n];
            F.out[(size_t)t * D + n] += y;
        }
    }
}

__device__ __forceinline__ void ph_e(const Frame& F0, int layer) { PHASE_FRAME(F0);
    const float* g = (const float*)arg_ptr<I_NORM_PLE>() + layer * D; const float* p = (const float*)arg_ptr<I_P>() + (size_t)layer * T * PLE_DIM;
    bf16* hc = (bf16*)(F.ws + WS_HCAT);
    for (int t = F.wg * NWAVES + F.wave; t < T; t += F.G * NWAVES) {
        norm_row_bf16(F.out + (size_t)t * D, g, hc + (size_t)t * HC + HC_H, F.lane);
#pragma unroll
        for (int i = 0; i < 4; ++i) hc[(size_t)t * HC + HC_OA + i * 64 + F.lane] = (bf16)f2bf(p[(size_t)t * PLE_DIM + i * 64 + F.lane]);
    }
}

__device__ __forceinline__ void ph_ple_naive(const Frame& F0, int layer) { PHASE_FRAME(F0);
    const bf16* hc = (const bf16*)(F.ws + WS_HCAT);
    const float* wi = (const float*)arg_ptr<I_W_PLE_IN>() + (size_t)layer * PLE_DIM * D; const float* wg = (const float*)arg_ptr<I_W_PLE_GATE>() + (size_t)layer * D * D;
    const int ntiles = (T / 128) * 8; const int tx = F.tid & 31, ty = F.tid >> 5;
    for (int it = F.wg; it < ntiles; it += F.G) {
        const int m0 = (it / 8) * 128, n0 = (it % 8) * 128;
        float g[8][4]; ZERO_ACC(g);
        naive_tile(g, hc + HC_H, HC, wg, D, m0, n0, D, F.lds, F.tid);
        float acc[8][4]; ZERO_ACC(acc);
        naive_tile(acc, hc + HC_OA, HC, wi, D, m0, n0, PLE_DIM, F.lds, F.tid);
#pragma unroll
        for (int i = 0; i < 8; ++i) { const size_t off = (size_t)(m0 + ty * 8 + i) * D + n0 + tx * 4; f32x4 xv = *(const f32x4*)(F.out + off);
            xv.x += acc[i][0] * sigmoidf_(g[i][0]); xv.y += acc[i][1] * sigmoidf_(g[i][1]); xv.z += acc[i][2] * sigmoidf_(g[i][2]); xv.w += acc[i][3] * sigmoidf_(g[i][3]);
            *(f32x4*)(F.out + off) = xv; }
    }
}

__device__ __forceinline__ void ph_final(const Frame& F0) { PHASE_FRAME(F0);
    const float* g = (const float*)arg_ptr<I_NORM_FINAL>(); const bf16* x3 = (const bf16*)(F.ws + OV_X3);
    u32x2 xw[2][4], xn[2][4];
#define FIN_LOAD(t0_, XW) do { _Pragma("unroll") for (int r = 0; r < 2; ++r) _Pragma("unroll") for (int j = 0; j < 4; ++j) XW[r][j] = *(const u32x2*)(x3 + (size_t)((t0_) + r) * D + j * 256 + F.lane * 4); } while (0)
    const int tstep = F.G * NWAVES * 2; int t0 = (F.wg * NWAVES + F.wave) * 2;
    f32x4 gg[4];
#pragma unroll
    for (int j = 0; j < 4; ++j) gg[j] = *(const f32x4*)(g + j * 256 + F.lane * 4);
    if (t0 < T) FIN_LOAD(t0, xw);
#pragma unroll 1
    for (; t0 < T; t0 += tstep) {
        const bool has_next = t0 + tstep < T;
        if (has_next) FIN_LOAD(t0 + tstep, xn);
#pragma unroll
        for (int r = 0; r < 2; ++r) { float s = 0.f; f32x4 v[4];
#pragma unroll
            for (int j = 0; j < 4; ++j) { v[j] = (f32x4){bflo(xw[r][j].x), bfhi(xw[r][j].x), bflo(xw[r][j].y), bfhi(xw[r][j].y)}; s += (v[j][0] * v[j][0] + v[j][1] * v[j][1]) + (v[j][2] * v[j][2] + v[j][3] * v[j][3]); }
            const float rr = 1.f / sqrtf(wave_sum(s) * (1.f / D) + EPS);
#pragma unroll
            for (int j = 0; j < 4; ++j) *(f32x4*)(F.out + (size_t)(t0 + r) * D + j * 256 + F.lane * 4) = v[j] * rr * gg[j]; }
        if (has_next) {
#pragma unroll
            for (int r = 0; r < 2; ++r)
#pragma unroll
                for (int j = 0; j < 4; ++j) xw[r][j] = xn[r][j]; }
    }
#undef FIN_LOAD
}


#define LAS __attribute__((address_space(3)))
typedef short bf16x8 __attribute__((ext_vector_type(8)));
typedef float f32x2 __attribute__((ext_vector_type(2)));
#define LDS_WAIT() asm volatile("s_waitcnt lgkmcnt(0)" ::: "memory")
#define VM_WAIT() asm volatile("s_waitcnt vmcnt(0)" ::: "memory")
typedef __bf16 bf16x2_t __attribute__((ext_vector_type(2)));
__device__ __forceinline__ unsigned cvt_pk_bf16(float lo, float hi) { f32x2 v = {lo, hi}; bf16x2_t b = __builtin_convertvector(v, bf16x2_t); return __builtin_bit_cast(unsigned, b); }
#define NEG_LOG2E (-1.4426950408889634f)
__device__ __forceinline__ float sigmoid_pre(float v) { return __builtin_amdgcn_rcpf(1.f + __builtin_amdgcn_exp2f(v)); }
__device__ __forceinline__ float fast_sigmoid(float x) { return __builtin_amdgcn_rcpf(1.f + __builtin_amdgcn_exp2f(-1.4426950408889634f * x)); }

constexpr size_t WO_IN = 0;
constexpr size_t WO_BCAT = WO_IN + (size_t)INW * D;
constexpr size_t WO_OUT = WO_BCAT + (size_t)D * 4352;
constexpr size_t WO_M1 = WO_OUT + (size_t)D * D;
constexpr size_t WO_M2 = WO_M1 + (size_t)NEXP * 512 * D;
constexpr size_t WO_PLE = WO_M2 + (size_t)NEXP * D * EXP_H;
constexpr size_t WO_END = WO_PLE + (size_t)D * 1280;
static_assert(WO_END * 2 <= 46 * MiB, "layer weights fit");
constexpr int BCAT_LD = 4352, PLE_LD = 1280;
constexpr int RMAX = 36864;
constexpr size_t OV_HM = WS_PROJ;
constexpr size_t OV_HID = WS_PROJ + 32 * MiB;
constexpr size_t OV_Y2 = WS_PROJ + 50 * MiB;
constexpr size_t OV_ASORT = WS_HCAT;
constexpr size_t OV_GT = WS_PROJ;
constexpr size_t SM_ROWTOK = WS_SMALL + 768 * 1024;
constexpr size_t SM_SLOT2 = WS_SMALL + 256 * 1024, SM_WROW = WS_SMALL + 384 * 1024, SM_TILE = WS_SMALL + 704 * 1024;

__device__ __forceinline__ int xcd_remap(int c, int n) { const int q = n / 8, r = n % 8, x = c % 8, k = c / 8; return (x < r ? x * (q + 1) : r * (q + 1) + (x - r) * q) + k; }
namespace pg8 {
constexpr int BM = 256, BK = 64, HALF = 128, HTB = HALF * BK * 2, STAGE_BYTES = 8 * HTB, NXCD = 8, WGM = 8;
__device__ __forceinline__ int lds_byte(int r, int c) { const int st = (r >> 4) * 2 + (c >> 5), rr = r & 15, cc = c & 31, ob = rr * 64 + cc * 2; return st * 1024 + (ob ^ (((ob >> 9) & 1) << 5)); }
__device__ __forceinline__ void stage_rc(int b, int& R, int& C) { const int st = b / 1024, sb = b % 1024, swz = sb ^ (((sb >> 9) & 1) << 5); R = (st >> 1) * 16 + swz / 64; C = (st & 1) * 32 + (swz % 64) / 2; }
__device__ __forceinline__ int perm32(int rho) { const int n = rho >> 4, i = rho & 15; return 8 * (i >> 2) + 4 * n + (i & 3); }

struct Unit { int pm, pn, ka, kb, nt, kind; };
struct Gemm { const bf16* A; int lda; const bf16* Bt; int ldb; const int* rowmap; };

__device__ __forceinline__ bool tile_order(int nM, int nN, int G, int c, int i, int& pm, int& pn) {
    const int nwg = nM * nN; const long L = (long)i * G + c; if (L >= nwg) return false;
    int wgid = (int)L; { const int q = nwg / NXCD, r = nwg % NXCD, xcd = wgid % NXCD, off = wgid / NXCD; wgid = (xcd < r ? xcd * (q + 1) : r * (q + 1) + (xcd - r) * q) + off; }
    const int nig = WGM * nN, gid = wgid / nig, fm = gid * WGM, gsz = (nM - fm) < WGM ? (nM - fm) : WGM;
    pm = fm + ((wgid % nig) % gsz); pn = (wgid % nig) / gsz; return true;
}

template <class Epi, class Sched, bool ALIGN_EPI, bool GATHER = false>
__device__ __forceinline__ void gemm_phase(LAS unsigned char* lds, const Gemm g, const Sched& S, const Epi& E, int tid) {
    asm volatile("" : "+v"(tid));
    const int wid = __builtin_amdgcn_readfirstlane(tid >> 6), lane = tid & 63, wr = wid >> 2, wc = wid & 3, fr = lane & 15, fq = lane >> 4;
    unsigned voffB[2], cvA[2][2], nvA[2][2]; int Rr[2], Cc[2];
#pragma unroll
    for (int i = 0; i < 2; ++i) { int R, C; stage_rc(tid * 16 + i * 8192, R, C); const int Rb = 2 * (R & ~31) + perm32(R & 31);
        Rr[i] = R; Cc[i] = C; voffB[i] = (unsigned)(Rb * g.ldb + C) * 2u;
#pragma unroll
        for (int h = 0; h < 2; ++h) { cvA[h][i] = (unsigned)((R + h * HALF) * g.lda + C) * 2u; nvA[h][i] = cvA[h][i]; } }
    const size_t kstep = (size_t)(BK * 2);
    const size_t hstepB = (size_t)32 * g.ldb * 2;
#define PG8_GATHER_VOFF(u, v) do { _Pragma("unroll") for (int _h = 0; _h < 2; ++_h) _Pragma("unroll") for (int _i = 0; _i < 2; ++_i) { \
        const int tok_ = g.rowmap[(u).pm * BM + _h * HALF + Rr[_i]]; v[_h][_i] = (unsigned)(tok_ * g.lda + Cc[_i]) * 2u; } \
        asm volatile("" : "+v"(v[0][0]), "+v"(v[0][1]), "+v"(v[1][0]), "+v"(v[1][1])); } while (0)
#define PG8_STAGE_A(bufoff, gbase, h, NX) do { _Pragma("unroll") for (int _i = 0; _i < 2; ++_i) { const unsigned vo_ = (GATHER && (NX)) ? nvA[h][_i] : cvA[h][_i]; \
        __builtin_amdgcn_global_load_lds((const unsigned*)((const char*)(gbase) + vo_), (LAS unsigned*)(lds + (bufoff) + ldsw + _i * 8192), 16, 0, 0); } } while (0)
    const unsigned ldsw = (unsigned)wid * 1024u;
    const int aoff = lds_byte(wr * 64 + fr, fq * 8), boff = lds_byte(wc * 32 + fr, fq * 8);
#define PG8_SA(b, h) (((b) * 2 + (h)) * HTB)
#define PG8_SB(b, h) ((4 + (b) * 2 + (h)) * HTB)
#define PG8_STAGE(bufoff, gbase, voff) do { _Pragma("unroll") for (int _i = 0; _i < 2; ++_i) \
        __builtin_amdgcn_global_load_lds((const unsigned*)((const char*)(gbase) + (voff)[_i]), (LAS unsigned*)(lds + (bufoff) + ldsw + _i * 8192), 16, 0, 0); } while (0)
#define PG8_LDA(dst, b, h) do { _Pragma("unroll") for (int m = 0; m < 4; ++m) _Pragma("unroll") for (int k = 0; k < 2; ++k) dst[m][k] = *(const LAS bf16x8*)(lds + PG8_SA(b, h) + aoff + m * 2048 + k * 1024); } while (0)
#define PG8_LDB(dst, b, h) do { _Pragma("unroll") for (int n = 0; n < 2; ++n) _Pragma("unroll") for (int k = 0; k < 2; ++k) dst[n][k] = *(const LAS bf16x8*)(lds + PG8_SB(b, h) + boff + n * 2048 + k * 1024); } while (0)
#define PG8_MMA(ai, bj, At, Bt) do { __builtin_amdgcn_s_setprio(1); _Pragma("unroll") for (int m = 0; m < 4; ++m) _Pragma("unroll") for (int n = 0; n < 2; ++n) _Pragma("unroll") for (int k = 0; k < 2; ++k) \
        acc[ai][bj][m][n] = __builtin_amdgcn_mfma_f32_16x16x32_bf16(Bt[n][k], At[m][k], acc[ai][bj][m][n], 0, 0, 0); __builtin_amdgcn_s_setprio(0); } while (0)
#define PG8_WAIT_V(n) asm volatile("s_waitcnt vmcnt(" #n ")" ::: "memory")
#define PG8_WAIT_L(n) asm volatile("s_waitcnt lgkmcnt(" #n ")" ::: "memory")
#define PG8_BAR __builtin_amdgcn_s_barrier()
#define PG8_SCHED __builtin_amdgcn_sched_barrier(0)
#define PG8_UA(u) ((const char*)g.A + ((GATHER ? (size_t)0 : (size_t)(u).pm * BM * g.lda) + (u).ka) * 2)
#define PG8_UB(u) ((const char*)g.Bt + ((size_t)(u).pn * BM * g.ldb + (u).kb) * 2)
    Unit cur, nxt; int ui = 0;
    if (!S.next(0, cur)) return;
    f32x4 acc[2][2][4][2];
#pragma unroll
    for (int a = 0; a < 2; ++a)
#pragma unroll
        for (int b = 0; b < 2; ++b)
#pragma unroll
            for (int m = 0; m < 4; ++m)
#pragma unroll
                for (int n = 0; n < 2; ++n) acc[a][b][m][n] = (f32x4){0.f, 0.f, 0.f, 0.f};
    bf16x8 At[4][2], B0[2][2], B1[2][2];
    const char* cA = PG8_UA(cur); const char* cB = PG8_UB(cur);
    if constexpr (GATHER) PG8_GATHER_VOFF(cur, cvA);
    PG8_STAGE(PG8_SB(0, 0), cB, voffB); PG8_STAGE(PG8_SB(0, 1), cB + hstepB, voffB); PG8_STAGE_A(PG8_SA(0, 0), cA, 0, false); PG8_STAGE_A(PG8_SA(0, 1), cA, 1, false);
    if (wr == 1) PG8_BAR;
    PG8_WAIT_V(2); PG8_BAR;
    PG8_STAGE(PG8_SB(1, 0), cB + kstep, voffB); PG8_STAGE_A(PG8_SA(1, 0), cA + kstep, 0, false); PG8_STAGE(PG8_SB(1, 1), cB + hstepB + kstep, voffB);
    PG8_WAIT_V(6); PG8_BAR;
    for (;;) {
        const bool has_next = S.next(ui + 1, nxt);
        const char* nA = has_next ? PG8_UA(nxt) : cA; const char* nB = has_next ? PG8_UB(nxt) : cB;
        if constexpr (GATHER) { if (has_next) PG8_GATHER_VOFF(nxt, nvA); }
        const int nt = cur.nt;
#pragma unroll 1
        for (int t = 0; t < nt; t += 2) {
            const bool last = (t == nt - 2), nx = last && has_next;
            const char* a1 = cA + (size_t)(t + 1) * kstep;
            const char* a2 = last ? nA : cA + (size_t)(t + 2) * kstep; const char* b2 = last ? nB : cB + (size_t)(t + 2) * kstep;
            const char* a3 = a2 + kstep; const char* b3 = b2 + kstep;
            PG8_LDB(B0, 0, 0); PG8_LDB(B1, 0, 1); PG8_SCHED; PG8_LDA(At, 0, 0); PG8_STAGE_A(PG8_SA(1, 1), a1, 1, false);
            PG8_WAIT_V(8); PG8_WAIT_L(0); PG8_BAR; PG8_MMA(0, 0, At, B0); PG8_MMA(0, 1, At, B1); PG8_BAR; PG8_SCHED;
            PG8_LDA(At, 0, 1); PG8_STAGE(PG8_SB(0, 0), b2, voffB); PG8_STAGE(PG8_SB(0, 1), b2 + hstepB, voffB); PG8_STAGE_A(PG8_SA(0, 0), a2, 0, nx);
            PG8_WAIT_V(8); PG8_WAIT_L(0); PG8_BAR; PG8_MMA(1, 0, At, B0); PG8_MMA(1, 1, At, B1); PG8_BAR; PG8_SCHED;
            PG8_LDB(B0, 1, 0); PG8_LDB(B1, 1, 1); PG8_SCHED; PG8_LDA(At, 1, 0); PG8_STAGE_A(PG8_SA(0, 1), a2, 1, nx);
            PG8_WAIT_V(8); PG8_WAIT_L(0); PG8_BAR; PG8_MMA(0, 0, At, B0); PG8_MMA(0, 1, At, B1); PG8_BAR; PG8_SCHED;
            PG8_LDA(At, 1, 1); PG8_STAGE(PG8_SB(1, 0), b3, voffB); PG8_STAGE(PG8_SB(1, 1), b3 + hstepB, voffB); PG8_STAGE_A(PG8_SA(1, 0), a3, 0, nx);
            PG8_WAIT_V(8); PG8_WAIT_L(0); PG8_BAR; PG8_MMA(1, 0, At, B0); PG8_MMA(1, 1, At, B1); PG8_BAR; PG8_SCHED;
        }
        if constexpr (ALIGN_EPI) { if (wr == 0) PG8_BAR; }
        E(acc, cur, wr, wc, fr, fq);
        if (!has_next) break;
#pragma unroll
        for (int a = 0; a < 2; ++a)
#pragma unroll
            for (int b = 0; b < 2; ++b)
#pragma unroll
                for (int m = 0; m < 4; ++m)
#pragma unroll
                    for (int n = 0; n < 2; ++n) acc[a][b][m][n] = (f32x4){0.f, 0.f, 0.f, 0.f};
        cur = nxt; cA = nA; cB = nB; ++ui;
        if constexpr (GATHER) {
#pragma unroll
            for (int h = 0; h < 2; ++h)
#pragma unroll
                for (int i = 0; i < 2; ++i) cvA[h][i] = nvA[h][i]; }
        if constexpr (ALIGN_EPI) { if (wr == 1) PG8_BAR; }
    }
    PG8_WAIT_V(0);
    if constexpr (!ALIGN_EPI) { if (wr == 0) PG8_BAR; }
    PG8_BAR;
#undef PG8_SA
#undef PG8_SB
#undef PG8_STAGE
#undef PG8_STAGE_A
#undef PG8_GATHER_VOFF
#undef PG8_LDA
#undef PG8_LDB
#undef PG8_MMA
#undef PG8_WAIT_V
#undef PG8_WAIT_L
#undef PG8_BAR
#undef PG8_SCHED
#undef PG8_UA
#undef PG8_UB
}
}

typedef f32x4 AccT[2][2][4][2];
#define EPI_ROW(u, ai, m) ((u).pm * 256 + (ai) * 128 + wr * 64 + (m) * 16 + fr)
#define EPI_ROW0(u, ai, m) ((u).pm * 256 + (ai) * 128 + wr * 64 + (m) * 16)
#define EPI_FOR_AM _Pragma("unroll") for (int ai = 0; ai < 2; ++ai) _Pragma("unroll") for (int m = 0; m < 4; ++m)
__device__ __forceinline__ u32x4 pack8(const f32x4 v0, const f32x4 v1) { u32x4 w; w.x = cvt_pk_bf16(v0[0], v0[1]); w.y = cvt_pk_bf16(v0[2], v0[3]); w.z = cvt_pk_bf16(v1[0], v1[1]); w.w = cvt_pk_bf16(v1[2], v1[3]); return w; }
__device__ __forceinline__ void unpack8(const u32x4 w, f32x4& v0, f32x4& v1) { v0 = (f32x4){bflo(w.x), bfhi(w.x), bflo(w.y), bfhi(w.y)}; v1 = (f32x4){bflo(w.z), bfhi(w.z), bflo(w.w), bfhi(w.w)}; }
constexpr int STG_OFF = 133120, STG_PITCH = 144, STG_WAVE = 16 * STG_PITCH;
__device__ __forceinline__ void store_rows16(const u32x4 v0, const u32x4 v1, bf16* g0, size_t pitch, int wid, int lane) {
    LAS unsigned char* stg = (LAS unsigned char*)lds_raw + STG_OFF + wid * STG_WAVE; const int fr = lane & 15, fq = lane >> 4;
    *(LAS u32x4*)(stg + fr * STG_PITCH + fq * 16) = v0; *(LAS u32x4*)(stg + fr * STG_PITCH + 64 + fq * 16) = v1;
#pragma unroll
    for (int k = 0; k < 2; ++k) { const int row = (lane >> 3) + 8 * k; const u32x4 w = *(const LAS u32x4*)(stg + row * STG_PITCH + (lane & 7) * 16); *(u32x4*)(g0 + (size_t)row * pitch + (lane & 7) * 8) = w; }
}

__device__ __forceinline__ void store_rows16_perm(const u32x4 v0, const u32x4 v1, bf16* g0, int ld, int wid, int lane) {
    LAS unsigned char* stg = (LAS unsigned char*)lds_raw + STG_OFF + wid * STG_WAVE; const int fr = lane & 15, fq = lane >> 4;
    *(LAS u32x4*)(stg + fr * STG_PITCH + fq * 16) = v0; *(LAS u32x4*)(stg + fr * STG_PITCH + 64 + fq * 16) = v1;
#pragma unroll
    for (int k = 0; k < 2; ++k) { const int row = (lane >> 3) + 8 * k; const u32x4 w = *(const LAS u32x4*)(stg + row * STG_PITCH + (lane & 7) * 16);
        const int prow = ((row & ((1 << ld) - 1)) << (12 - ld)) + (row >> ld); *(u32x4*)(g0 + (size_t)prow * 64 + (lane & 7) * 8) = w; }
}

constexpr int EXTRA_OFF = STG_OFF + 8 * STG_WAVE;
__device__ __forceinline__ void rowfac_reset(int wave, int lane) { if (lane == 0) ((LAS int*)((LAS unsigned char*)lds_raw + EXTRA_OFF + 8192))[wave] = -1; }
__device__ __forceinline__ void rowfac_get(float (&rsv)[2][4], const unsigned long long* ssq, const pg8::Unit& u, int wr, int wid, int l_) {
    LAS float* ex = (LAS float*)((LAS unsigned char*)lds_raw + EXTRA_OFF + wid * 1024); const int fr = l_ & 15, fq = l_ >> 4;
    LAS int* idw = (LAS int*)((LAS unsigned char*)lds_raw + EXTRA_OFF + 8192) + wid;
    const int cached = __builtin_amdgcn_readfirstlane(*idw);
    if (cached == u.pm) { EPI_FOR_AM rsv[ai][m] = ex[(ai * 4 + m) * 16 + fr]; }
    else { unsigned long long sq8[2][4];
        EPI_FOR_AM sq8[ai][m] = ssq[EPI_ROW(u, ai, m)];
        EPI_FOR_AM rsv[ai][m] = __builtin_amdgcn_rsqf(ssq_val(sq8[ai][m]) * (1.f / D) + EPS);
        if (fq == 0) { EPI_FOR_AM ex[(ai * 4 + m) * 16 + fr] = rsv[ai][m]; }
        if (l_ == 0) *idw = u.pm; }
}

struct SchedProj { int G, c;
    __device__ __forceinline__ bool next(int i, pg8::Unit& u) const { int pm, pn; if (!pg8::tile_order(T / 256, INW / 256, G, c, i, pm, pn)) return false; u.pm = pm; u.pn = pn; u.ka = HC_H; u.kb = 0; u.nt = 16; u.kind = pn; return true; } };
struct EpiProj { bf16* proj; const float* rope; const unsigned long long* rstd;
    __device__ __forceinline__ void operator()(const AccT& acc, const pg8::Unit& u, int wr, int wc, int, int) const { const int l_ = lane_id(), fr = l_ & 15, fq = l_ >> 4;
        const int pn = u.pn, wid = wr * 4 + wc; const bool dorope = pn < 6; const float sc = (pn < 3 || pn == 9 || pn == 10) ? C2 : 1.f;
        const float sc_ = sc; float rsv[2][4];
        EPI_FOR_AM rsv[ai][m] = 1.f;
        if (rstd) rowfac_get(rsv, rstd, u, wr, wid, l_);
        EPI_FOR_AM { const int row = EPI_ROW(u, ai, m); u32x4 pk[2]; const float sc = sc_ * rsv[ai][m];
#pragma unroll
            for (int bj = 0; bj < 2; ++bj) { f32x4 cs0 = (f32x4){1.f, 0.f, 1.f, 0.f}, cs1 = cs0;
                if (dorope) { const f32x4* rp = (const f32x4*)(rope + ((size_t)row * 32 + 16 * bj + 4 * fq) * 2); cs0 = rp[0]; cs1 = rp[1]; }
                const f32x4 a0 = acc[ai][bj][m][0], a1 = acc[ai][bj][m][1]; f32x4 o0, o1;
                o0[0] = (a0[0] * cs0[0] - a0[1] * cs0[1]) * sc; o0[1] = (a0[1] * cs0[0] + a0[0] * cs0[1]) * sc;
                o0[2] = (a0[2] * cs0[2] - a0[3] * cs0[3]) * sc; o0[3] = (a0[3] * cs0[2] + a0[2] * cs0[3]) * sc;
                o1[0] = (a1[0] * cs1[0] - a1[1] * cs1[1]) * sc; o1[1] = (a1[1] * cs1[0] + a1[0] * cs1[1]) * sc;
                o1[2] = (a1[2] * cs1[2] - a1[3] * cs1[3]) * sc; o1[3] = (a1[3] * cs1[2] + a1[2] * cs1[3]) * sc;
                pk[bj] = pack8(o0, o1); }
            const int t0 = EPI_ROW0(u, ai, m);
            if (pn < 15) { const int ld = pn < 9 ? 2 * (pn % 3) : 0, s0 = t0 & (SEQ - 1);
                store_rows16_perm(pk[0], pk[1], proj + PJ_HM(pn * 4 + wc, (t0 - s0) + (s0 >> ld)), ld, wid, l_); }
            else store_rows16(pk[0], pk[1], proj + PJ_UC + (size_t)t0 * 512 + (pn - 15) * 256 + wc * 64, 512, wid, l_); }
    } };

struct SchedG4 { int G, c;
    __device__ __forceinline__ bool next(int i, pg8::Unit& u) const { const int ti = i / 6, sub = i - ti * 6, b = sub >> 1; int pm, pn; if (!pg8::tile_order(T / 256, 4, G, c, ti, pm, pn)) return false;
        u.pm = pm; u.pn = pn; u.kind = sub;
        if (!(sub & 1)) { u.ka = HC_H; u.kb = b * 1024; u.nt = 16; } else { u.ka = b == 0 ? HC_OA : b == 1 ? HC_OB : HC_PL; u.kb = 3072 + (b == 0 ? 0 : b == 1 ? 256 : 768); u.nt = b == 0 ? 4 : 8; }
        return true; } };
struct EpiG4 { bf16* gt; bf16* mg; const float* bias; const unsigned long long* rstd;
    __device__ __forceinline__ void operator()(const AccT& acc, const pg8::Unit& u, int wr, int wc, int, int) const { const int l_ = lane_id(), fr = l_ & 15, fq = l_ >> 4;
        const int b = u.kind >> 1, wid = wr * 4 + wc, colw = u.pn * 256 + wc * 64, colb = colw + 8 * fq;
        if (!(u.kind & 1)) {
            f32x4 bv[2][2];
            LAS f32x4* bx = (LAS f32x4*)((LAS unsigned char*)lds_raw + EXTRA_OFF + wid * 1024 + 512);
            if (b == 0) { f32x4 b12[2][2][2];
#pragma unroll
                for (int bj = 0; bj < 2; ++bj) { bv[bj][0] = *(const f32x4*)(bias + colb + bj * 32) * NEG_LOG2E; bv[bj][1] = *(const f32x4*)(bias + colb + bj * 32 + 4) * NEG_LOG2E;
#pragma unroll
                    for (int bb = 0; bb < 2; ++bb) { b12[bb][bj][0] = *(const f32x4*)(bias + (bb + 1) * 1024 + colb + bj * 32) * NEG_LOG2E; b12[bb][bj][1] = *(const f32x4*)(bias + (bb + 1) * 1024 + colb + bj * 32 + 4) * NEG_LOG2E; } }
                if (fr == 0) {
#pragma unroll
                    for (int bb = 0; bb < 2; ++bb)
#pragma unroll
                        for (int bj = 0; bj < 2; ++bj) { bx[(bb * 4 + fq) * 4 + bj * 2] = b12[bb][bj][0]; bx[(bb * 4 + fq) * 4 + bj * 2 + 1] = b12[bb][bj][1]; } }
            } else {
#pragma unroll
                for (int bj = 0; bj < 2; ++bj) { bv[bj][0] = bx[((b - 1) * 4 + fq) * 4 + bj * 2]; bv[bj][1] = bx[((b - 1) * 4 + fq) * 4 + bj * 2 + 1]; } }
            float rsv[2][4];
            EPI_FOR_AM rsv[ai][m] = 1.f;
            if (rstd) rowfac_get(rsv, rstd, u, wr, wid, l_);
            EPI_FOR_AM { u32x4 pk[2]; const float rs = rsv[ai][m];
#pragma unroll
                for (int bj = 0; bj < 2; ++bj) { f32x4 v0 = acc[ai][bj][m][0] * rs + bv[bj][0], v1 = acc[ai][bj][m][1] * rs + bv[bj][1];
#pragma unroll
                    for (int e = 0; e < 4; ++e) { v0[e] = sigmoid_pre(v0[e]); v1[e] = sigmoid_pre(v1[e]); }
                    pk[bj] = pack8(v0, v1); }
                store_rows16(pk[0], pk[1], gt + (size_t)EPI_ROW0(u, ai, m) * D + colw, D, wid, l_); }
        } else {
            u32x4 gvb[2][2][2], pvb[2][2][2];
#define G4_LOAD(batch, buf) do { _Pragma("unroll") for (int mm = 0; mm < 2; ++mm) { const size_t off = (size_t)EPI_ROW(u, (batch) >> 1, ((batch) & 1) * 2 + mm) * D + colb; \
                _Pragma("unroll") for (int bj = 0; bj < 2; ++bj) { gvb[buf][mm][bj] = *(const u32x4*)(gt + off + bj * 32); if (b > 0) pvb[buf][mm][bj] = *(const u32x4*)(mg + off + bj * 32); } } } while (0)
            G4_LOAD(0, 0);
#pragma unroll
            for (int batch = 0; batch < 4; ++batch) { const int ai = batch >> 1, buf = batch & 1;
                if (batch < 3) G4_LOAD(batch + 1, (batch + 1) & 1);
#pragma unroll
                for (int mm = 0; mm < 2; ++mm) { const int m = (batch & 1) * 2 + mm; u32x4 pk[2];
#pragma unroll
                    for (int bj = 0; bj < 2; ++bj) { f32x4 g0, g1; unpack8(gvb[buf][mm][bj], g0, g1);
                        f32x4 v0 = acc[ai][bj][m][0] * g0, v1 = acc[ai][bj][m][1] * g1;
                        if (b > 0) { f32x4 p0, p1; unpack8(pvb[buf][mm][bj], p0, p1); v0 += p0; v1 += p1; }
                        pk[bj] = pack8(v0, v1); }
                    store_rows16(pk[0], pk[1], mg + (size_t)EPI_ROW0(u, ai, m) * D + colw, D, wid, l_); }
            }
#undef G4_LOAD
        }
    } };

struct SchedG5 { int G, c;
    __device__ __forceinline__ bool next(int i, pg8::Unit& u) const { int pm, pn; if (!pg8::tile_order(T / 256, 4, G, c, i, pm, pn)) return false; u.pm = pm; u.pn = pn; u.ka = 0; u.kb = 0; u.nt = 16; u.kind = 0; return true; } };
template <bool XF32> struct EpiG5 { const void* x; bf16* xb; int xpitch;
    __device__ __forceinline__ void operator()(const AccT& acc, const pg8::Unit& u, int wr, int wc, int, int) const { const int l_ = lane_id(), fr = l_ & 15, fq = l_ >> 4;
        const int wid = wr * 4 + wc, colw = u.pn * 256 + wc * 64, colb = colw + 8 * fq;
        f32x4 xv[2][2][2][2]; u32x4 xr[2][2][2];
#define G5_LOAD(batch, buf) do { _Pragma("unroll") for (int mm = 0; mm < 2; ++mm) { const size_t off = (size_t)EPI_ROW(u, (batch) >> 1, ((batch) & 1) * 2 + mm) * xpitch + colb; \
            _Pragma("unroll") for (int bj = 0; bj < 2; ++bj) { \
                if (XF32) { xv[buf][mm][bj][0] = *(const f32x4*)((const float*)x + off + bj * 32); xv[buf][mm][bj][1] = *(const f32x4*)((const float*)x + off + bj * 32 + 4); } \
                else xr[buf][mm][bj] = *(const u32x4*)((const bf16*)x + off + bj * 32); } } } while (0)
        G5_LOAD(0, 0);
#pragma unroll
        for (int batch = 0; batch < 4; ++batch) { const int ai = batch >> 1, buf = batch & 1;
            if (batch < 3) G5_LOAD(batch + 1, (batch + 1) & 1);
#pragma unroll
            for (int mm = 0; mm < 2; ++mm) { const int m = (batch & 1) * 2 + mm;
                if (!XF32) { unpack8(xr[buf][mm][0], xv[buf][mm][0][0], xv[buf][mm][0][1]); unpack8(xr[buf][mm][1], xv[buf][mm][1][0], xv[buf][mm][1][1]); }
                store_rows16(pack8(xv[buf][mm][0][0] + acc[ai][0][m][0], xv[buf][mm][0][1] + acc[ai][0][m][1]), pack8(xv[buf][mm][1][0] + acc[ai][1][m][0], xv[buf][mm][1][1] + acc[ai][1][m][1]),
                             xb + (size_t)EPI_ROW0(u, ai, m) * D + colw, D, wid, l_); }
        }
#undef G5_LOAD
    } };

struct SchedPle { int G, c;
    __device__ __forceinline__ bool next(int i, pg8::Unit& u) const { int pm, pn; if (!pg8::tile_order(T / 256, 4, G, c, i, pm, pn)) return false;
        u.pm = pm; u.pn = pn; u.kind = 0; u.ka = 0; u.kb = 0; u.nt = 16; return true; } };
struct EpiPle { const bf16* pin; const bf16* xin_; bf16* xout; int xpitch; const float* rstd; unsigned long long* ssq;
    __device__ __forceinline__ void operator()(const AccT& acc, const pg8::Unit& u, int wr, int wc, int, int) const { const int l_ = lane_id(), fr = l_ & 15, fq = l_ >> 4;
        const int wid = wr * 4 + wc, colw = u.pn * 256 + wc * 64, colb = colw + 8 * fq;
        float rsv[2][4];
        EPI_FOR_AM rsv[ai][m] = rstd[EPI_ROW(u, ai, m)];
        u32x4 pva[2][2], xwa[2][2];
#define PLE_LOAD(g, buf) do { const size_t off = (size_t)EPI_ROW(u, (g) >> 2, (g) & 3) * D + colb; \
            pva[buf][0] = *(const u32x4*)(pin + off); pva[buf][1] = *(const u32x4*)(pin + off + 32); xwa[buf][0] = *(const u32x4*)(xin_ + off); xwa[buf][1] = *(const u32x4*)(xin_ + off + 32); } while (0)
        PLE_LOAD(0, 0);
#pragma unroll
        for (int g = 0; g < 8; ++g) { const int ai = g >> 2, m = g & 3, buf = g & 1; const float rs = rsv[ai][m]; f32x4 r[2][2];
            if (g < 7) PLE_LOAD(g + 1, (g + 1) & 1);
#pragma unroll
            for (int bj = 0; bj < 2; ++bj) { f32x4 g0 = acc[ai][bj][m][0] * rs, g1 = acc[ai][bj][m][1] * rs, p0, p1, x0, x1;
#pragma unroll
                for (int e = 0; e < 4; ++e) { g0[e] = sigmoid_pre(g0[e]); g1[e] = sigmoid_pre(g1[e]); }
                unpack8(pva[buf][bj], p0, p1); unpack8(xwa[buf][bj], x0, x1); r[bj][0] = x0 + p0 * g0; r[bj][1] = x1 + p1 * g1; }
            if (ssq) { const f32x4 q = r[0][0] * r[0][0] + r[0][1] * r[0][1] + r[1][0] * r[1][0] + r[1][1] * r[1][1]; float ps = (q[0] + q[1]) + (q[2] + q[3]); ps += __shfl_xor(ps, 16); ps += __shfl_xor(ps, 32);
                if (l_ < 16) atomicAdd(ssq + EPI_ROW(u, ai, m), ssq_fix(ps)); }
            store_rows16(pack8(r[0][0], r[0][1]), pack8(r[1][0], r[1][1]), xout + (size_t)EPI_ROW0(u, ai, m) * xpitch + colw, xpitch, wid, l_); }
#undef PLE_LOAD
    } };
struct SchedPin { int stride, c2;
    __device__ __forceinline__ bool next(int i, pg8::Unit& u) const { const int ti = c2 + i * stride; if (c2 < 0 || ti >= (T / 256) * 4) return false; u.pm = ti >> 2; u.pn = ti & 3; u.kind = 0; u.ka = 0; u.kb = 1024; u.nt = 4; return true; } };
struct EpiPin { bf16* pin;
    __device__ __forceinline__ void operator()(const AccT& acc, const pg8::Unit& u, int wr, int wc, int, int) const { const int l_ = lane_id();
        const int wid = wr * 4 + wc, colw = u.pn * 256 + wc * 64;
        EPI_FOR_AM store_rows16(pack8(acc[ai][0][m][0], acc[ai][0][m][1]), pack8(acc[ai][1][m][0], acc[ai][1][m][1]), pin + (size_t)EPI_ROW0(u, ai, m) * D + colw, D, wid, l_);
    } };

constexpr int LDS_TILE_OFF = 132096;
struct SchedM1 { int G, c; const LAS int* tile;
    __device__ __forceinline__ bool next(int i, pg8::Unit& u) const { const int nt_ = __builtin_amdgcn_readfirstlane(tile[0]); const int nrem = 2 * nt_ - i * G; if (c >= nrem) return false; const long L = (long)i * G + xcd_remap(c, nrem < G ? nrem : G); const int rt = (int)(L >> 1), hh = (int)(L & 1);
        u.pm = rt; u.pn = __builtin_amdgcn_readfirstlane(tile[1 + rt]) * 2 + hh; u.ka = 0; u.kb = 0; u.nt = 16; u.kind = hh; return true; } };
struct EpiM1 { bf16* hid; const float* wrow;
    __device__ __forceinline__ void operator()(const AccT& acc, const pg8::Unit& u, int wr, int wc, int, int) const { const int l_ = lane_id(), fr = l_ & 15, fq = l_ >> 4;
        const int colb = u.kind * 128 + wc * 32 + 8 * fq;
        f32x2 wv[2][4];
        EPI_FOR_AM wv[ai][m] = *(const f32x2*)(wrow + 2 * (size_t)EPI_ROW(u, ai, m));
        EPI_FOR_AM { const int row = EPI_ROW(u, ai, m); const float w = wv[ai][m][0], rs = wv[ai][m][1]; f32x4 v0, v1;
#pragma unroll
            for (int e = 0; e < 4; ++e) { const float g0 = acc[ai][0][m][0][e] * rs, g1 = acc[ai][0][m][1][e] * rs;
                v0[e] = g0 * fast_sigmoid(g0) * acc[ai][1][m][0][e] * w; v1[e] = g1 * fast_sigmoid(g1) * acc[ai][1][m][1][e] * w; }
            *(u32x4*)(hid + (size_t)row * EXP_H + colb) = pack8(v0, v1); }
    } };
struct SchedM2 { int G, c; const LAS int* tile;
    __device__ __forceinline__ bool next(int i, pg8::Unit& u) const { const int nt_ = __builtin_amdgcn_readfirstlane(tile[0]); const int nrem = 4 * nt_ - i * G; if (c >= nrem) return false; const long L = (long)i * G + xcd_remap(c, nrem < G ? nrem : G); const int rt = (int)(L >> 2), ct = (int)(L & 3);
        u.pm = rt; u.pn = __builtin_amdgcn_readfirstlane(tile[1 + rt]) * 4 + ct; u.ka = 0; u.kb = 0; u.nt = 4; u.kind = ct; return true; } };
struct EpiM2 { bf16* y2;
    __device__ __forceinline__ void operator()(const AccT& acc, const pg8::Unit& u, int wr, int wc, int, int) const { const int l_ = lane_id(), fr = l_ & 15, fq = l_ >> 4;
        const int wid = wr * 4 + wc, colw = u.kind * 256 + wc * 64;
        EPI_FOR_AM store_rows16(pack8(acc[ai][0][m][0], acc[ai][0][m][1]), pack8(acc[ai][1][m][0], acc[ai][1][m][1]), y2 + (size_t)EPI_ROW0(u, ai, m) * D + colw, D, wid, l_);
    } };

struct RmId { __device__ __forceinline__ int operator()(int n) const { return n; } };
struct RmRope { __device__ __forceinline__ int operator()(int n) const { const int hl = n & 63; return n < 1536 ? (n & ~63) + (hl < 32 ? 2 * hl : 2 * (hl - 32) + 1) : n; } };
struct RmGU { int base; __device__ __forceinline__ int operator()(int n) const { const int f = n & 127; return base + (n >> 7) * 256 + 64 * (f >> 5) + (f & 31); } };
template <class RM>
__device__ __forceinline__ void tr_matrix(const float* W, int ldw, int K_, int N_, bf16* dst, int ldt, int kdst0, RM rm, LAS float* scr, int gw, int NGW, int lane, int& base, float wscale = 1.f, const float* kscale = nullptr) {
    const int nb = N_ / 32, cnt = (K_ / 64) * nb;
    f32x4 v[8], vn[8]; float ks[8], ksn[8];
#define TR_LOAD(it_, V, KS) do { const int k0_ = ((it_) / nb) * 64, n0_ = ((it_) % nb) * 32; _Pragma("unroll") for (int j = 0; j < 8; ++j) { \
        V[j] = *(const f32x4*)(W + (size_t)(k0_ + j * 8 + (lane >> 3)) * ldw + n0_ + (lane & 7) * 4); KS[j] = kscale ? kscale[k0_ + j * 8 + (lane >> 3)] : 1.f; } } while (0)
    int it = ((gw - base) % NGW + NGW) % NGW;
    if (it < cnt) TR_LOAD(it, v, ks);
#pragma unroll 1
    for (; it < cnt; it += NGW) {
        const int k0 = (it / nb) * 64, n0 = (it % nb) * 32;
#pragma unroll
        for (int j = 0; j < 8; ++j) { LAS float* d_ = scr + (j * 8 + (lane >> 3)) * 33 + (lane & 7) * 4; const f32x4 w_ = v[j] * (ks[j] * wscale); d_[0] = w_[0]; d_[1] = w_[1]; d_[2] = w_[2]; d_[3] = w_[3]; }
        if (it + NGW < cnt) TR_LOAD(it + NGW, vn, ksn);
        LDS_WAIT(); asm volatile("" ::: "memory");
        const int c = lane & 7;
#pragma unroll
        for (int j = 0; j < 4; ++j) { const int n = (lane >> 3) + 8 * j; const LAS float* s = scr + (8 * c) * 33 + n;
            u32x4 o; o.x = pk2(s[0 * 33], s[1 * 33]); o.y = pk2(s[2 * 33], s[3 * 33]); o.z = pk2(s[4 * 33], s[5 * 33]); o.w = pk2(s[6 * 33], s[7 * 33]);
            *(u32x4*)(dst + (size_t)rm(n0 + n) * ldt + kdst0 + k0 + 8 * c) = o; }
        LDS_WAIT(); asm volatile("" ::: "memory");
#pragma unroll
        for (int j = 0; j < 8; ++j) { v[j] = vn[j]; ks[j] = ksn[j]; }
    }
#undef TR_LOAD
    base += cnt;
}
template <int PART> __device__ __forceinline__ void wconv_part(const Frame& F, int layer, int gw, int NGW) {
    LAS float* scr = (LAS float*)F.lds + F.wave * (64 * 33);
    bf16* W = (bf16*)(F.ws + WS_W); int base = 0;
#define SRC(idx, per_layer) ((const float*)arg_ptr<idx>() + (size_t)layer * (per_layer))
    if (PART == 0) { tr_matrix(SRC(I_W_IN, (size_t)D * INW), INW, D, INW, W + WO_IN, D, 0, RmRope{}, scr, gw, NGW, F.lane, base, 1.f, SRC(I_NORM_MIX, D)); return; }
    if (PART == 1) for (int b = 0; b < 3; ++b) tr_matrix(SRC(I_W_GATE, (size_t)D * NGATE) + b * 1024, NGATE, D, 1024, W + WO_BCAT, BCAT_LD, b * 1024, RmId{}, scr, gw, NGW, F.lane, base, NEG_LOG2E, SRC(I_NORM_MIX, D));
    if (PART == 1) { tr_matrix(SRC(I_W_UP_A, (size_t)256 * D), D, 256, D, W + WO_BCAT, BCAT_LD, 3072, RmId{}, scr, gw, NGW, F.lane, base);
    tr_matrix(SRC(I_W_UP_B, (size_t)512 * D), D, 512, D, W + WO_BCAT, BCAT_LD, 3328, RmId{}, scr, gw, NGW, F.lane, base);
    tr_matrix(SRC(I_W_OUT, (size_t)D * D), D, D, D, W + WO_OUT, D, 0, RmId{}, scr, gw, NGW, F.lane, base);
    tr_matrix(SRC(I_W_PLE_IN, (size_t)PLE_DIM * D), D, PLE_DIM, D, W + WO_PLE, PLE_LD, 1024, RmId{}, scr, gw, NGW, F.lane, base); }
    if (PART == 2) {
        for (int e = 0; e < NEXP; ++e) tr_matrix(SRC(I_W_ED, (size_t)NEXP * EXP_H * D) + (size_t)e * EXP_H * D, D, EXP_H, D, W + WO_M2 + (size_t)e * D * EXP_H, EXP_H, 0, RmId{}, scr, gw, NGW, F.lane, base);
        tr_matrix(SRC(I_W_PLE_GATE, (size_t)D * D), D, D, D, W + WO_PLE, PLE_LD, 0, RmId{}, scr, gw, NGW, F.lane, base, NEG_LOG2E, SRC(I_NORM_PLE, D));
        return;
    }
    for (int e = 0; e < NEXP; ++e) {
        tr_matrix(SRC(I_W_EG, (size_t)NEXP * D * EXP_H) + (size_t)e * D * EXP_H, EXP_H, D, EXP_H, W + WO_M1, D, 0, RmGU{e * 512}, scr, gw, NGW, F.lane, base, 1.f, SRC(I_NORM_MOE, D));
        tr_matrix(SRC(I_W_EU, (size_t)NEXP * D * EXP_H) + (size_t)e * D * EXP_H, EXP_H, D, EXP_H, W + WO_M1, D, 0, RmGU{e * 512 + 32}, scr, gw, NGW, F.lane, base, 1.f, SRC(I_NORM_MOE, D));
    }
    {
        const float* wp = SRC(I_W_POOL, (size_t)4 * 128 * 128); const float* ps = SRC(I_POOL_SCALE, 512); const float* wc = SRC(I_W_UP_C, (size_t)512 * D);
        for (int it = ((gw - base) % NGW + NGW) % NGW; it < 1024; it += NGW) {
            const int kc = it >> 4, n = (it & 15) * 64 + F.lane, g = kc >> 4, kl0 = (kc & 15) * 8;
            const float ps0 = ps[g * 128 + F.lane], ps1 = ps[g * 128 + 64 + F.lane];
            float al[8], ah[8], a[8];
#pragma unroll
            for (int q = 0; q < 8; ++q) { al[q] = wp[(size_t)(g * 128 + kl0 + q) * 128 + F.lane] * ps0; ah[q] = wp[(size_t)(g * 128 + kl0 + q) * 128 + 64 + F.lane] * ps1; a[q] = 0.f; }
            float bv[16], bvn[16];
#pragma unroll
            for (int j = 0; j < 16; ++j) bv[j] = wc[(size_t)(g * 128 + j) * D + n];
#pragma unroll 1
            for (int d0 = 0; d0 < 128; d0 += 16) {
                if (d0 + 16 < 128) {
#pragma unroll
                    for (int j = 0; j < 16; ++j) bvn[j] = wc[(size_t)(g * 128 + d0 + 16 + j) * D + n]; }
#pragma unroll
                for (int j = 0; j < 16; ++j)
#pragma unroll
                    for (int q = 0; q < 8; ++q) { const float av = __builtin_bit_cast(float, __builtin_amdgcn_readlane(__builtin_bit_cast(int, d0 < 64 ? al[q] : ah[q]), (d0 + j) & 63)); a[q] += av * bv[j]; }
#pragma unroll
                for (int j = 0; j < 16; ++j) bv[j] = bvn[j];
            }
            u32x4 o; o.x = pk2(a[0], a[1]); o.y = pk2(a[2], a[3]); o.z = pk2(a[4], a[5]); o.w = pk2(a[6], a[7]);
            *(u32x4*)(W + WO_BCAT + (size_t)n * BCAT_LD + 3840 + kc * 8) = o;
        }
    }
#undef SRC
}
__device__ __forceinline__ void ph_wconv(const Frame& F0, int layer) { PHASE_FRAME(F0);
    wconv_part<0>(F, layer, F.wg * NWAVES + F.wave, F.G * NWAVES);
}
__device__ __forceinline__ void ph_ropetab(const Frame& F0) { PHASE_FRAME(F0);
    float* rope = (float*)(F.ws + WS_ROPE); const int* pos = (const int*)arg_ptr<I_POS>();
    const int step = F.G * NTHREADS, i0 = F.wg * NTHREADS + F.tid;
    for (int ib = i0; ib < T * 32; ib += 4 * step) {
        int pv[4];
#pragma unroll
        for (int k = 0; k < 4; ++k) { const int i = ib + k * step; pv[k] = i < T * 32 ? pos[i >> 5] : 0; }
#pragma unroll
        for (int k = 0; k < 4; ++k) { const int i = ib + k * step; if (i < T * 32) { const int j = i & 31;
            const float inv = exp2f(-(float)j * (13.287712379549449f / 32.0f)); const float ang = (float)pv[k] * inv;
            double rev = (double)ang * 0.15915494309189535; rev -= floor(rev); const float fr = (float)rev;
            *(f32x2*)(rope + (size_t)i * 2) = (f32x2){__builtin_amdgcn_cosf(fr), __builtin_amdgcn_sinf(fr)}; } }
    }
}

__device__ __forceinline__ void ph_proj_fast(const Frame& F0, int layer) { PHASE_FRAME(F0);
    rowfac_reset(F.wave, F.lane);
    const pg8::Gemm g{(const bf16*)(F.ws + WS_HCAT), HC, (const bf16*)(F.ws + WS_W) + WO_IN, D, nullptr};
    pg8::gemm_phase<EpiProj, SchedProj, true>((LAS unsigned char*)F.lds, g, SchedProj{F.G, F.wg}, EpiProj{(bf16*)(F.ws + WS_PROJ), (const float*)(F.ws + WS_ROPE), layer == 0 ? nullptr : (const unsigned long long*)(F.ws + SM_SSQ)}, F.tid);
    constexpr int NBUSY = (T / 256) * (INW / 256) - 4 * 256;
    if (F.G == 256 && F.wg >= NBUSY) wconv_part<1>(F, layer, (F.wg - NBUSY) * NWAVES + F.wave, (F.G - NBUSY) * NWAVES);
    else if (F.G != 256) wconv_part<1>(F, layer, F.wg * NWAVES + F.wave, F.G * NWAVES);
}
__device__ __forceinline__ void ph_g4_fast(const Frame& F0, int layer) { PHASE_FRAME(F0);
    rowfac_reset(F.wave, F.lane);
    const pg8::Gemm g{(const bf16*)(F.ws + WS_HCAT), HC, (const bf16*)(F.ws + WS_W) + WO_BCAT, BCAT_LD, nullptr};
    pg8::gemm_phase<EpiG4, SchedG4, true>((LAS unsigned char*)F.lds, g, SchedG4{F.G, F.wg}, EpiG4{(bf16*)(F.ws + OV_GT), (bf16*)(F.ws + OV_MERGED), (const float*)arg_ptr<I_B_GATE>() + layer * NGATE, layer == 0 ? nullptr : (const unsigned long long*)(F.ws + SM_SSQ)}, F.tid);
}
__device__ __forceinline__ void ph_g5_fast(const Frame& F0, int layer) { PHASE_FRAME(F0);
    const pg8::Gemm g{(const bf16*)(F.ws + OV_MERGED), D, (const bf16*)(F.ws + WS_W) + WO_OUT, D, nullptr};
    if (layer == 0) pg8::gemm_phase<EpiG5<true>, SchedG5, true>((LAS unsigned char*)F.lds, g, SchedG5{F.G, F.wg}, EpiG5<true>{arg_ptr<I_X>(), (bf16*)F.out, D}, F.tid);
    else pg8::gemm_phase<EpiG5<false>, SchedG5, true>((LAS unsigned char*)F.lds, g, SchedG5{F.G, F.wg}, EpiG5<false>{(const void*)((const bf16*)(F.ws + WS_HCAT) + HC_H), (bf16*)F.out, HC}, F.tid);
}
__device__ __forceinline__ void ph_ple_fast(const Frame& F0, int layer) { PHASE_FRAME(F0);
    const pg8::Gemm g{(const bf16*)F.out, D, (const bf16*)(F.ws + WS_W) + WO_PLE, PLE_LD, nullptr};
    const bool last = layer == DEPTH - 1;
    pg8::gemm_phase<EpiPle, SchedPle, true>((LAS unsigned char*)F.lds, g, SchedPle{F.G, F.wg}, EpiPle{(const bf16*)(F.ws + OV_GT), (const bf16*)F.out, last ? (bf16*)(F.ws + OV_X3) : (bf16*)(F.ws + WS_HCAT) + HC_H, last ? D : HC,
        (const float*)(F.ws + SM_RSTD_PLE), last ? nullptr : (unsigned long long*)(F.ws + SM_SSQ)}, F.tid);
}
__device__ __forceinline__ void ph_m1_fast(const Frame& F0, int layer) { PHASE_FRAME(F0);
    const pg8::Gemm g{(const bf16*)F.out, D, (const bf16*)(F.ws + WS_W) + WO_M1, D, (const int*)(F.ws + SM_ROWTOK)};
    { const int* tg = (const int*)(F.ws + SM_TILE); LAS int* tl = (LAS int*)((LAS unsigned char*)F.lds + LDS_TILE_OFF); if (F.tid < 161) tl[F.tid] = tg[F.tid]; __syncthreads(); }
    pg8::gemm_phase<EpiM1, SchedM1, true, true>((LAS unsigned char*)F.lds, g, SchedM1{F.G, F.wg, (const LAS int*)((LAS unsigned char*)F.lds + LDS_TILE_OFF)}, EpiM1{(bf16*)(F.ws + OV_HID), (const float*)(F.ws + SM_WROW)}, F.tid);
    {   const pg8::Gemm gp{(const bf16*)F.out + (size_t)T * D, D, (const bf16*)(F.ws + WS_W) + WO_PLE, PLE_LD, nullptr};
        const bool std_ = F.G == 256;
        if (!std_ || F.wg >= 32) pg8::gemm_phase<EpiPin, SchedPin, true>((LAS unsigned char*)F.lds, gp, SchedPin{std_ ? F.G - 32 : F.G, std_ ? F.wg - 32 : F.wg}, EpiPin{(bf16*)(F.ws + OV_GT)}, F.tid); }
    if (F.G == 256 && F.wg >= 64) { wconv_part<2>(F, layer, (F.wg - 64) * NWAVES + F.wave, (F.G - 64) * NWAVES); if (layer + 1 < DEPTH) wconv_part<0>(F, layer + 1, (F.wg - 64) * NWAVES + F.wave, (F.G - 64) * NWAVES); }
    else if (F.G != 256) { wconv_part<2>(F, layer, F.wg * NWAVES + F.wave, F.G * NWAVES); if (layer + 1 < DEPTH) wconv_part<0>(F, layer + 1, F.wg * NWAVES + F.wave, F.G * NWAVES); }
}
__device__ __forceinline__ void ph_m2_fast(const Frame& F0) { PHASE_FRAME(F0);
    const pg8::Gemm g{(const bf16*)(F.ws + OV_HID), EXP_H, (const bf16*)(F.ws + WS_W) + WO_M2, EXP_H, nullptr};
    { const int* tg = (const int*)(F.ws + SM_TILE); LAS int* tl = (LAS int*)((LAS unsigned char*)F.lds + LDS_TILE_OFF); if (F.tid < 161) tl[F.tid] = tg[F.tid]; __syncthreads(); }
    pg8::gemm_phase<EpiM2, SchedM2, true>((LAS unsigned char*)F.lds, g, SchedM2{F.G, F.wg, (const LAS int*)((LAS unsigned char*)F.lds + LDS_TILE_OFF)}, EpiM2{(bf16*)(F.ws + OV_Y2)}, F.tid);
}

constexpr size_t SM_CHUNK = WS_SMALL + 720 * 1024;
__device__ __forceinline__ int wave_sum_i(int v) {
#pragma unroll
    for (int o = 1; o < 64; o <<= 1) v += __shfl_xor(v, o);
    return v;
}
__device__ __forceinline__ void ph_route2(const Frame& F0, int layer) { PHASE_FRAME(F0);
    const float* g = (const float*)arg_ptr<I_NORM_MOE>() + layer * D;
    const float* wrg = (const float*)arg_ptr<I_W_RG>() + (size_t)layer * D * 4; const float* brg = (const float*)arg_ptr<I_B_RG>() + layer * 4;
    const float* wre = (const float*)arg_ptr<I_W_RE>() + (size_t)layer * 4 * D * 4; const float* bre = (const float*)arg_ptr<I_B_RE>() + layer * 16;
    bf16* hmb = (bf16*)(F.ws + OV_HM); int* eid = (int*)(F.ws + SM_EID); float* wgt = (float*)(F.ws + SM_WGT); int* chunk = (int*)(F.ws + SM_CHUNK);
    {
        const float* p = (const float*)arg_ptr<I_P>() + (size_t)layer * T * PLE_DIM; bf16* pob = (bf16*)F.out + (size_t)T * D; f32x4 pv8[8];
#pragma unroll
        for (int q = 0; q < 8; ++q) pv8[q] = *(const f32x4*)(p + (size_t)(F.wg * 64 + F.wave * 8 + q) * PLE_DIM + F.lane * 4);
#pragma unroll
        for (int q = 0; q < 8; ++q) { u32x2 po; po.x = pk2(pv8[q][0], pv8[q][1]); po.y = pk2(pv8[q][2], pv8[q][3]); *(u32x2*)(pob + (size_t)(F.wg * 64 + F.wave * 8 + q) * D + F.lane * 4) = po; } }
    LAS float* Wl = (LAS float*)F.lds;
    LAS int* cnt = (LAS int*)(F.lds + 5 * 1024 * 4);
    const int tw0 = F.wg * 64 + F.wave * 8;
    unsigned xw[4][8]; f32x2 gk[8];
#pragma unroll
    for (int i = 0; i < 8; ++i) {
#pragma unroll
        for (int q = 0; q < 4; ++q) xw[q][i] = *(const unsigned*)((const bf16*)F.out + (size_t)(tw0 + q) * D + i * 128 + 2 * F.lane);
        gk[i] = *(const f32x2*)(g + i * 128 + 2 * F.lane); }
    for (int i = F.tid; i < 1024; i += NTHREADS) { *(LAS f32x4*)(Wl + (size_t)i * 4) = *(const f32x4*)(wrg + (size_t)i * 4);
#pragma unroll
        for (int gg = 0; gg < 4; ++gg) *(LAS f32x4*)(Wl + ((size_t)(1 + gg) * 1024 + i) * 4) = *(const f32x4*)(wre + ((size_t)gg * D + i) * 4); }
    if (F.tid < 16) cnt[F.tid] = 0;
    __syncthreads();
#pragma unroll 1
    for (int pass = 0; pass < 2; ++pass) {
        const int tk = tw0 + pass * 4;
        float a20[20];
#pragma unroll
        for (int i = 0; i < 20; ++i) a20[i] = 0.f;
#pragma unroll
        for (int i = 0; i < 8; ++i) { const int k = i * 128 + 2 * F.lane;
            const f32x4 w0 = *(const LAS f32x4*)(Wl + (size_t)k * 4), w1 = *(const LAS f32x4*)(Wl + (size_t)(k + 1) * 4);
#pragma unroll
            for (int q = 0; q < 4; ++q) { const float x0 = bflo(xw[q][i]), x1 = bfhi(xw[q][i]); a20[q * 5] += x0 * x0 + x1 * x1; const float y0 = x0 * gk[i][0], y1 = x1 * gk[i][1];
#pragma unroll
                for (int e = 0; e < 4; ++e) a20[q * 5 + 1 + e] += y0 * w0[e] + y1 * w1[e]; } }
        float u5[5];
        {   float w10[10];
#pragma unroll
            for (int i = 0; i < 10; ++i) { const float lo = a20[i], hi_ = a20[10 + i]; const bool up = (F.lane & 32) != 0; const float keep = up ? hi_ : lo, send = up ? lo : hi_; w10[i] = keep + __shfl_xor(send, 32); }
#pragma unroll
            for (int i = 0; i < 5; ++i) { const bool up = (F.lane & 16) != 0; const float keep = up ? w10[i + 5] : w10[i], send = up ? w10[i] : w10[i + 5]; u5[i] = keep + __shfl_xor(send, 16); } }
#pragma unroll
        for (int i = 0; i < 5; ++i) { float v = u5[i]; v += __shfl_xor(v, 8); v += __shfl_xor(v, 4); v += __shfl_xor(v, 2); v += __shfl_xor(v, 1); u5[i] = v; }
        const float rsq = 1.f / sqrtf(u5[0] * (1.f / D) + EPS);
        float lg[4];
#pragma unroll
        for (int e = 0; e < 4; ++e) lg[e] = u5[1 + e] * rsq + brg[e];
        int gi = 0; float mx = lg[0];
#pragma unroll
        for (int e = 1; e < 4; ++e) if (lg[e] > mx) { mx = lg[e]; gi = e; }
        float den = 0.f;
#pragma unroll
        for (int e = 0; e < 4; ++e) den += __expf(lg[e] - mx);
        const float p1 = 1.f / den;
        float rs[4]; int gq[4];
#pragma unroll
        for (int q = 0; q < 4; ++q) { rs[q] = __builtin_bit_cast(float, __builtin_amdgcn_readlane(__builtin_bit_cast(int, rsq), q * 16)); gq[q] = __builtin_amdgcn_readlane(gi, q * 16); }
        float a16[16];
#pragma unroll
        for (int i = 0; i < 16; ++i) a16[i] = 0.f;
#pragma unroll
        for (int i = 0; i < 8; ++i) { const int k = i * 128 + 2 * F.lane;
#pragma unroll
            for (int q = 0; q < 4; ++q) { const LAS float* wq = Wl + ((size_t)(1 + gq[q]) * 1024 + k) * 4; const f32x4 w0 = *(const LAS f32x4*)wq, w1 = *(const LAS f32x4*)(wq + 4);
                const float y0 = bflo(xw[q][i]) * gk[i][0], y1 = bfhi(xw[q][i]) * gk[i][1];
#pragma unroll
                for (int e = 0; e < 4; ++e) a16[q * 4 + e] += y0 * w0[e] + y1 * w1[e]; } }
        float u4[4];
        {   float w8[8];
#pragma unroll
            for (int i = 0; i < 8; ++i) { const float lo = a16[i], hi_ = a16[8 + i]; const bool up = (F.lane & 32) != 0; const float keep = up ? hi_ : lo, send = up ? lo : hi_; w8[i] = keep + __shfl_xor(send, 32); }
#pragma unroll
            for (int i = 0; i < 4; ++i) { const bool up = (F.lane & 16) != 0; const float keep = up ? w8[i + 4] : w8[i], send = up ? w8[i] : w8[i + 4]; u4[i] = keep + __shfl_xor(send, 16); } }
#pragma unroll
        for (int i = 0; i < 4; ++i) { float v = u4[i]; v += __shfl_xor(v, 8); v += __shfl_xor(v, 4); v += __shfl_xor(v, 2); v += __shfl_xor(v, 1); u4[i] = v; }
        if ((F.lane & 15) == 0) {
            const int q = F.lane >> 4;
            float ls[4];
#pragma unroll
            for (int e = 0; e < 4; ++e) ls[e] = u4[e] * rsq + bre[gi * 4 + e];
            int i0 = 0; float v0 = ls[0];
#pragma unroll
            for (int e = 1; e < 4; ++e) if (ls[e] > v0) { v0 = ls[e]; i0 = e; }
            int i1 = -1; float v1 = -3.0e38f;
#pragma unroll
            for (int e = 0; e < 4; ++e) if (e != i0 && ls[e] > v1) { v1 = ls[e]; i1 = e; }
            const float ex = __expf(v1 - v0), w0_ = p1 / (1.f + ex), w1_ = p1 * ex / (1.f + ex);
            const int t = tk + q, ea = gi * 4 + i0, eb = gi * 4 + i1;
            eid[t * 2 + 0] = ea; eid[t * 2 + 1] = eb; wgt[t * 2 + 0] = w0_; wgt[t * 2 + 1] = w1_; ((float*)(F.ws + SM_RSTD_MOE))[t] = rsq;
            __hip_atomic_fetch_add(&cnt[ea], 1, __ATOMIC_RELAXED, __HIP_MEMORY_SCOPE_WORKGROUP); __hip_atomic_fetch_add(&cnt[eb], 1, __ATOMIC_RELAXED, __HIP_MEMORY_SCOPE_WORKGROUP);
        }
        if (pass == 0) {
#pragma unroll
            for (int i = 0; i < 8; ++i)
#pragma unroll
                for (int q = 0; q < 4; ++q) xw[q][i] = *(const unsigned*)((const bf16*)F.out + (size_t)(tw0 + 4 + q) * D + i * 128 + 2 * F.lane); }
    }
    __syncthreads();
    if (F.tid < 16) chunk[F.wg * 16 + F.tid] = cnt[F.tid];
}
__device__ __forceinline__ void ph_scatter2(const Frame& F0) { PHASE_FRAME(F0);
    const int* eid = (const int*)(F.ws + SM_EID); const float* wgt = (const float*)(F.ws + SM_WGT); const int* chunk = (const int*)(F.ws + SM_CHUNK);
    int* rowtok = (int*)(F.ws + SM_ROWTOK); float* wrow = (float*)(F.ws + SM_WROW); int* tile = (int*)(F.ws + SM_TILE);
    LAS int* L = (LAS int*)F.lds;
    const int t0 = F.wg * 64;
    int e0 = 0, e1 = 0; float wg0 = 0.f, wg1 = 0.f, r0 = 0.f, r1 = 0.f;
    if (F.wave == 0) { const float* rstd = (const float*)(F.ws + SM_RSTD_MOE); e0 = eid[t0 * 2 + F.lane]; e1 = eid[t0 * 2 + 64 + F.lane]; wg0 = wgt[t0 * 2 + F.lane]; wg1 = wgt[t0 * 2 + 64 + F.lane]; r0 = rstd[t0 + (F.lane >> 1)]; r1 = rstd[t0 + 32 + (F.lane >> 1)]; }
#pragma unroll
    for (int ee = 0; ee < 2; ++ee) { const int e = 2 * F.wave + ee; int ts = 0, ps = 0;
        for (int ch = F.lane; ch < F.G; ch += 64) { const int v = chunk[ch * 16 + e]; ts += v; ps += (ch < F.wg) ? v : 0; }
        ts = wave_sum_i(ts); ps = wave_sum_i(ps);
        if (F.lane == 0) { L[e] = ts; L[16 + e] = ps; } }
    __syncthreads();
    if (F.tid == 0) { int b = 0;
        for (int e = 0; e < NEXP; ++e) { L[32 + e] = b; const int ntl = (L[e] + 255) >> 8; if (F.wg == 0) for (int q = 0; q < ntl; ++q) tile[1 + (b >> 8) + q] = e; b += ntl << 8; }
        if (F.wg == 0) tile[0] = b >> 8; }
    __syncthreads();
    if (F.wave == 0) {
        int p0 = 0, p1 = 0;
        const unsigned long long below = (1ull << F.lane) - 1ull;
#pragma unroll
        for (int e = 0; e < NEXP; ++e) { const unsigned long long b0 = __ballot(e0 == e), b1 = __ballot(e1 == e);
            if (e0 == e) p0 = __popcll(b0 & below); if (e1 == e) p1 = __popcll(b0) + __popcll(b1 & below); }
        const int s0 = L[32 + e0] + L[16 + e0] + p0, s1 = L[32 + e1] + L[16 + e1] + p1;
        L[64 + F.lane] = s0; L[128 + F.lane] = s1;
        ((int*)(F.ws + SM_SLOT2))[t0 * 2 + F.lane] = s0; ((int*)(F.ws + SM_SLOT2))[t0 * 2 + 64 + F.lane] = s1;
        rowtok[s0] = t0 + (F.lane >> 1); *(f32x2*)(wrow + 2 * (size_t)s0) = (f32x2){wg0 * r0, r0}; rowtok[s1] = t0 + 32 + (F.lane >> 1); *(f32x2*)(wrow + 2 * (size_t)s1) = (f32x2){wg1 * r1, r1};
    }
    __syncthreads();
    for (int e = F.wg; e < NEXP; e += F.G) { const int b = L[32 + e], n = L[e], np = ((n + 255) >> 8) << 8; for (int s = n + F.tid; s < np; s += NTHREADS) { rowtok[b + s] = 0; *(f32x2*)(wrow + 2 * (size_t)(b + s)) = (f32x2){0.f, 0.f}; } }
}
__device__ __forceinline__ void ph_e_fast(const Frame& F0, int layer) { PHASE_FRAME(F0);
    const bf16* y2 = (const bf16*)(F.ws + OV_Y2); const int* slot2 = (const int*)(F.ws + SM_SLOT2);
    u32x2 xw[2][4], ya[2][4], yb[2][4], xwn[2][4], yan[2][4], ybn[2][4];
#define E_LOAD(t0_, XW, YA, YB) do { _Pragma("unroll") for (int r = 0; r < 2; ++r) { const size_t t = (size_t)(t0_) + r; \
        const size_t sa = (size_t)__builtin_amdgcn_readfirstlane(slot2[t * 2]), sb = (size_t)__builtin_amdgcn_readfirstlane(slot2[t * 2 + 1]); \
        _Pragma("unroll") for (int j = 0; j < 4; ++j) { const int k = j * 256 + F.lane * 4; XW[r][j] = *(const u32x2*)((const bf16*)F.out + t * D + k); YA[r][j] = *(const u32x2*)(y2 + sa * D + k); YB[r][j] = *(const u32x2*)(y2 + sb * D + k); } } } while (0)
    const int tstep = F.G * NWAVES * 2; int t0 = (F.wg * NWAVES + F.wave) * 2;
    if (t0 < T) E_LOAD(t0, xw, ya, yb);
#pragma unroll 1
    for (; t0 < T; t0 += tstep) {
        const bool has_next = t0 + tstep < T;
        if (has_next) E_LOAD(t0 + tstep, xwn, yan, ybn);
#pragma unroll
        for (int r = 0; r < 2; ++r) { const size_t t = t0 + r; float s = 0.f; f32x4 xv[4];
#pragma unroll
            for (int j = 0; j < 4; ++j) { f32x4 v = (f32x4){bflo(xw[r][j].x), bfhi(xw[r][j].x), bflo(xw[r][j].y), bfhi(xw[r][j].y)};
                v[0] += bflo(ya[r][j].x) + bflo(yb[r][j].x); v[1] += bfhi(ya[r][j].x) + bfhi(yb[r][j].x); v[2] += bflo(ya[r][j].y) + bflo(yb[r][j].y); v[3] += bfhi(ya[r][j].y) + bfhi(yb[r][j].y);
                xv[j] = v; s += (v[0] * v[0] + v[1] * v[1]) + (v[2] * v[2] + v[3] * v[3]); u32x2 xo; xo.x = pk2(v[0], v[1]); xo.y = pk2(v[2], v[3]); *(u32x2*)((bf16*)F.out + t * D + j * 256 + F.lane * 4) = xo; }
            const float rr = 1.f / sqrtf(wave_sum(s) * (1.f / D) + EPS);
            if (F.lane == 0) { ((float*)(F.ws + SM_RSTD_PLE))[t] = rr;
                if (layer + 1 < DEPTH) ((unsigned long long*)(F.ws + SM_SSQ))[t] = 0ull; }
        }
        if (has_next) {
#pragma unroll
            for (int r = 0; r < 2; ++r) {
#pragma unroll
                for (int j = 0; j < 4; ++j) { xw[r][j] = xwn[r][j]; ya[r][j] = yan[r][j]; yb[r][j] = ybn[r][j]; } } }
    }
#undef E_LOAD
}


typedef float f32x16 __attribute__((ext_vector_type(16)));
typedef short s16x4 __attribute__((ext_vector_type(4)));
#define MFMA32(a, b, c) __builtin_amdgcn_mfma_f32_32x32x16_bf16((a), (b), (c), 0, 0, 0)
constexpr int AT_K = 0, AT_V = 49152, AT_OST = 98304, AT_FLAG = 131072;
constexpr float NEG_BIG = -1.0e30f;
#ifndef SB_EARLY_EXIT
#define SB_EARLY_EXIT 1
#endif
constexpr float SB_EXIT_THR = 160.0f;

__device__ __forceinline__ int crow(int r, int hi) { return (r & 3) + 8 * (r >> 2) + 4 * hi; }
template <int S> __device__ __forceinline__ bf16x8 pack_step(const f32x16& x) {
    u32x4 p; p.x = cvt_pk_bf16(x[8 * S], x[8 * S + 1]); p.y = cvt_pk_bf16(x[8 * S + 2], x[8 * S + 3]); p.z = cvt_pk_bf16(x[8 * S + 4], x[8 * S + 5]); p.w = cvt_pk_bf16(x[8 * S + 6], x[8 * S + 7]);
    return __builtin_bit_cast(bf16x8, p); }
__device__ __forceinline__ void glds16(const void* gsrc, LAS unsigned char* dst) { __builtin_amdgcn_global_load_lds((const unsigned*)gsrc, (LAS unsigned*)dst, 16, 0, 0); }
typedef short v4i16_t __attribute__((ext_vector_type(4)));
__device__ __forceinline__ s16x4 vtr(const LAS unsigned char* p) { return __builtin_bit_cast(s16x4, __builtin_amdgcn_ds_read_tr16_b64_v4i16((LAS v4i16_t*)p)); }
#define AT_WAITBAR() asm volatile("s_waitcnt vmcnt(0) lgkmcnt(0)\n\ts_barrier" ::: "memory")

__device__ __forceinline__ void at_qkt(f32x16& p0, f32x16& p1, const LAS unsigned char* kt, const bf16x8 (&qr)[4], int r32, int hi) {
    const LAS unsigned char* kb = kt + r32 * 128; const int x = r32 & 7;
    const f32x16 zero = {0.f, 0.f, 0.f, 0.f, 0.f, 0.f, 0.f, 0.f, 0.f, 0.f, 0.f, 0.f, 0.f, 0.f, 0.f, 0.f};
#pragma unroll
    for (int d0 = 0; d0 < 4; ++d0) { const int off = ((2 * d0 + hi) ^ x) * 16; const bf16x8 b0 = *(const LAS bf16x8*)(kb + off), b1 = *(const LAS bf16x8*)(kb + 4096 + off);
        p0 = MFMA32(b0, qr[d0], d0 == 0 ? zero : p0); p1 = MFMA32(b1, qr[d0], d0 == 0 ? zero : p1); }
}
__device__ __forceinline__ void at_pv(f32x16& o0, f32x16& o1, const LAS unsigned char* vt, int lane, int hi, bf16x8 pa0, bf16x8 pa1, bf16x8 pa2, bf16x8 pa3) {
    const LAS unsigned char* vp = vt + ((lane >> 4) & 1) * 32 + (lane & 3) * 8 + (4 * hi + ((lane & 15) >> 2)) * 64;
#define AT_VF(off) ({ const s16x4 lo_ = vtr(vp + (off)), hi_ = vtr(vp + (off) + 512); (bf16x8){lo_[0], lo_[1], lo_[2], lo_[3], hi_[0], hi_[1], hi_[2], hi_[3]}; })
    o0 = MFMA32(pa0, AT_VF(0), o0);    o0 = MFMA32(pa1, AT_VF(1024), o0); o0 = MFMA32(pa2, AT_VF(2048), o0); o0 = MFMA32(pa3, AT_VF(3072), o0);
    o1 = MFMA32(pa0, AT_VF(4096), o1); o1 = MFMA32(pa1, AT_VF(5120), o1); o1 = MFMA32(pa2, AT_VF(6144), o1); o1 = MFMA32(pa3, AT_VF(7168), o1);
#undef AT_VF
}
template <class RowPtr>
__device__ __forceinline__ void at_store_o(const f32x16& o0, const f32x16& o1, const float (&sc)[16], LAS unsigned char* lds, int wid, int lane, RowPtr rowptr) {
    const int r32 = lane & 31, hi = lane >> 5; LAS bf16* stg = (LAS bf16*)(lds + AT_OST + wid * 4096);
#pragma unroll
    for (int r = 0; r < 16; ++r) { const int orow = crow(r, hi); const unsigned pk = cvt_pk_bf16(o0[r] * sc[r], o1[r] * sc[r]); stg[orow * 64 + r32] = (bf16)(pk & 0xffffu); stg[orow * 64 + 32 + r32] = (bf16)(pk >> 16); }
    LDS_WAIT();
#pragma unroll
    for (int i = 0; i < 4; ++i) { const int row = i * 8 + (lane >> 3), ch = lane & 7; const u32x4 v = *(const LAS u32x4*)(stg + row * 64 + ch * 8); *(u32x4*)(rowptr(row) + ch * 8) = v; }
}

struct SbRow { bf16* base; __device__ __forceinline__ bf16* operator()(int row) const { return base + (size_t)row * HC; } };
__device__ __forceinline__ void sb_unit(const Frame& F, int b, int h, int qb, const bf16* proj, bf16* hc) {
    LAS unsigned char* lds = (LAS unsigned char*)lds_raw;
    const int lane = F.lane, r32 = lane & 31, hi = lane >> 5, wid = F.wave;
    const size_t rowbase = (size_t)b * SEQ; const int q0 = qb * 256;
    const bf16* Qw = proj + PJ_HM(36 + h, rowbase + q0 + wid * 32);
    const bf16* ksrc = proj + PJ_HM(44 + h, rowbase + 8 * wid + (lane >> 3)) + (((lane & 7) ^ ((lane >> 3) & 7)) * 8);
    const bf16* vsrc = proj + PJ_HM(52 + h, rowbase + 16 * (wid & 3) + (lane >> 2)) + (wid >> 2) * 32 + (lane & 3) * 8;
#define SB_DMA(t, slot) do { glds16(ksrc + (size_t)(t) * 64 * 64, lds + AT_K + (slot) * 8192 + wid * 1024); glds16(vsrc + (size_t)(t) * 64 * 64, lds + AT_V + (slot) * 8192 + wid * 1024); } while (0)
    bf16x8 qr[4];
#pragma unroll
    for (int d0 = 0; d0 < 4; ++d0) qr[d0] = *(const bf16x8*)(Qw + (size_t)r32 * 64 + d0 * 16 + hi * 8);
    bf16x8 tri0, tri1, ones;
#pragma unroll
    for (int j = 0; j < 8; ++j) { const int k0 = 8 * (j >> 2) + 4 * hi + (j & 3); tri0[j] = (k0 >= r32) ? (short)0x3F80 : (short)0; tri1[j] = (16 + k0 >= r32) ? (short)0x3F80 : (short)0; ones[j] = (short)0x3F80; }
    const int NT = 4 * (qb + 1), jd = 4 * qb + (wid >> 1), qpos = q0 + wid * 32 + r32;
    f32x16 o0, o1;
#pragma unroll
    for (int r = 0; r < 16; ++r) { o0[r] = 0.f; o1[r] = 0.f; }
    float carry = 0.f;
    SB_DMA(NT - 1, 0); AT_WAITBAR();
    int cur = 0; bool wdone = false;
    for (int t = NT - 1; t >= 0; --t) {
        if (t > 0) SB_DMA(t - 1, cur ^ 1);
        if (t <= jd && !wdone) {
            f32x16 z0, z1;
            at_qkt(z0, z1, lds + AT_K + cur * 8192, qr, r32, hi);
            if (t == jd) { const int kb_ = 64 * t + 4 * hi;
#pragma unroll
                for (int r = 0; r < 16; ++r) { const int kv = kb_ + (r & 3) + 8 * (r >> 2); if (kv >= qpos) z0[r] = NEG_BIG; if (kv + 32 >= qpos) z1[r] = NEG_BIG; } }
            f32x16 s0, s1;
#pragma unroll
            for (int r = 0; r < 16; ++r) { z0[r] = __builtin_amdgcn_fmed3f(z0[r], 126.f, -3.0e38f); z1[r] = __builtin_amdgcn_fmed3f(z1[r], 126.f, -3.0e38f);
                s0[r] = __builtin_amdgcn_logf(1.f + __builtin_amdgcn_exp2f(z0[r])); s1[r] = __builtin_amdgcn_logf(1.f + __builtin_amdgcn_exp2f(z1[r])); }
            const bf16x8 x0a = pack_step<0>(s0), x0b = pack_step<1>(s0), x1a = pack_step<0>(s1), x1b = pack_step<1>(s1);
            f32x16 T1, y1, y0;
#pragma unroll
            for (int r = 0; r < 16; ++r) { T1[r] = carry; y1[r] = carry - z1[r]; }
            T1 = MFMA32(ones, x1a, T1); T1 = MFMA32(ones, x1b, T1);
            y1 = MFMA32(tri0, x1a, y1); y1 = MFMA32(tri1, x1b, y1);
#pragma unroll
            for (int r = 0; r < 16; ++r) y0[r] = T1[r] - z0[r];
            y0 = MFMA32(tri0, x0a, y0); y0 = MFMA32(tri1, x0b, y0);
            T1 = MFMA32(ones, x0a, T1); T1 = MFMA32(ones, x0b, T1); carry = T1[0];
#pragma unroll
            for (int r = 0; r < 16; ++r) { y0[r] = __builtin_amdgcn_exp2f(-y0[r]); y1[r] = __builtin_amdgcn_exp2f(-y1[r]); }
            at_pv(o0, o1, lds + AT_V + cur * 8192, lane, hi, pack_step<0>(y0), pack_step<1>(y0), pack_step<0>(y1), pack_step<1>(y1));
        }
        if (SB_EARLY_EXIT) { wdone = __all(carry > SB_EXIT_THR) != 0; if (lane == 0) ((LAS int*)(lds + AT_FLAG))[(t & 1) * 8 + wid] = wdone ? 1 : 0; }
        AT_WAITBAR();
        if (SB_EARLY_EXIT) { const LAS int* fl = (const LAS int*)(lds + AT_FLAG) + (t & 1) * 8; const int all = fl[0] & fl[1] & fl[2] & fl[3] & fl[4] & fl[5] & fl[6] & fl[7];
            if (__builtin_amdgcn_readfirstlane(all)) break; }
        cur ^= 1;
    }
#undef SB_DMA
    float one[16];
#pragma unroll
    for (int r = 0; r < 16; ++r) one[r] = 1.f;
    at_store_o(o0, o1, one, lds, wid, lane, SbRow{hc + (rowbase + q0 + wid * 32) * HC + HC_OB + h * 64});
    AT_WAITBAR();
}
__device__ __forceinline__ void ph_sb_fast(const Frame& F0) { PHASE_FRAME(F0);
    const bf16* proj = (const bf16*)(F.ws + WS_PROJ); bf16* hc = (bf16*)(F.ws + WS_HCAT);
    for (int idx0 = F.wg; idx0 < 256; idx0 += F.G) { const int idx = F.G == 256 ? xcd_remap(idx0, 256) : idx0, bh = idx >> 3, s = idx & 7;
        sb_unit(F, bh >> 3, bh & 7, 15 - s, proj, hc); sb_unit(F, bh >> 3, bh & 7, s, proj, hc); }
}

struct DilRow { bf16* base; size_t stride; __device__ __forceinline__ bf16* operator()(int row) const { return base + (size_t)row * stride; } };
struct DilUnit { int b, gj, res, blk, d, l0; size_t rowbase, prow; };
__device__ __forceinline__ DilUnit dil_decode(int u) { DilUnit U; const int x = u & 15, bgj = u >> 4; U.gj = bgj % 12; U.b = bgj / 12; const int g = U.gj >> 2;
    U.res = g == 0 ? 0 : (g == 1 ? (x >> 2) : x); U.blk = g == 0 ? x : (g == 1 ? (x & 3) : 0); U.d = (g == 0) ? 1 : (g == 1 ? 4 : 16); U.l0 = U.blk * 256; U.rowbase = (size_t)U.b * SEQ; U.prow = U.rowbase + (size_t)U.res * (SEQ / U.d); return U; }
__device__ __forceinline__ void dil_issue_k(const DilUnit& U, const bf16* proj, LAS unsigned char* lds, int wid, int lane) {
#pragma unroll 1
    for (int tile = 0; tile < 6; ++tile) { int lk = U.l0 - 128 + tile * 64 + 8 * wid + (lane >> 3); lk = lk < 0 ? 0 : lk;
        glds16(proj + PJ_HM(12 + U.gj, U.prow + lk) + (((lane & 7) ^ ((lane >> 3) & 7)) * 8), lds + AT_K + tile * 8192 + wid * 1024); } }
__device__ __forceinline__ void dil_issue_v(const DilUnit& U, const bf16* proj, LAS unsigned char* lds, int wid, int lane) {
#pragma unroll 1
    for (int tile = 0; tile < 6; ++tile) { int lv = U.l0 - 128 + tile * 64 + 16 * (wid & 3) + (lane >> 2); lv = lv < 0 ? 0 : lv;
        glds16(proj + PJ_HM(24 + U.gj, U.prow + lv) + (wid >> 2) * 32 + (lane & 3) * 8, lds + AT_V + tile * 8192 + wid * 1024); } }
__device__ __forceinline__ void dil_load_q(const DilUnit& U, const bf16* proj, bf16x8 (&q)[4], int wid, int r32, int hi) {
    const bf16* qp = proj + PJ_HM(U.gj, U.prow + U.l0 + 32 * wid + r32);
#pragma unroll
    for (int d0 = 0; d0 < 4; ++d0) q[d0] = *(const bf16x8*)(qp + d0 * 16 + hi * 8); }
#define AT_BAR() asm volatile("s_waitcnt lgkmcnt(0)\n\ts_barrier" ::: "memory")
__device__ __forceinline__ void ph_dil_fast(const Frame& F0) { PHASE_FRAME(F0);
    bf16* proj = (bf16*)(F.ws + WS_PROJ); float* lse = (float*)(F.ws + WS_LSE);
    LAS unsigned char* lds = (LAS unsigned char*)lds_raw;
    const int lane = F.lane, r32 = lane & 31, hi = lane >> 5, wid = F.wave;
    const int NU = BATCH * 12 * 16;
    if (F.wg >= NU) return;
    const int c_ = F.G == 256 ? xcd_remap(F.wg, 256) : F.wg;
    DilUnit U = dil_decode(c_);
    bf16x8 qr[4], qn[4];
    dil_load_q(U, proj, qr, wid, r32, hi);
    asm volatile("s_waitcnt vmcnt(0)" : "+v"(qr[0]), "+v"(qr[1]), "+v"(qr[2]), "+v"(qr[3]) :: "memory");
    dil_issue_k(U, proj, lds, wid, lane); dil_issue_v(U, proj, lds, wid, lane);
#pragma unroll 1
    for (int u = c_; u < NU; u += F.G) {
        const bool has_next = u + F.G < NU; DilUnit UN = U;
        asm volatile("s_waitcnt vmcnt(6)" ::: "memory"); AT_BAR();
        if (has_next) { UN = dil_decode(u + F.G); dil_load_q(UN, proj, qn, wid, r32, hi); }
        const int l0 = U.l0, qloc = 32 * wid + r32, tb = wid >> 1, kmin = (128 - l0) > qloc ? (128 - l0) : qloc, kmax = qloc + 128;
        f32x16 za[3], zb[3]; float m = NEG_BIG;
#pragma unroll
        for (int ti = 0; ti < 3; ++ti) {
            at_qkt(za[ti], zb[ti], lds + AT_K + (tb + ti) * 8192, qr, r32, hi);
            const int thr_lo = kmin - 64 * (tb + ti) - 4 * hi, thr_hi = kmax - 64 * (tb + ti) - 4 * hi;
            if (ti == 0 || l0 == 0) {
#pragma unroll
                for (int r = 0; r < 16; ++r) { const int C = (r & 3) + 8 * (r >> 2); za[ti][r] = (C >= thr_lo) ? za[ti][r] : NEG_BIG; zb[ti][r] = (C + 32 >= thr_lo) ? zb[ti][r] : NEG_BIG; } }
            if (ti == 2) {
#pragma unroll
                for (int r = 0; r < 16; ++r) { const int C = (r & 3) + 8 * (r >> 2); za[ti][r] = (C <= thr_hi) ? za[ti][r] : NEG_BIG; zb[ti][r] = (C + 32 <= thr_hi) ? zb[ti][r] : NEG_BIG; } }
#pragma unroll
            for (int r = 0; r < 16; r += 2) m = fmaxf(fmaxf(m, fmaxf(za[ti][r], zb[ti][r])), fmaxf(za[ti][r + 1], zb[ti][r + 1]));
        }
        AT_BAR();
        asm volatile("s_waitcnt vmcnt(0)" : "+v"(qn[0]), "+v"(qn[1]), "+v"(qn[2]), "+v"(qn[3]) :: "memory");
        if (has_next) dil_issue_k(UN, proj, lds, wid, lane);
        m = fmaxf(m, __shfl_xor(m, 32));
        float l = 0.f;
#pragma unroll
        for (int ti = 0; ti < 3; ++ti)
#pragma unroll
            for (int r = 0; r < 16; ++r) { za[ti][r] = __builtin_amdgcn_exp2f(za[ti][r] - m); zb[ti][r] = __builtin_amdgcn_exp2f(zb[ti][r] - m); l += za[ti][r] + zb[ti][r]; }
        l += __shfl_xor(l, 32);
        AT_BAR();
        f32x16 o0, o1;
#pragma unroll
        for (int r = 0; r < 16; ++r) { o0[r] = 0.f; o1[r] = 0.f; }
#pragma unroll
        for (int ti = 0; ti < 3; ++ti) at_pv(o0, o1, lds + AT_V + (tb + ti) * 8192, lane, hi, pack_step<0>(za[ti]), pack_step<1>(za[ti]), pack_step<0>(zb[ti]), pack_step<1>(zb[ti]));
        AT_BAR();
        const size_t qrow = U.rowbase + (size_t)(l0 + qloc) * U.d + U.res;
        LAS float* lsc = (LAS float*)(lds + AT_OST + wid * 4096);
        if (hi == 0) { lsc[r32] = 1.f / l; lse[qrow * 12 + U.gj] = m + __builtin_amdgcn_logf(l); }
        LDS_WAIT();
        float sc[16];
#pragma unroll
        for (int r = 0; r < 16; ++r) sc[r] = lsc[crow(r, hi)];
        LDS_WAIT();
        at_store_o(o0, o1, sc, lds, wid, lane, DilRow{proj + PJ_HM(U.gj, U.prow + l0 + 32 * wid), (size_t)64});
        if (has_next) { dil_issue_v(UN, proj, lds, wid, lane);
#pragma unroll
            for (int d0 = 0; d0 < 4; ++d0) qr[d0] = qn[d0]; U = UN; }
    }
    AT_WAITBAR();
}
template <int W> __device__ __forceinline__ void pool_item(const bf16* uc, bf16* hc, int t0, int s0, int c) {
    unsigned uv[32 + W - 1];
#pragma unroll
    for (int k = 0; k < 32 + W - 1; ++k) { const int dt = k - (W - 1); uv[k] = (s0 + dt >= 0) ? *(const unsigned*)(uc + (size_t)(t0 + dt) * 512 + c) : 0u; }
    float sa = 0.f, sb = 0.f;
#pragma unroll
    for (int k = 0; k < W - 1; ++k) { sa += bflo(uv[k]); sb += bfhi(uv[k]); }
#pragma unroll
    for (int tt = 0; tt < 32; ++tt) { const int s = s0 + tt; const unsigned u = uv[tt + W - 1]; const float ua = bflo(u), ub = bfhi(u);
        sa += ua; sb += ub;
        const float rc = 1.f / (float)((s + 1 < W) ? s + 1 : W);
        *(unsigned*)(hc + (size_t)(t0 + tt) * HC + HC_PL + c) = pk2(sa * rc - ua, sb * rc - ub);
        sa -= bflo(uv[tt]); sb -= bfhi(uv[tt]); }
}
__device__ __forceinline__ void ph_pool_fast(const Frame& F0) { PHASE_FRAME(F0);
    const bf16* uc = (const bf16*)(F.ws + WS_PROJ) + PJ_UC; bf16* hc = (bf16*)(F.ws + WS_HCAT);
    for (int i = F.wg * NTHREADS + F.tid; i < (T / 32) * 256; i += F.G * NTHREADS) {
        const int cp = i & 255, chunk = i >> 8, c = cp * 2, g = __builtin_amdgcn_readfirstlane(c >> 7), t0 = chunk * 32, s0 = t0 % SEQ;
        if (g == 0) pool_item<2>(uc, hc, t0, s0, c); else if (g == 1) pool_item<4>(uc, hc, t0, s0, c); else if (g == 2) pool_item<8>(uc, hc, t0, s0, c); else pool_item<16>(uc, hc, t0, s0, c);
    }
}

typedef __attribute__((address_space(1))) unsigned gu32;
#define RLX_AGENT __ATOMIC_RELAXED, __HIP_MEMORY_SCOPE_AGENT
#define XB_TMO      128
#define XB_XCNT(j)  (256  + 64 * (j))
#define XB_XSUB(j)  (1280 + 64 * (j))
#define XB_XGEN(j)  (2304 + 64 * (j))
#define XB_TOP      3328
#define XB_TOPGEN   3392
#define XCD_BAR_WORDS 3456
#define XB_SPIN_CAP (1u << 18)
__device__ __forceinline__ unsigned xb_ld(unsigned* p)              { return __hip_atomic_load(p, __ATOMIC_RELAXED, __HIP_MEMORY_SCOPE_AGENT); }
__device__ __forceinline__ unsigned xb_add(unsigned* p, unsigned v) { return __hip_atomic_fetch_add(p, v, __ATOMIC_RELAXED, __HIP_MEMORY_SCOPE_AGENT); }
__device__ __forceinline__ unsigned xb_xcc_id() { return (unsigned)__builtin_amdgcn_s_getreg((3 << 11) | 20) & 0xFu; }
#define XB_SPIN(cond, bar) do { unsigned _sp = 0; while (cond) { __builtin_amdgcn_s_sleep(1); \
    if ((++_sp & 255u) == 0u) { if (xb_ld(&(bar)[XB_TMO])) break; if (_sp > XB_SPIN_CAP) { atomicAdd(&(bar)[XB_TMO], 1u); break; } } } } while (0)
struct XcdBarrier { unsigned* bar; unsigned x; volatile LAS unsigned* st; };
__device__ __forceinline__ XcdBarrier xcd_barrier_post(unsigned* bar, volatile LAS unsigned* st, bool t0) {
    XcdBarrier b; b.bar = bar; b.x = xb_xcc_id(); b.st = st;
    if (t0) (void)xb_add(&bar[XB_XCNT(b.x)], 1u);
    return b;
}
__device__ __forceinline__ void xcd_barrier_complete(unsigned* bar, unsigned x, unsigned& nloc, unsigned& nx) {
    const unsigned G = gridDim.x * gridDim.y * gridDim.z;
    unsigned sum, cnt, mine, sp = 0u;
    for (;;) {
        sum = 0u; cnt = 0u; mine = 0u;
#pragma unroll
        for (unsigned j = 0; j < 16; ++j) { const unsigned c = xb_ld(&bar[XB_XCNT(j)]); sum += c; cnt += (c > 0u) ? 1u : 0u; mine = (j == x) ? c : mine; }
        if (sum == G) break;
        __builtin_amdgcn_s_sleep(1);
        if ((++sp & 255u) == 0u) { if (xb_ld(&bar[XB_TMO])) break; if (sp > XB_SPIN_CAP) { atomicAdd(&bar[XB_TMO], 1u); break; } }
    }
    nloc = mine > 0u ? mine : 1u; nx = cnt > 0u ? cnt : 1u;
}
__device__ __forceinline__ void xcd_barrier(const XcdBarrier& b, bool t0) {
    asm volatile("s_waitcnt vmcnt(0)" ::: "memory");
    __syncthreads();
    if (t0) {
        unsigned* bar = b.bar;
        __builtin_amdgcn_s_waitcnt(0);
        unsigned nloc = b.st[0], nx = b.st[1];
        if (nloc == 0u) { xcd_barrier_complete(bar, b.x, nloc, nx); b.st[0] = nloc; b.st[1] = nx; }
        const unsigned old = xb_add(&bar[XB_XSUB(b.x)], 1u);
        const unsigned gen = old / nloc;
        if (old + 1u == (gen + 1u) * nloc) {
            __builtin_amdgcn_fence(__ATOMIC_RELEASE, "agent");
            asm volatile("s_waitcnt vmcnt(0)" ::: "memory");
            const unsigned og = xb_add(&bar[XB_TOP], 1u);
            const unsigned tg = og / nx;
            if (og + 1u == (tg + 1u) * nx) xb_add(&bar[XB_TOPGEN], 1u);
            else XB_SPIN(xb_ld(&bar[XB_TOPGEN]) == tg, bar);
            __builtin_amdgcn_fence(__ATOMIC_ACQUIRE, "agent");
            xb_add(&bar[XB_XGEN(b.x)], 1u);
            asm volatile("s_waitcnt vmcnt(0)" ::: "memory");
        } else {
            XB_SPIN(xb_ld(&bar[XB_XGEN(b.x)]) == gen, bar);
            __builtin_amdgcn_fence(__ATOMIC_ACQUIRE, "agent");
            asm volatile("s_waitcnt vmcnt(0)" ::: "memory");
        }
    }
    __syncthreads();
}

#define USE_FAST_DIL 1
#define USE_FAST_SB 1
#define USE_FAST_POOL 1
constexpr int LDS_BYTES = 163840, MISC_OFF = 131072 + 320;
constexpr int CW_BAR = 4096;

__global__ void __launch_bounds__(NTHREADS, 2) mega(Args args) {
    Frame F{}; F.wave = __builtin_amdgcn_readfirstlane((int)threadIdx.x >> 6);
    volatile LAS unsigned* MISC = (volatile LAS unsigned*)((LAS unsigned char*)lds_raw + MISC_OFF);
    if (threadIdx.x < 32) MISC[threadIdx.x] = 0u;
    __syncthreads();
    (void)xcd_barrier_post((unsigned*)((unsigned char*)arg_ptr<26>() + WS_CTL) + CW_BAR, MISC + 8, threadIdx.x == 0);
#define GRID_BAR() do { XcdBarrier b_; b_.bar = (unsigned*)((unsigned char*)arg_ptr<26>() + WS_CTL) + CW_BAR; b_.x = xb_xcc_id(); b_.st = MISC + 8; xcd_barrier(b_, F.wave == 0 && lane_id() == 0); } while (0)
#define LAYER_PROGRAM(layer) do { \
        if (layer == 0) { ph_wconv(F, layer); ph_norm1(F, layer); ph_ropetab(F); \
        GRID_BAR(); } \
        ph_proj_fast(F, layer); \
        GRID_BAR(); \
        if (USE_FAST_DIL) ph_dil_fast(F); else ph_dil_naive(F); if (USE_FAST_SB) ph_sb_fast(F); else ph_sb_naive(F); if (USE_FAST_POOL) ph_pool_fast(F); else ph_pool_naive(F); \
        GRID_BAR(); \
        ph_comb_naive(F, layer); \
        GRID_BAR(); \
        ph_g4_fast(F, layer); \
        GRID_BAR(); \
        ph_g5_fast(F, layer); \
        GRID_BAR(); \
        ph_route2(F, layer); \
        GRID_BAR(); \
        ph_scatter2(F); \
        GRID_BAR(); \
        ph_m1_fast(F, layer); \
        GRID_BAR(); \
        ph_m2_fast(F); \
        GRID_BAR(); \
        ph_e_fast(F, layer); \
        GRID_BAR(); \
        ph_ple_fast(F, layer); \
        GRID_BAR(); \
     \
    } while (0)
    LAYER_PROGRAM(0);
    LAYER_PROGRAM(1);
    ph_final(F);
}

extern "C" void kernel_launch(void* const* d_in, const int* in_sizes, int n_in, void* d_out, int out_size, void* d_ws, size_t ws_size, hipStream_t stream) {
    static int grid = 0;
    if (grid == 0) {
        if (n_in != N_IN || out_size != T * D || ws_size < WS_END) { fprintf(stderr, "kernel_launch: unexpected shapes n_in %d out %d ws %zu\n", n_in, out_size, ws_size); grid = -1; return; }
        int dev = 0, cus = 0, per_cu = 0;
        (void)hipGetDevice(&dev); (void)hipDeviceGetAttribute(&cus, hipDeviceAttributeMultiprocessorCount, dev);
        if (hipFuncSetAttribute((const void*)mega, hipFuncAttributeMaxDynamicSharedMemorySize, LDS_BYTES) != hipSuccess) { fprintf(stderr, "kernel_launch: hipFuncSetAttribute failed\n"); grid = -1; return; }
        if (hipOccupancyMaxActiveBlocksPerMultiprocessor(&per_cu, (const void*)mega, NTHREADS, LDS_BYTES) != hipSuccess || per_cu < 1) { fprintf(stderr, "kernel_launch: occupancy query says %d blocks per CU\n", per_cu); grid = -1; return; }
        (void)hipGetLastError();
        if (cus < 256) { fprintf(stderr, "kernel_launch: needs >= 256 CUs\n"); grid = -1; return; }
        grid = 256;
    }
    if (grid < 0) return;
    (void)hipMemsetAsync((char*)d_ws + WS_CTL, 0, 32 * 1024, stream);
    Args a{};
    for (int i = 0; i < N_IN; ++i) a.in[i] = d_in[i];
    a.out = (float*)d_out; a.ws = (unsigned char*)d_ws;
    void* kargs[] = {&a};
    hipError_t e = hipLaunchCooperativeKernel((const void*)mega, dim3(grid), dim3(NTHREADS), kargs, LDS_BYTES, stream);
    if (e != hipSuccess) fprintf(stderr, "kernel_launch: cooperative launch failed: %s (grid %d)\n", hipGetErrorString(e), grid);
}
```

```cpp
#include <hip/hip_runtime.h>
#include <cstdio>
#include <cstdint>

constexpr int BATCH = 4, SEQ = 4096, T = BATCH * SEQ, D = 1024, DEPTH = 2;
constexpr int INW = 4352, C_QA = 0, C_KA = 768, C_VA = 1536, C_QB = 2304, C_KB = 2816, C_VB = 3328, C_UC = 3840;
#define PJ_HM(ch, row) (((size_t)(ch) * T + (size_t)(row)) * 64)
constexpr size_t PJ_UC = (size_t)60 * 16384 * 64;
constexpr int HC = 2304, HC_H = 0, HC_OA = 1024, HC_OB = 1280, HC_PL = 1792;
constexpr int NGATE = 3072, PLE_DIM = 256, EXP_H = 256, NEXP = 16;
constexpr float EPS = 1e-6f;
constexpr float C2 = 0.125f * 1.4426950408889634f;
constexpr int NTHREADS = 512, NWAVES = 8;

enum { I_X = 0, I_P, I_POS, I_NORM_MIX, I_W_IN, I_W_GATE, I_B_GATE, I_W_POOL, I_POOL_SCALE, I_W_UP_A, I_W_UP_B, I_W_UP_C, I_W_OUT, I_NORM_MOE,
       I_W_RG, I_B_RG, I_W_RE, I_B_RE, I_W_EG, I_W_EU, I_W_ED, I_NORM_PLE, I_W_PLE_IN, I_W_PLE_GATE, I_NORM_FINAL, N_IN };

constexpr size_t MiB = 1u << 20;
constexpr size_t WS_CTL = 0;
constexpr size_t WS_SMALL = 1 * MiB;
constexpr size_t WS_HCAT = 2 * MiB;
constexpr size_t WS_PROJ = 74 * MiB;
constexpr size_t WS_W = 210 * MiB;
constexpr size_t WS_ROPE = 256 * MiB;
constexpr size_t WS_LSE = 260 * MiB;
constexpr size_t WS_YCPRE = 262 * MiB;
constexpr size_t WS_END = 278 * MiB;
constexpr size_t OV_X3 = WS_PROJ + 32 * MiB;
constexpr size_t OV_GATES = WS_PROJ, OV_MERGED = WS_PROJ + 96 * MiB, OV_PLEG = WS_PROJ + 96 * MiB;
constexpr size_t SM_EID = WS_SMALL, SM_WGT = WS_SMALL + 128 * 1024;
constexpr size_t SM_RSTD_MOE = WS_LSE + 1 * MiB, SM_RSTD_PLE = SM_RSTD_MOE + 64 * 1024;
constexpr size_t SM_SSQ = WS_LSE + 2 * MiB;
__device__ __forceinline__ unsigned long long ssq_fix(float ps) { ps = __builtin_amdgcn_fmed3f(ps, 0.f, 2.0e9f); const unsigned hi = (unsigned)ps; const unsigned lo = (unsigned)((ps - (float)hi) * 4294967296.f); return ((unsigned long long)hi << 32) | lo; }
__device__ __forceinline__ float ssq_val(unsigned long long v) { return (float)(unsigned)(v >> 32) + (float)(unsigned)v * 2.3283064365386963e-10f; }

typedef unsigned short bf16;
typedef float f32x4 __attribute__((ext_vector_type(4)));
typedef unsigned u32x2 __attribute__((ext_vector_type(2)));
typedef unsigned u32x4 __attribute__((ext_vector_type(4)));

__device__ __forceinline__ unsigned f2bf(float f) { unsigned u = __builtin_bit_cast(unsigned, f); return (u + 0x7fffu + ((u >> 16) & 1u)) >> 16; }
__device__ __forceinline__ float bf2f(unsigned h) { return __builtin_bit_cast(float, h << 16); }
__device__ __forceinline__ unsigned pk2(float lo, float hi) { return f2bf(lo) | (f2bf(hi) << 16); }
__device__ __forceinline__ float bflo(unsigned w) { return __builtin_bit_cast(float, w << 16); }
__device__ __forceinline__ float bfhi(unsigned w) { return __builtin_bit_cast(float, w & 0xffff0000u); }
__device__ __forceinline__ float wave_sum(float v) {
#pragma unroll
    for (int o = 1; o < 64; o <<= 1) v += __shfl_xor(v, o);
    return v;
}
__device__ __forceinline__ float sigmoidf_(float x) { return 1.f / (1.f + __expf(-x)); }

struct Args { const void* in[N_IN]; float* out; unsigned char* ws; int ph_lo, ph_hi; };

struct Frame {
    int tid, lane, wave, wg, G;
    float* out; unsigned char* ws;
    float* lds;
};
extern __shared__ __attribute__((aligned(16))) unsigned char lds_raw[];
template <int I> __device__ __forceinline__ const void* arg_ptr() {
    const __attribute__((address_space(1))) void* p; asm volatile("s_load_dwordx2 %0, %1, %2\n\ts_waitcnt lgkmcnt(0)" : "=s"(p) : "s"(__builtin_amdgcn_kernarg_segment_ptr()), "i"(I * 8) : "memory"); return (const void*)p; }
static_assert(N_IN == 25, "Args layout: in[25] at 0, out at 200, ws at 208");

__device__ __forceinline__ int lane_id() { int l; asm volatile("v_mbcnt_lo_u32_b32 %0, -1, 0\n\tv_mbcnt_hi_u32_b32 %0, -1, %0" : "=v"(l)); return l; }
#define PHASE_FRAME(F0) Frame F; F.wave = (F0).wave; asm volatile("" : "+s"(F.wave)); F.lane = lane_id(); asm volatile("" : "+v"(F.lane)); F.tid = F.wave * 64 + F.lane; F.wg = blockIdx.x; F.G = gridDim.x; \
    F.out = (float*)arg_ptr<25>(); F.ws = (unsigned char*)arg_ptr<26>(); F.lds = (float*)lds_raw
__device__ __forceinline__ void norm_row_bf16(const float* xrow, const float* g, bf16* orow, int lane) {
    f32x4 v[4]; float s = 0.f;
#pragma unroll
    for (int j = 0; j < 4; ++j) { v[j] = *(const f32x4*)(xrow + j * 256 + lane * 4); s += (v[j][0] * v[j][0] + v[j][1] * v[j][1]) + (v[j][2] * v[j][2] + v[j][3] * v[j][3]); }
    const float r = 1.f / sqrtf(wave_sum(s) * (1.f / D) + EPS);
#pragma unroll
    for (int j = 0; j < 4; ++j) { const f32x4 gg = *(const f32x4*)(g + j * 256 + lane * 4); u32x2 o; o.x = pk2(v[j][0] * r * gg[0], v[j][1] * r * gg[1]); o.y = pk2(v[j][2] * r * gg[2], v[j][3] * r * gg[3]);
        *(u32x2*)(orow + j * 256 + lane * 4) = o; }
}

__device__ __forceinline__ void naive_tile(float (&acc)[8][4], const bf16* A, int lda, const float* B, int ldb, int m0, int n0, int K, float* lds, int tid) {
    float* As = lds;
    float* Bs = lds + 16 * 132;
    const int tx = tid & 31, ty = tid >> 5;
    const int ar = tid >> 2, ak = (tid & 3) * 4;
    const int bk = tid >> 5, bn = (tid & 31) * 4;
    for (int k0 = 0; k0 < K; k0 += 16) {
        const u32x2 av = *(const u32x2*)(A + (size_t)(m0 + ar) * lda + k0 + ak);
        const f32x4 bv = *(const f32x4*)(B + (size_t)(k0 + bk) * ldb + n0 + bn);
        __syncthreads();
        As[(ak + 0) * 132 + ar] = bflo(av.x); As[(ak + 1) * 132 + ar] = bfhi(av.x);
        As[(ak + 2) * 132 + ar] = bflo(av.y); As[(ak + 3) * 132 + ar] = bfhi(av.y);
        *(f32x4*)(Bs + bk * 132 + bn) = bv;
        __syncthreads();
#pragma unroll 4
        for (int k = 0; k < 16; ++k) {
            const f32x4 a0 = *(const f32x4*)(As + k * 132 + ty * 8), a1 = *(const f32x4*)(As + k * 132 + ty * 8 + 4);
            const f32x4 b = *(const f32x4*)(Bs + k * 132 + tx * 4);
            const float a[8] = {a0.x, a0.y, a0.z, a0.w, a1.x, a1.y, a1.z, a1.w};
#pragma unroll
            for (int i = 0; i < 8; ++i) { acc[i][0] += a[i] * b.x; acc[i][1] += a[i] * b.y; acc[i][2] += a[i] * b.z; acc[i][3] += a[i] * b.w; }
        }
    }
}
#define ZERO_ACC(acc) _Pragma("unroll") for (int i_ = 0; i_ < 8; ++i_) _Pragma("unroll") for (int j_ = 0; j_ < 4; ++j_) acc[i_][j_] = 0.f

__device__ __forceinline__ const float* xin(const Frame& F, int layer) { return layer == 0 ? (const float*)arg_ptr<I_X>() : F.out; }

template <bool XF32> __device__ __forceinline__ void norm1_rows(const Frame& F, const void* xsrc, unsigned long long* rstd, bf16* hc) {
    f32x4 v[4][4], vn[4][4];
#define N1_LOAD(t0_, V) do { _Pragma("unroll") for (int r = 0; r < 4; ++r) _Pragma("unroll") for (int j = 0; j < 4; ++j) { const size_t off = (size_t)((t0_) + r) * D + j * 256 + F.lane * 4; \
        if (XF32) V[r][j] = *(const f32x4*)((const float*)xsrc + off); \
        else { const u32x2 w = *(const u32x2*)((const bf16*)xsrc + off); V[r][j] = (f32x4){bflo(w.x), bfhi(w.x), bflo(w.y), bfhi(w.y)}; } } } while (0)
    const int tstep = F.G * NWAVES * 4; int t0 = (F.wg * NWAVES + F.wave) * 4;
    if (t0 < T) N1_LOAD(t0, v);
#pragma unroll 1
    for (; t0 < T; t0 += tstep) {
        const bool has_next = t0 + tstep < T;
        if (has_next) N1_LOAD(t0 + tstep, vn);
#pragma unroll
        for (int r = 0; r < 4; ++r) { float sq = 0.f;
#pragma unroll
            for (int j = 0; j < 4; ++j) sq += (v[r][j][0] * v[r][j][0] + v[r][j][1] * v[r][j][1]) + (v[r][j][2] * v[r][j][2] + v[r][j][3] * v[r][j][3]);
            const float rr = 1.f / sqrtf(wave_sum(sq) * (1.f / D) + EPS);
#pragma unroll
            for (int j = 0; j < 4; ++j) { u32x2 o; o.x = pk2(v[r][j][0] * rr, v[r][j][1] * rr); o.y = pk2(v[r][j][2] * rr, v[r][j][3] * rr);
                *(u32x2*)(hc + (size_t)(t0 + r) * HC + HC_H + j * 256 + F.lane * 4) = o; } }
        if (has_next) {
#pragma unroll
            for (int r = 0; r < 4; ++r)
#pragma unroll
                for (int j = 0; j < 4; ++j) v[r][j] = vn[r][j]; }
    }
#undef N1_LOAD
}
__device__ __forceinline__ void ph_norm1(const Frame& F0, int layer) { PHASE_FRAME(F0);
    unsigned long long* rstd = (unsigned long long*)(F.ws + SM_SSQ);
    bf16* hc = (bf16*)(F.ws + WS_HCAT);
    if (layer == 0) norm1_rows<true>(F, arg_ptr<I_X>(), rstd, hc); else norm1_rows<false>(F, (const void*)F.out, rstd, hc);
}

__device__ __forceinline__ void ph_proj_naive(const Frame& F0, int layer) { PHASE_FRAME(F0);
    const bf16* hc = (const bf16*)(F.ws + WS_HCAT); bf16* proj = (bf16*)(F.ws + WS_PROJ);
    const float* W = (const float*)arg_ptr<I_W_IN>() + (size_t)layer * D * INW;
    const int ntn = INW / 128, ntiles = (T / 128) * ntn;
    for (int it = F.wg; it < ntiles; it += F.G) {
        const int m0 = (it / ntn) * 128, n0 = (it % ntn) * 128;
        float acc[8][4]; ZERO_ACC(acc);
        naive_tile(acc, hc + HC_H, HC, W, INW, m0, n0, D, F.lds, F.tid);
        const int tx = F.tid & 31, ty = F.tid >> 5;
#pragma unroll
        for (int i = 0; i < 8; ++i) { u32x2 o; o.x = pk2(acc[i][0], acc[i][1]); o.y = pk2(acc[i][2], acc[i][3]);
            *(u32x2*)(proj + (size_t)(m0 + ty * 8 + i) * INW + n0 + tx * 4) = o; }
    }
}

__device__ __forceinline__ void ph_rope_naive(const Frame& F0) { PHASE_FRAME(F0);
    bf16* proj = (bf16*)(F.ws + WS_PROJ); const int* pos = (const int*)arg_ptr<I_POS>();
    const int j = F.lane & 31, sub = F.lane >> 5;
    const float inv = exp2f(-(float)j * (13.287712379549449f / 32.0f));
    const long nitems = (long)T * 24 / 2;
    for (long it = (long)F.wg * NWAVES + F.wave; it < nitems; it += (long)F.G * NWAVES) {
        const long th = it * 2 + sub; const int t = (int)(th / 24), hh = (int)(th % 24);
        const int c0 = (hh < 12 ? C_QA : C_KA - 768) + hh * 64;
        bf16* p = proj + (size_t)t * INW + c0;
        const float t1 = bf2f(p[j]), t2 = bf2f(p[j + 32]);
        const float ang = (float)pos[t] * inv;
        double rev = (double)ang * 0.15915494309189535; rev -= floor(rev);
        const float fr = (float)rev;
        const float sn = __builtin_amdgcn_sinf(fr), cs = __builtin_amdgcn_cosf(fr);
        const float sc = hh < 12 ? C2 : 1.0f;
        const float r1 = (t1 * cs - t2 * sn) * sc, r2 = (t2 * cs + t1 * sn) * sc;
        *(unsigned*)(p + 2 * j) = pk2(r1, r2);
    }
    const long nq = (long)T * 512 / 2;
    for (long i = (long)F.wg * NTHREADS + F.tid; i < nq; i += (long)F.G * NTHREADS) {
        const int t = (int)(i / 256), c = (int)(i % 256) * 2;
        unsigned* p = (unsigned*)(proj + (size_t)t * INW + C_QB + c); const unsigned w = *p; *p = pk2(bflo(w) * C2, bfhi(w) * C2);
    }
}

__device__ __forceinline__ void ph_dil_naive(const Frame& F0) { PHASE_FRAME(F0);
    bf16* proj = (bf16*)(F.ws + WS_PROJ); float* lse = (float*)(F.ws + WS_LSE);
    const long n = (long)T * 12;
    for (long i = (long)F.wg * NTHREADS + F.tid; i < n; i += (long)F.G * NTHREADS) {
        const int gj = (int)(i / T), tt = (int)(i % T);
        const int g = gj >> 2, b = tt / SEQ, s = tt % SEQ, d = (g == 0) ? 1 : (g == 1 ? 4 : 16);
        const unsigned* qp = (const unsigned*)(proj + (size_t)tt * INW + C_QA + gj * 64);
        float q[64];
#pragma unroll
        for (int c = 0; c < 32; ++c) { const unsigned w = qp[c]; q[2 * c] = bflo(w); q[2 * c + 1] = bfhi(w); }
        float o[64];
#pragma unroll
        for (int c = 0; c < 64; ++c) o[c] = 0.f;
        float m = -1e30f, l = 0.f;
        for (int mm = 0; mm <= 128; ++mm) {
            const int sp = s - mm * d; if (sp < 0) break;
            const size_t row = (size_t)(b * SEQ + sp) * INW;
            const unsigned* kp = (const unsigned*)(proj + row + C_KA + gj * 64);
            const unsigned* vp = (const unsigned*)(proj + row + C_VA + gj * 64);
            float z = 0.f;
#pragma unroll
            for (int c = 0; c < 32; ++c) { const unsigned w = kp[c]; z += q[2 * c] * bflo(w) + q[2 * c + 1] * bfhi(w); }
            const float mn = fmaxf(m, z), a = exp2f(m - mn), pz = exp2f(z - mn);
            l = l * a + pz; m = mn;
#pragma unroll
            for (int c = 0; c < 32; ++c) { const unsigned w = vp[c]; o[2 * c] = o[2 * c] * a + pz * bflo(w); o[2 * c + 1] = o[2 * c + 1] * a + pz * bfhi(w); }
        }
        const float rl = 1.f / l;
        unsigned* op = (unsigned*)(proj + (size_t)tt * INW + C_QA + gj * 64);
#pragma unroll
        for (int c = 0; c < 32; ++c) op[c] = pk2(o[2 * c] * rl, o[2 * c + 1] * rl);
        lse[(size_t)tt * 12 + gj] = m + log2f(l);
    }
}

__device__ __forceinline__ void ph_sb_naive(const Frame& F0) { PHASE_FRAME(F0);
    const bf16* proj = (const bf16*)(F.ws + WS_PROJ); bf16* hc = (bf16*)(F.ws + WS_HCAT);
    const int nitems = BATCH * 8 * (SEQ / 64);
    for (int it = F.wg * NWAVES + F.wave; it < nitems; it += F.G * NWAVES) {
        const int chunk = (SEQ / 64 - 1) - it / (BATCH * 8), bh = it % (BATCH * 8), b = bh >> 3, h = bh & 7;
        const int t = chunk * 64 + F.lane;
        const unsigned* qp = (const unsigned*)(proj + (size_t)(b * SEQ + t) * INW + C_QB + h * 64);
        float q[64], o[64];
#pragma unroll
        for (int c = 0; c < 32; ++c) { const unsigned w = qp[c]; q[2 * c] = bflo(w); q[2 * c + 1] = bfhi(w); }
#pragma unroll
        for (int c = 0; c < 64; ++c) o[c] = 0.f;
        float carry = 0.f;
        for (int s = chunk * 64 + 62; s >= 0; --s) {
            const size_t row = (size_t)(b * SEQ + s) * INW;
            const unsigned* kp = (const unsigned*)(proj + row + C_KB + h * 64);
            const unsigned* vp = (const unsigned*)(proj + row + C_VB + h * 64);
            float z = 0.f;
#pragma unroll
            for (int c = 0; c < 32; ++c) { const unsigned w = kp[c]; z += q[2 * c] * bflo(w) + q[2 * c + 1] * bfhi(w); }
            const float sp = (z > 30.f) ? z : log2f(1.f + exp2f(z));
            float a = exp2f(z - sp - carry);
            const bool act = s < t;
            a = act ? a : 0.f; carry += act ? sp : 0.f;
#pragma unroll
            for (int c = 0; c < 32; ++c) { const unsigned w = vp[c]; o[2 * c] += a * bflo(w); o[2 * c + 1] += a * bfhi(w); }
        }
        unsigned* op = (unsigned*)(hc + (size_t)(b * SEQ + t) * HC + HC_OB + h * 64);
#pragma unroll
        for (int c = 0; c < 32; ++c) op[c] = pk2(o[2 * c], o[2 * c + 1]);
    }
}

__device__ __forceinline__ void ph_pool_naive(const Frame& F0) { PHASE_FRAME(F0);
    const bf16* proj = (const bf16*)(F.ws + WS_PROJ); bf16* hc = (bf16*)(F.ws + WS_HCAT);
    const long n = (long)T * 512;
    for (long i = (long)F.wg * NTHREADS + F.tid; i < n; i += (long)F.G * NTHREADS) {
        const int t = (int)(i / 512), c = (int)(i % 512), g = c >> 7, w = 2 << g, s = t % SEQ;
        const int cnt = (s + 1 < w) ? s + 1 : w;
        float sum = 0.f;
        for (int k = 0; k < cnt; ++k) sum += bf2f(proj[(size_t)(t - k) * INW + C_UC + c]);
        const float u = bf2f(proj[(size_t)t * INW + C_UC + c]);
        hc[(size_t)t * HC + HC_PL + c] = (bf16)f2bf(sum / (float)cnt - u);
    }
}

__device__ __forceinline__ void ph_comb_naive(const Frame& F0, int layer) { PHASE_FRAME(F0);
    const bf16* proj = (const bf16*)(F.ws + WS_PROJ); bf16* hc = (bf16*)(F.ws + WS_HCAT); const float* lse = (const float*)(F.ws + WS_LSE);
    float l0, l1, l2, n0, n1, n2; u32x4 a, b_, d_, na, nb, nd;
#define COMB_LOAD(i_, L0, L1, L2, A, B, DD) do { const int t = (i_) >> 5, c = ((i_) & 31) * 8, j = c >> 6, s_ = t & (SEQ - 1), bb = t - s_, cl = c & 63; \
        L0 = lse[(size_t)t * 12 + j]; L1 = lse[(size_t)t * 12 + 4 + j]; L2 = lse[(size_t)t * 12 + 8 + j]; \
        A = *(const u32x4*)(proj + PJ_HM(j, t) + cl); B = *(const u32x4*)(proj + PJ_HM(4 + j, bb + (s_ & 3) * (SEQ / 4) + (s_ >> 2)) + cl); DD = *(const u32x4*)(proj + PJ_HM(8 + j, bb + (s_ & 15) * (SEQ / 16) + (s_ >> 4)) + cl); } while (0)
    const int step = F.G * NTHREADS; int i = F.wg * NTHREADS + F.tid;
    if (i < T * 32) COMB_LOAD(i, l0, l1, l2, a, b_, d_);
#pragma unroll 1
    for (; i < T * 32; i += step) {
        const bool has_next = i + step < T * 32;
        if (has_next) COMB_LOAD(i + step, n0, n1, n2, na, nb, nd);
        const int t = i >> 5, c = (i & 31) * 8;
        const float mx = fmaxf(l0, fmaxf(l1, l2)), e0 = exp2f(l0 - mx), e1 = exp2f(l1 - mx), e2 = exp2f(l2 - mx), rs = 1.f / (e0 + e1 + e2);
        u32x4 o;
#pragma unroll
        for (int q = 0; q < 4; ++q) o[q] = pk2((e0 * bflo(a[q]) + e1 * bflo(b_[q]) + e2 * bflo(d_[q])) * rs, (e0 * bfhi(a[q]) + e1 * bfhi(b_[q]) + e2 * bfhi(d_[q])) * rs);
        *(u32x4*)(hc + (size_t)t * HC + HC_OA + c) = o;
        if (has_next) { l0 = n0; l1 = n1; l2 = n2; a = na; b_ = nb; d_ = nd; }
    }
#undef COMB_LOAD
}
__device__ __forceinline__ void ph_ycpre_naive(const Frame& F0, int layer) { PHASE_FRAME(F0);
    bf16* hc = (bf16*)(F.ws + WS_HCAT);
    const float* wp = (const float*)arg_ptr<I_W_POOL>() + (size_t)layer * 4 * 128 * 128; const float* ps = (const float*)arg_ptr<I_POOL_SCALE>() + layer * 512;
    bf16* yc = (bf16*)(F.ws + WS_YCPRE);
    const long n2 = (long)T * 512;
    for (long i = (long)F.wg * NTHREADS + F.tid; i < n2; i += (long)F.G * NTHREADS) {
        const int t = (int)(i / 512), c = (int)(i % 512), g = c >> 7, dd = c & 127;
        const bf16* pl = hc + (size_t)t * HC + HC_PL + g * 128; const float* w = wp + (size_t)g * 128 * 128 + dd;
        float s = 0.f;
        for (int k = 0; k < 128; ++k) s += bf2f(pl[k]) * w[k * 128];
        yc[(size_t)t * 512 + c] = (bf16)f2bf(s * ps[c]);
    }
}

__device__ __forceinline__ void ph_g4_naive(const Frame& F0, int layer) { PHASE_FRAME(F0);
    const bf16* hc = (const bf16*)(F.ws + WS_HCAT); const bf16* yc = (const bf16*)(F.ws + WS_YCPRE); bf16* mg = (bf16*)(F.ws + OV_MERGED);
    const float* wg = (const float*)arg_ptr<I_W_GATE>() + (size_t)layer * D * NGATE; const float* bg = (const float*)arg_ptr<I_B_GATE>() + layer * NGATE;
    const float* wa = (const float*)arg_ptr<I_W_UP_A>() + (size_t)layer * 256 * D; const float* wb = (const float*)arg_ptr<I_W_UP_B>() + (size_t)layer * 512 * D;
    const float* wc = (const float*)arg_ptr<I_W_UP_C>() + (size_t)layer * 512 * D;
    const int ntiles = (T / 128) * 8; const int tx = F.tid & 31, ty = F.tid >> 5;
    for (int it = F.wg; it < ntiles; it += F.G) {
        const int m0 = (it / 8) * 128, n0 = (it % 8) * 128;
        float m[8][4]; ZERO_ACC(m);
#pragma unroll 1
        for (int b = 0; b < 3; ++b) {
            float g[8][4]; ZERO_ACC(g);
            naive_tile(g, hc + HC_H, HC, wg, NGATE, m0, b * 1024 + n0, D, F.lds, F.tid);
            const f32x4 bias = *(const f32x4*)(bg + b * 1024 + n0 + tx * 4);
#pragma unroll
            for (int i = 0; i < 8; ++i) { g[i][0] = sigmoidf_(g[i][0] + bias.x); g[i][1] = sigmoidf_(g[i][1] + bias.y); g[i][2] = sigmoidf_(g[i][2] + bias.z); g[i][3] = sigmoidf_(g[i][3] + bias.w); }
            float acc[8][4]; ZERO_ACC(acc);
            if (b == 0) naive_tile(acc, hc + HC_OA, HC, wa, D, m0, n0, 256, F.lds, F.tid);
            else if (b == 1) naive_tile(acc, hc + HC_OB, HC, wb, D, m0, n0, 512, F.lds, F.tid);
            else naive_tile(acc, yc, 512, wc, D, m0, n0, 512, F.lds, F.tid);
#pragma unroll
            for (int i = 0; i < 8; ++i)
#pragma unroll
                for (int j = 0; j < 4; ++j) m[i][j] += g[i][j] * acc[i][j];
        }
#pragma unroll
        for (int i = 0; i < 8; ++i) { u32x2 o; o.x = pk2(m[i][0], m[i][1]); o.y = pk2(m[i][2], m[i][3]); *(u32x2*)(mg + (size_t)(m0 + ty * 8 + i) * D + n0 + tx * 4) = o; }
    }
}

__device__ __forceinline__ void ph_g5_naive(const Frame& F0, int layer) { PHASE_FRAME(F0);
    const bf16* mg = (const bf16*)(F.ws + OV_MERGED); const float* W = (const float*)arg_ptr<I_W_OUT>() + (size_t)layer * D * D; const float* x = xin(F, layer);
    const int ntiles = (T / 128) * 8; const int tx = F.tid & 31, ty = F.tid >> 5;
    for (int it = F.wg; it < ntiles; it += F.G) {
        const int m0 = (it / 8) * 128, n0 = (it % 8) * 128;
        float acc[8][4]; ZERO_ACC(acc);
        naive_tile(acc, mg, D, W, D, m0, n0, D, F.lds, F.tid);
#pragma unroll
        for (int i = 0; i < 8; ++i) { const size_t off = (size_t)(m0 + ty * 8 + i) * D + n0 + tx * 4; const f32x4 xv = *(const f32x4*)(x + off);
            *(f32x4*)(F.out + off) = (f32x4){xv.x + acc[i][0], xv.y + acc[i][1], xv.z + acc[i][2], xv.w + acc[i][3]}; }
    }
}

__device__ __forceinline__ void ph_route(const Frame& F0, int layer) { PHASE_FRAME(F0);
    const float* g = (const float*)arg_ptr<I_NORM_MOE>() + layer * D;
    const float* wrg = (const float*)arg_ptr<I_W_RG>() + (size_t)layer * D * 4; const float* brg = (const float*)arg_ptr<I_B_RG>() + layer * 4;
    const float* wre = (const float*)arg_ptr<I_W_RE>() + (size_t)layer * 4 * D * 4; const float* bre = (const float*)arg_ptr<I_B_RE>() + layer * 16;
    bf16* hmb = (bf16*)(F.ws + WS_PROJ); int* eid = (int*)(F.ws + SM_EID); float* wgt = (float*)(F.ws + SM_WGT);
    for (int t = F.wg * NWAVES + F.wave; t < T; t += F.G * NWAVES) {
        const float* xr = F.out + (size_t)t * D;
        float s = 0.f;
#pragma unroll
        for (int i = 0; i < 16; ++i) { const float xv = xr[i * 64 + F.lane]; s += xv * xv; }
        const float r = 1.f / sqrtf(wave_sum(s) * (1.f / D) + EPS);
        float lg[4] = {0.f, 0.f, 0.f, 0.f}; float le[16];
#pragma unroll
        for (int e = 0; e < 16; ++e) le[e] = 0.f;
#pragma unroll 2
        for (int i = 0; i < 16; ++i) {
            const int k = i * 64 + F.lane; const float hm = xr[k] * r * g[k];
            hmb[(size_t)t * D + k] = (bf16)f2bf(hm);
            const f32x4 a = *(const f32x4*)(wrg + (size_t)k * 4);
            lg[0] += hm * a.x; lg[1] += hm * a.y; lg[2] += hm * a.z; lg[3] += hm * a.w;
#pragma unroll
            for (int gg = 0; gg < 4; ++gg) { const f32x4 w = *(const f32x4*)(wre + ((size_t)gg * D + k) * 4);
                le[gg * 4 + 0] += hm * w.x; le[gg * 4 + 1] += hm * w.y; le[gg * 4 + 2] += hm * w.z; le[gg * 4 + 3] += hm * w.w; }
        }
#pragma unroll
        for (int e = 0; e < 4; ++e) lg[e] = wave_sum(lg[e]) + brg[e];
#pragma unroll
        for (int e = 0; e < 16; ++e) le[e] = wave_sum(le[e]) + bre[e];
        if (F.lane == 0) {
            int gi = 0; float mx = lg[0];
#pragma unroll
            for (int e = 1; e < 4; ++e) if (lg[e] > mx) { mx = lg[e]; gi = e; }
            float den = 0.f;
#pragma unroll
            for (int e = 0; e < 4; ++e) den += __expf(lg[e] - mx);
            const float p1 = 1.f / den;
            float ls[4];
#pragma unroll
            for (int e = 0; e < 4; ++e) ls[e] = gi == 0 ? le[e] : gi == 1 ? le[4 + e] : gi == 2 ? le[8 + e] : le[12 + e];
            int i0 = 0; float v0 = ls[0];
#pragma unroll
            for (int e = 1; e < 4; ++e) if (ls[e] > v0) { v0 = ls[e]; i0 = e; }
            int i1 = -1; float v1 = -3.0e38f;
#pragma unroll
            for (int e = 0; e < 4; ++e) if (e != i0 && ls[e] > v1) { v1 = ls[e]; i1 = e; }
            const float ex = __expf(v1 - v0), w0 = p1 / (1.f + ex), w1 = p1 * ex / (1.f + ex);
            eid[t * 2 + 0] = gi * 4 + i0; eid[t * 2 + 1] = gi * 4 + i1; wgt[t * 2 + 0] = w0; wgt[t * 2 + 1] = w1;
        }
    }
}

__device__ __forceinline__ void ph_moe_naive(const Frame& F0, int layer) { PHASE_FRAME(F0);
    const bf16* hmb = (const bf16*)(F.ws + WS_PROJ); const int* eid = (const int*)(F.ws + SM_EID); const float* wgt = (const float*)(F.ws + SM_WGT);
    const float* WG = (const float*)arg_ptr<I_W_EG>() + (size_t)layer * NEXP * D * EXP_H; const float* WU = (const float*)arg_ptr<I_W_EU>() + (size_t)layer * NEXP * D * EXP_H;
    const float* WD = (const float*)arg_ptr<I_W_ED>() + (size_t)layer * NEXP * EXP_H * D;
    float* hrow = F.lds; float* hid = F.lds + D;
    for (int t = F.wg; t < T; t += F.G) {
        __syncthreads();
        for (int k = F.tid; k < D; k += NTHREADS) hrow[k] = bf2f(hmb[(size_t)t * D + k]);
        __syncthreads();
        const int slot = F.tid >> 8, f = F.tid & 255, e = eid[t * 2 + slot];
        const float* wg = WG + (size_t)e * D * EXP_H + f; const float* wu = WU + (size_t)e * D * EXP_H + f;
        float a = 0.f, u = 0.f;
#pragma unroll 8
        for (int k = 0; k < D; ++k) { const float h = hrow[k]; a += h * wg[(size_t)k * EXP_H]; u += h * wu[(size_t)k * EXP_H]; }
        const float hv = (a / (1.f + __expf(-a))) * u * wgt[t * 2 + slot];
        hid[slot * 256 + f] = bf2f(f2bf(hv));
        __syncthreads();
        const int e0 = eid[t * 2], e1 = eid[t * 2 + 1];
        const float* d0 = WD + (size_t)e0 * EXP_H * D; const float* d1 = WD + (size_t)e1 * EXP_H * D;
        for (int n = F.tid; n < D; n += NTHREADS) {
            float y = 0.f;
#pragma unroll 8
            for (int ff = 0; ff < 256; ++ff) y += hid[ff] * d0[(size_t)ff * D + n] + hid[256 + ff] * d1[(size_t)ff * D + n];
            F.out[(size_t)t * D + n] += y;
        }
    }
}

__device__ __forceinline__ void ph_e(const Frame& F0, int layer) { PHASE_FRAME(F0);
    const float* g = (const float*)arg_ptr<I_NORM_PLE>() + layer * D; const float* p = (const float*)arg_ptr<I_P>() + (size_t)layer * T * PLE_DIM;
    bf16* hc = (bf16*)(F.ws + WS_HCAT);
    for (int t = F.wg * NWAVES + F.wave; t < T; t += F.G * NWAVES) {
        norm_row_bf16(F.out + (size_t)t * D, g, hc + (size_t)t * HC + HC_H, F.lane);
#pragma unroll
        for (int i = 0; i < 4; ++i) hc[(size_t)t * HC + HC_OA + i * 64 + F.lane] = (bf16)f2bf(p[(size_t)t * PLE_DIM + i * 64 + F.lane]);
    }
}

__device__ __forceinline__ void ph_ple_naive(const Frame& F0, int layer) { PHASE_FRAME(F0);
    const bf16* hc = (const bf16*)(F.ws + WS_HCAT);
    const float* wi = (const float*)arg_ptr<I_W_PLE_IN>() + (size_t)layer * PLE_DIM * D; const float* wg = (const float*)arg_ptr<I_W_PLE_GATE>() + (size_t)layer * D * D;
    const int ntiles = (T / 128) * 8; const int tx = F.tid & 31, ty = F.tid >> 5;
    for (int it = F.wg; it < ntiles; it += F.G) {
        const int m0 = (it / 8) * 128, n0 = (it % 8) * 128;
        float g[8][4]; ZERO_ACC(g);
        naive_tile(g, hc + HC_H, HC, wg, D, m0, n0, D, F.lds, F.tid);
        float acc[8][4]; ZERO_ACC(acc);
        naive_tile(acc, hc + HC_OA, HC, wi, D, m0, n0, PLE_DIM, F.lds, F.tid);
#pragma unroll
        for (int i = 0; i < 8; ++i) { const size_t off = (size_t)(m0 + ty * 8 + i) * D + n0 + tx * 4; f32x4 xv = *(const f32x4*)(F.out + off);
            xv.x += acc[i][0] * sigmoidf_(g[i][0]); xv.y += acc[i][1] * sigmoidf_(g[i][1]); xv.z += acc[i][2] * sigmoidf_(g[i][2]); xv.w += acc[i][3] * sigmoidf_(g[i][3]);
            *(f32x4*)(F.out + off) = xv; }
    }
}

__device__ __forceinline__ void ph_final(const Frame& F0) { PHASE_FRAME(F0);
    const float* g = (const float*)arg_ptr<I_NORM_FINAL>(); const bf16* x3 = (const bf16*)(F.ws + OV_X3);
    u32x2 xw[2][4], xn[2][4];
#define FIN_LOAD(t0_, XW) do { _Pragma("unroll") for (int r = 0; r < 2; ++r) _Pragma("unroll") for (int j = 0; j < 4; ++j) XW[r][j] = *(const u32x2*)(x3 + (size_t)((t0_) + r) * D + j * 256 + F.lane * 4); } while (0)
    const int tstep = F.G * NWAVES * 2; int t0 = (F.wg * NWAVES + F.wave) * 2;
    f32x4 gg[4];
#pragma unroll
    for (int j = 0; j < 4; ++j) gg[j] = *(const f32x4*)(g + j * 256 + F.lane * 4);
    if (t0 < T) FIN_LOAD(t0, xw);
#pragma unroll 1
    for (; t0 < T; t0 += tstep) {
        const bool has_next = t0 + tstep < T;
        if (has_next) FIN_LOAD(t0 + tstep, xn);
#pragma unroll
        for (int r = 0; r < 2; ++r) { float s = 0.f; f32x4 v[4];
#pragma unroll
            for (int j = 0; j < 4; ++j) { v[j] = (f32x4){bflo(xw[r][j].x), bfhi(xw[r][j].x), bflo(xw[r][j].y), bfhi(xw[r][j].y)}; s += (v[j][0] * v[j][0] + v[j][1] * v[j][1]) + (v[j][2] * v[j][2] + v[j][3] * v[j][3]); }
            const float rr = 1.f / sqrtf(wave_sum(s) * (1.f / D) + EPS);
#pragma unroll
            for (int j = 0; j < 4; ++j) *(f32x4*)(F.out + (size_t)(t0 + r) * D + j * 256 + F.lane * 4) = v[j] * rr * gg[j]; }
        if (has_next) {
#pragma unroll
            for (int r = 0; r < 2; ++r)
#pragma unroll
                for (int j = 0; j < 4; ++j) xw[r][j] = xn[r][j]; }
    }
#undef FIN_LOAD
}


#define LAS __attribute__((address_space(3)))
typedef short bf16x8 __attribute__((ext_vector_type(8)));
typedef float f32x2 __attribute__((ext_vector_type(2)));
#define LDS_WAIT() asm volatile("s_waitcnt lgkmcnt(0)" ::: "memory")
#define VM_WAIT() asm volatile("s_waitcnt vmcnt(0)" ::: "memory")
typedef __bf16 bf16x2_t __attribute__((ext_vector_type(2)));
__device__ __forceinline__ unsigned cvt_pk_bf16(float lo, float hi) { f32x2 v = {lo, hi}; bf16x2_t b = __builtin_convertvector(v, bf16x2_t); return __builtin_bit_cast(unsigned, b); }
#define NEG_LOG2E (-1.4426950408889634f)
__device__ __forceinline__ float sigmoid_pre(float v) { return __builtin_amdgcn_rcpf(1.f + __builtin_amdgcn_exp2f(v)); }
__device__ __forceinline__ float fast_sigmoid(float x) { return __builtin_amdgcn_rcpf(1.f + __builtin_amdgcn_exp2f(-1.4426950408889634f * x)); }

constexpr size_t WO_IN = 0;
constexpr size_t WO_BCAT = WO_IN + (size_t)INW * D;
constexpr size_t WO_OUT = WO_BCAT + (size_t)D * 4352;
constexpr size_t WO_M1 = WO_OUT + (size_t)D * D;
constexpr size_t WO_M2 = WO_M1 + (size_t)NEXP * 512 * D;
constexpr size_t WO_PLE = WO_M2 + (size_t)NEXP * D * EXP_H;
constexpr size_t WO_END = WO_PLE + (size_t)D * 1280;
static_assert(WO_END * 2 <= 46 * MiB, "layer weights fit");
constexpr int BCAT_LD = 4352, PLE_LD = 1280;
constexpr int RMAX = 36864;
constexpr size_t OV_HM = WS_PROJ;
constexpr size_t OV_HID = WS_PROJ + 32 * MiB;
constexpr size_t OV_Y2 = WS_PROJ + 50 * MiB;
constexpr size_t OV_ASORT = WS_HCAT;
constexpr size_t OV_GT = WS_PROJ;
constexpr size_t SM_ROWTOK = WS_SMALL + 768 * 1024;
constexpr size_t SM_SLOT2 = WS_SMALL + 256 * 1024, SM_WROW = WS_SMALL + 384 * 1024, SM_TILE = WS_SMALL + 704 * 1024;

__device__ __forceinline__ int xcd_remap(int c, int n) { const int q = n / 8, r = n % 8, x = c % 8, k = c / 8; return (x < r ? x * (q + 1) : r * (q + 1) + (x - r) * q) + k; }
namespace pg8 {
constexpr int BM = 256, BK = 64, HALF = 128, HTB = HALF * BK * 2, STAGE_BYTES = 8 * HTB, NXCD = 8, WGM = 8;
__device__ __forceinline__ int lds_byte(int r, int c) { const int st = (r >> 4) * 2 + (c >> 5), rr = r & 15, cc = c & 31, ob = rr * 64 + cc * 2; return st * 1024 + (ob ^ (((ob >> 9) & 1) << 5)); }
__device__ __forceinline__ void stage_rc(int b, int& R, int& C) { const int st = b / 1024, sb = b % 1024, swz = sb ^ (((sb >> 9) & 1) << 5); R = (st >> 1) * 16 + swz / 64; C = (st & 1) * 32 + (swz % 64) / 2; }
__device__ __forceinline__ int perm32(int rho) { const int n = rho >> 4, i = rho & 15; return 8 * (i >> 2) + 4 * n + (i & 3); }

struct Unit { int pm, pn, ka, kb, nt, kind; };
struct Gemm { const bf16* A; int lda; const bf16* Bt; int ldb; const int* rowmap; };

__device__ __forceinline__ bool tile_order(int nM, int nN, int G, int c, int i, int& pm, int& pn) {
    const int nwg = nM * nN; const long L = (long)i * G + c; if (L >= nwg) return false;
    int wgid = (int)L; { const int q = nwg / NXCD, r = nwg % NXCD, xcd = wgid % NXCD, off = wgid / NXCD; wgid = (xcd < r ? xcd * (q + 1) : r * (q + 1) + (xcd - r) * q) + off; }
    const int nig = WGM * nN, gid = wgid / nig, fm = gid * WGM, gsz = (nM - fm) < WGM ? (nM - fm) : WGM;
    pm = fm + ((wgid % nig) % gsz); pn = (wgid % nig) / gsz; return true;
}

template <class Epi, class Sched, bool ALIGN_EPI, bool GATHER = false>
__device__ __forceinline__ void gemm_phase(LAS unsigned char* lds, const Gemm g, const Sched& S, const Epi& E, int tid) {
    asm volatile("" : "+v"(tid));
    const int wid = __builtin_amdgcn_readfirstlane(tid >> 6), lane = tid & 63, wr = wid >> 2, wc = wid & 3, fr = lane & 15, fq = lane >> 4;
    unsigned voffB[2], cvA[2][2], nvA[2][2]; int Rr[2], Cc[2];
#pragma unroll
    for (int i = 0; i < 2; ++i) { int R, C; stage_rc(tid * 16 + i * 8192, R, C); const int Rb = 2 * (R & ~31) + perm32(R & 31);
        Rr[i] = R; Cc[i] = C; voffB[i] = (unsigned)(Rb * g.ldb + C) * 2u;
#pragma unroll
        for (int h = 0; h < 2; ++h) { cvA[h][i] = (unsigned)((R + h * HALF) * g.lda + C) * 2u; nvA[h][i] = cvA[h][i]; } }
    const size_t kstep = (size_t)(BK * 2);
    const size_t hstepB = (size_t)32 * g.ldb * 2;
#define PG8_GATHER_VOFF(u, v) do { _Pragma("unroll") for (int _h = 0; _h < 2; ++_h) _Pragma("unroll") for (int _i = 0; _i < 2; ++_i) { \
        const int tok_ = g.rowmap[(u).pm * BM + _h * HALF + Rr[_i]]; v[_h][_i] = (unsigned)(tok_ * g.lda + Cc[_i]) * 2u; } \
        asm volatile("" : "+v"(v[0][0]), "+v"(v[0][1]), "+v"(v[1][0]), "+v"(v[1][1])); } while (0)
#define PG8_STAGE_A(bufoff, gbase, h, NX) do { _Pragma("unroll") for (int _i = 0; _i < 2; ++_i) { const unsigned vo_ = (GATHER && (NX)) ? nvA[h][_i] : cvA[h][_i]; \
        __builtin_amdgcn_global_load_lds((const unsigned*)((const char*)(gbase) + vo_), (LAS unsigned*)(lds + (bufoff) + ldsw + _i * 8192), 16, 0, 0); } } while (0)
    const unsigned ldsw = (unsigned)wid * 1024u;
    const int aoff = lds_byte(wr * 64 + fr, fq * 8), boff = lds_byte(wc * 32 + fr, fq * 8);
#define PG8_SA(b, h) (((b) * 2 + (h)) * HTB)
#define PG8_SB(b, h) ((4 + (b) * 2 + (h)) * HTB)
#define PG8_STAGE(bufoff, gbase, voff) do { _Pragma("unroll") for (int _i = 0; _i < 2; ++_i) \
        __builtin_amdgcn_global_load_lds((const unsigned*)((const char*)(gbase) + (voff)[_i]), (LAS unsigned*)(lds + (bufoff) + ldsw + _i * 8192), 16, 0, 0); } while (0)
#define PG8_LDA(dst, b, h) do { _Pragma("unroll") for (int m = 0; m < 4; ++m) _Pragma("unroll") for (int k = 0; k < 2; ++k) dst[m][k] = *(const LAS bf16x8*)(lds + PG8_SA(b, h) + aoff + m * 2048 + k * 1024); } while (0)
#define PG8_LDB(dst, b, h) do { _Pragma("unroll") for (int n = 0; n < 2; ++n) _Pragma("unroll") for (int k = 0; k < 2; ++k) dst[n][k] = *(const LAS bf16x8*)(lds + PG8_SB(b, h) + boff + n * 2048 + k * 1024); } while (0)
#define PG8_MMA(ai, bj, At, Bt) do { __builtin_amdgcn_s_setprio(1); _Pragma("unroll") for (int m = 0; m < 4; ++m) _Pragma("unroll") for (int n = 0; n < 2; ++n) _Pragma("unroll") for (int k = 0; k < 2; ++k) \
        acc[ai][bj][m][n] = __builtin_amdgcn_mfma_f32_16x16x32_bf16(Bt[n][k], At[m][k], acc[ai][bj][m][n], 0, 0, 0); __builtin_amdgcn_s_setprio(0); } while (0)
#define PG8_WAIT_V(n) asm volatile("s_waitcnt vmcnt(" #n ")" ::: "memory")
#define PG8_WAIT_L(n) asm volatile("s_waitcnt lgkmcnt(" #n ")" ::: "memory")
#define PG8_BAR __builtin_amdgcn_s_barrier()
#define PG8_SCHED __builtin_amdgcn_sched_barrier(0)
#define PG8_UA(u) ((const char*)g.A + ((GATHER ? (size_t)0 : (size_t)(u).pm * BM * g.lda) + (u).ka) * 2)
#define PG8_UB(u) ((const char*)g.Bt + ((size_t)(u).pn * BM * g.ldb + (u).kb) * 2)
    Unit cur, nxt; int ui = 0;
    if (!S.next(0, cur)) return;
    f32x4 acc[2][2][4][2];
#pragma unroll
    for (int a = 0; a < 2; ++a)
#pragma unroll
        for (int b = 0; b < 2; ++b)
#pragma unroll
            for (int m = 0; m < 4; ++m)
#pragma unroll
                for (int n = 0; n < 2; ++n) acc[a][b][m][n] = (f32x4){0.f, 0.f, 0.f, 0.f};
    bf16x8 At[4][2], B0[2][2], B1[2][2];
    const char* cA = PG8_UA(cur); const char* cB = PG8_UB(cur);
    if constexpr (GATHER) PG8_GATHER_VOFF(cur, cvA);
    PG8_STAGE(PG8_SB(0, 0), cB, voffB); PG8_STAGE(PG8_SB(0, 1), cB + hstepB, voffB); PG8_STAGE_A(PG8_SA(0, 0), cA, 0, false); PG8_STAGE_A(PG8_SA(0, 1), cA, 1, false);
    if (wr == 1) PG8_BAR;
    PG8_WAIT_V(2); PG8_BAR;
    PG8_STAGE(PG8_SB(1, 0), cB + kstep, voffB); PG8_STAGE_A(PG8_SA(1, 0), cA + kstep, 0, false); PG8_STAGE(PG8_SB(1, 1), cB + hstepB + kstep, voffB);
    PG8_WAIT_V(6); PG8_BAR;
    for (;;) {
        const bool has_next = S.next(ui + 1, nxt);
        const char* nA = has_next ? PG8_UA(nxt) : cA; const char* nB = has_next ? PG8_UB(nxt) : cB;
        if constexpr (GATHER) { if (has_next) PG8_GATHER_VOFF(nxt, nvA); }
        const int nt = cur.nt;
#pragma unroll 1
        for (int t = 0; t < nt; t += 2) {
            const bool last = (t == nt - 2), nx = last && has_next;
            const char* a1 = cA + (size_t)(t + 1) * kstep;
            const char* a2 = last ? nA : cA + (size_t)(t + 2) * kstep; const char* b2 = last ? nB : cB + (size_t)(t + 2) * kstep;
            const char* a3 = a2 + kstep; const char* b3 = b2 + kstep;
            PG8_LDB(B0, 0, 0); PG8_LDB(B1, 0, 1); PG8_SCHED; PG8_LDA(At, 0, 0); PG8_STAGE_A(PG8_SA(1, 1), a1, 1, false);
            PG8_WAIT_V(8); PG8_WAIT_L(0); PG8_BAR; PG8_MMA(0, 0, At, B0); PG8_MMA(0, 1, At, B1); PG8_BAR; PG8_SCHED;
            PG8_LDA(At, 0, 1); PG8_STAGE(PG8_SB(0, 0), b2, voffB); PG8_STAGE(PG8_SB(0, 1), b2 + hstepB, voffB); PG8_STAGE_A(PG8_SA(0, 0), a2, 0, nx);
            PG8_WAIT_V(8); PG8_WAIT_L(0); PG8_BAR; PG8_MMA(1, 0, At, B0); PG8_MMA(1, 1, At, B1); PG8_BAR; PG8_SCHED;
            PG8_LDB(B0, 1, 0); PG8_LDB(B1, 1, 1); PG8_SCHED; PG8_LDA(At, 1, 0); PG8_STAGE_A(PG8_SA(0, 1), a2, 1, nx);
            PG8_WAIT_V(8); PG8_WAIT_L(0); PG8_BAR; PG8_MMA(0, 0, At, B0); PG8_MMA(0, 1, At, B1); PG8_BAR; PG8_SCHED;
            PG8_LDA(At, 1, 1); PG8_STAGE(PG8_SB(1, 0), b3, voffB); PG8_STAGE(PG8_SB(1, 1), b3 + hstepB, voffB); PG8_STAGE_A(PG8_SA(1, 0), a3, 0, nx);
            PG8_WAIT_V(8); PG8_WAIT_L(0); PG8_BAR; PG8_MMA(1, 0, At, B0); PG8_MMA(1, 1, At, B1); PG8_BAR; PG8_SCHED;
        }
        if constexpr (ALIGN_EPI) { if (wr == 0) PG8_BAR; }
        E(acc, cur, wr, wc, fr, fq);
        if (!has_next) break;
#pragma unroll
        for (int a = 0; a < 2; ++a)
#pragma unroll
            for (int b = 0; b < 2; ++b)
#pragma unroll
                for (int m = 0; m < 4; ++m)
#pragma unroll
                    for (int n = 0; n < 2; ++n) acc[a][b][m][n] = (f32x4){0.f, 0.f, 0.f, 0.f};
        cur = nxt; cA = nA; cB = nB; ++ui;
        if constexpr (GATHER) {
#pragma unroll
            for (int h = 0; h < 2; ++h)
#pragma unroll
                for (int i = 0; i < 2; ++i) cvA[h][i] = nvA[h][i]; }
        if constexpr (ALIGN_EPI) { if (wr == 1) PG8_BAR; }
    }
    PG8_WAIT_V(0);
    if constexpr (!ALIGN_EPI) { if (wr == 0) PG8_BAR; }
    PG8_BAR;
#undef PG8_SA
#undef PG8_SB
#undef PG8_STAGE
#undef PG8_STAGE_A
#undef PG8_GATHER_VOFF
#undef PG8_LDA
#undef PG8_LDB
#undef PG8_MMA
#undef PG8_WAIT_V
#undef PG8_WAIT_L
#undef PG8_BAR
#undef PG8_SCHED
#undef PG8_UA
#undef PG8_UB
}
}

typedef f32x4 AccT[2][2][4][2];
#define EPI_ROW(u, ai, m) ((u).pm * 256 + (ai) * 128 + wr * 64 + (m) * 16 + fr)
#define EPI_ROW0(u, ai, m) ((u).pm * 256 + (ai) * 128 + wr * 64 + (m) * 16)
#define EPI_FOR_AM _Pragma("unroll") for (int ai = 0; ai < 2; ++ai) _Pragma("unroll") for (int m = 0; m < 4; ++m)
__device__ __forceinline__ u32x4 pack8(const f32x4 v0, const f32x4 v1) { u32x4 w; w.x = cvt_pk_bf16(v0[0], v0[1]); w.y = cvt_pk_bf16(v0[2], v0[3]); w.z = cvt_pk_bf16(v1[0], v1[1]); w.w = cvt_pk_bf16(v1[2], v1[3]); return w; }
__device__ __forceinline__ void unpack8(const u32x4 w, f32x4& v0, f32x4& v1) { v0 = (f32x4){bflo(w.x), bfhi(w.x), bflo(w.y), bfhi(w.y)}; v1 = (f32x4){bflo(w.z), bfhi(w.z), bflo(w.w), bfhi(w.w)}; }
constexpr int STG_OFF = 133120, STG_PITCH = 144, STG_WAVE = 16 * STG_PITCH;
__device__ __forceinline__ void store_rows16(const u32x4 v0, const u32x4 v1, bf16* g0, size_t pitch, int wid, int lane) {
    LAS unsigned char* stg = (LAS unsigned char*)lds_raw + STG_OFF + wid * STG_WAVE; const int fr = lane & 15, fq = lane >> 4;
    *(LAS u32x4*)(stg + fr * STG_PITCH + fq * 16) = v0; *(LAS u32x4*)(stg + fr * STG_PITCH + 64 + fq * 16) = v1;
#pragma unroll
    for (int k = 0; k < 2; ++k) { const int row = (lane >> 3) + 8 * k; const u32x4 w = *(const LAS u32x4*)(stg + row * STG_PITCH + (lane & 7) * 16); *(u32x4*)(g0 + (size_t)row * pitch + (lane & 7) * 8) = w; }
}

__device__ __forceinline__ void store_rows16_perm(const u32x4 v0, const u32x4 v1, bf16* g0, int ld, int wid, int lane) {
    LAS unsigned char* stg = (LAS unsigned char*)lds_raw + STG_OFF + wid * STG_WAVE; const int fr = lane & 15, fq = lane >> 4;
    *(LAS u32x4*)(stg + fr * STG_PITCH + fq * 16) = v0; *(LAS u32x4*)(stg + fr * STG_PITCH + 64 + fq * 16) = v1;
#pragma unroll
    for (int k = 0; k < 2; ++k) { const int row = (lane >> 3) + 8 * k; const u32x4 w = *(const LAS u32x4*)(stg + row * STG_PITCH + (lane & 7) * 16);
        const int prow = ((row & ((1 << ld) - 1)) << (12 - ld)) + (row >> ld); *(u32x4*)(g0 + (size_t)prow * 64 + (lane & 7) * 8) = w; }
}

constexpr int EXTRA_OFF = STG_OFF + 8 * STG_WAVE;
__device__ __forceinline__ void rowfac_reset(int wave, int lane) { if (lane == 0) ((LAS int*)((LAS unsigned char*)lds_raw + EXTRA_OFF + 8192))[wave] = -1; }
__device__ __forceinline__ void rowfac_get(float (&rsv)[2][4], const unsigned long long* ssq, const pg8::Unit& u, int wr, int wid, int l_) {
    LAS float* ex = (LAS float*)((LAS unsigned char*)lds_raw + EXTRA_OFF + wid * 1024); const int fr = l_ & 15, fq = l_ >> 4;
    LAS int* idw = (LAS int*)((LAS unsigned char*)lds_raw + EXTRA_OFF + 8192) + wid;
    const int cached = __builtin_amdgcn_readfirstlane(*idw);
    if (cached == u.pm) { EPI_FOR_AM rsv[ai][m] = ex[(ai * 4 + m) * 16 + fr]; }
    else { unsigned long long sq8[2][4];
        EPI_FOR_AM sq8[ai][m] = ssq[EPI_ROW(u, ai, m)];
        EPI_FOR_AM rsv[ai][m] = __builtin_amdgcn_rsqf(ssq_val(sq8[ai][m]) * (1.f / D) + EPS);
        if (fq == 0) { EPI_FOR_AM ex[(ai * 4 + m) * 16 + fr] = rsv[ai][m]; }
        if (l_ == 0) *idw = u.pm; }
}

struct SchedProj { int G, c;
    __device__ __forceinline__ bool next(int i, pg8::Unit& u) const { int pm, pn; if (!pg8::tile_order(T / 256, INW / 256, G, c, i, pm, pn)) return false; u.pm = pm; u.pn = pn; u.ka = HC_H; u.kb = 0; u.nt = 16; u.kind = pn; return true; } };
struct EpiProj { bf16* proj; const float* rope; const unsigned long long* rstd;
    __device__ __forceinline__ void operator()(const AccT& acc, const pg8::Unit& u, int wr, int wc, int, int) const { const int l_ = lane_id(), fr = l_ & 15, fq = l_ >> 4;
        const int pn = u.pn, wid = wr * 4 + wc; const bool dorope = pn < 6; const float sc = (pn < 3 || pn == 9 || pn == 10) ? C2 : 1.f;
        const float sc_ = sc; float rsv[2][4];
        EPI_FOR_AM rsv[ai][m] = 1.f;
        if (rstd) rowfac_get(rsv, rstd, u, wr, wid, l_);
        EPI_FOR_AM { const int row = EPI_ROW(u, ai, m); u32x4 pk[2]; const float sc = sc_ * rsv[ai][m];
#pragma unroll
            for (int bj = 0; bj < 2; ++bj) { f32x4 cs0 = (f32x4){1.f, 0.f, 1.f, 0.f}, cs1 = cs0;
                if (dorope) { const f32x4* rp = (const f32x4*)(rope + ((size_t)row * 32 + 16 * bj + 4 * fq) * 2); cs0 = rp[0]; cs1 = rp[1]; }
                const f32x4 a0 = acc[ai][bj][m][0], a1 = acc[ai][bj][m][1]; f32x4 o0, o1;
                o0[0] = (a0[0] * cs0[0] - a0[1] * cs0[1]) * sc; o0[1] = (a0[1] * cs0[0] + a0[0] * cs0[1]) * sc;
                o0[2] = (a0[2] * cs0[2] - a0[3] * cs0[3]) * sc; o0[3] = (a0[3] * cs0[2] + a0[2] * cs0[3]) * sc;
                o1[0] = (a1[0] * cs1[0] - a1[1] * cs1[1]) * sc; o1[1] = (a1[1] * cs1[0] + a1[0] * cs1[1]) * sc;
                o1[2] = (a1[2] * cs1[2] - a1[3] * cs1[3]) * sc; o1[3] = (a1[3] * cs1[2] + a1[2] * cs1[3]) * sc;
                pk[bj] = pack8(o0, o1); }
            const int t0 = EPI_ROW0(u, ai, m);
            if (pn < 15) { const int ld = pn < 9 ? 2 * (pn % 3) : 0, s0 = t0 & (SEQ - 1);
                store_rows16_perm(pk[0], pk[1], proj + PJ_HM(pn * 4 + wc, (t0 - s0) + (s0 >> ld)), ld, wid, l_); }
            else store_rows16(pk[0], pk[1], proj + PJ_UC + (size_t)t0 * 512 + (pn - 15) * 256 + wc * 64, 512, wid, l_); }
    } };

__device__ __forceinline__ void g4_barrier_wait(unsigned* bar, const volatile LAS unsigned* st, int wave) {
    if (wave == 0) {
        const unsigned x = (unsigned)__builtin_amdgcn_s_getreg((3 << 11) | 20) & 0xFu, gen = st[4];
        if (lane_id() == 0) { unsigned sp = 0; while (__hip_atomic_load(&bar[2304 + 64 * x], __ATOMIC_RELAXED, __HIP_MEMORY_SCOPE_AGENT) == gen) { __builtin_amdgcn_s_sleep(1); if (++sp > (1u << 22)) break; } }
        __builtin_amdgcn_fence(__ATOMIC_ACQUIRE, "agent"); asm volatile("s_waitcnt vmcnt(0)" ::: "memory"); }
    __builtin_amdgcn_s_barrier();
}
struct SchedG4 { int G, c; unsigned* bar; const volatile LAS unsigned* st; int wave;
    __device__ __forceinline__ bool next(int i, pg8::Unit& u) const { const int ti = i / 6, sub = i - ti * 6, grp = (c >> 3) & 1; int pm, pn; if (!pg8::tile_order(T / 256, 4, G, c, ti, pm, pn)) return false;
        const unsigned tab = grp ? ((1u) | (1u | 1u << 2) << 6 | (2u | 1u << 4) << 12 | (2u | 1u << 2 | 1u << 4) << 18 | (0u | 2u << 4) << 24)
                                 : ((0u) | (1u | 1u << 3 | 1u << 4) << 6 | (0u | 1u << 2) << 12 | (1u | 1u << 2 | 1u << 3 | 1u << 4) << 18 | (2u | 2u << 4) << 24);
        const unsigned e_ = sub < 5 ? (tab >> (6 * sub)) & 63u : (grp ? (0u | 1u << 2 | 2u << 4) : (2u | 1u << 2 | 2u << 4));
        const int b = e_ & 3, isup = (e_ >> 2) & 1;
        if (i == (grp ? 3 : 2)) g4_barrier_wait(bar, st, wave);
        u.pm = pm; u.pn = pn; u.kind = (int)e_;
        if (!isup) { u.ka = HC_H; u.kb = b * 1024; u.nt = 16; } else { u.ka = b == 0 ? HC_OA : b == 1 ? HC_OB : HC_PL; u.kb = 3072 + (b == 0 ? 0 : b == 1 ? 256 : 768); u.nt = b == 0 ? 4 : 8; }
        return true; } };
#define G4_PRIV(u, wid, g, bj, lane) ((((size_t)((u).pm * 4 + (u).pn) * 8 + (wid)) * 16 + (size_t)((g) * 2 + (bj))) * 512 + (size_t)(lane) * 8)
struct EpiG4 { bf16* gt; bf16* mg; const float* bias; const unsigned long long* rstd; bf16* mgt;
    __device__ __forceinline__ void operator()(const AccT& acc, const pg8::Unit& u, int wr, int wc, int, int) const { const int l_ = lane_id(), fr = l_ & 15, fq = l_ >> 4;
        const int b = u.kind & 3, isup = (u.kind >> 2) & 1, slot = (u.kind >> 3) & 1, seq = (u.kind >> 4) & 3, wid = wr * 4 + wc, colw = u.pn * 256 + wc * 64, colb = colw + 8 * fq;
        bf16* gt = this->gt + (size_t)slot * ((size_t)32 * 1024 * 1024);
        if (!isup) {
            f32x4 bv[2][2];
            LAS f32x4* bx = (LAS f32x4*)((LAS unsigned char*)lds_raw + EXTRA_OFF + wid * 1024 + 512);
            if (seq == 0) {
#pragma unroll
                for (int bj = 0; bj < 2; ++bj) { bv[bj][0] = *(const f32x4*)(bias + b * 1024 + colb + bj * 32) * NEG_LOG2E; bv[bj][1] = *(const f32x4*)(bias + b * 1024 + colb + bj * 32 + 4) * NEG_LOG2E; }
#pragma unroll 1
                for (int bb = 0; bb < 2; ++bb) { const int bo = (b + bb + 1) % 3;
                    if (fr == 0) {
#pragma unroll
                        for (int bj = 0; bj < 2; ++bj) { bx[(bb * 4 + fq) * 4 + bj * 2] = *(const f32x4*)(bias + bo * 1024 + colb + bj * 32) * NEG_LOG2E; bx[(bb * 4 + fq) * 4 + bj * 2 + 1] = *(const f32x4*)(bias + bo * 1024 + colb + bj * 32 + 4) * NEG_LOG2E; } } }
            } else {
#pragma unroll
                for (int bj = 0; bj < 2; ++bj) { bv[bj][0] = bx[((seq - 1) * 4 + fq) * 4 + bj * 2]; bv[bj][1] = bx[((seq - 1) * 4 + fq) * 4 + bj * 2 + 1]; } }
            float rsv[2][4];
            EPI_FOR_AM rsv[ai][m] = 1.f;
            if (rstd) rowfac_get(rsv, rstd, u, wr, wid, l_);
            EPI_FOR_AM { u32x4 pk[2]; const float rs = rsv[ai][m];
#pragma unroll
                for (int bj = 0; bj < 2; ++bj) { f32x4 v0 = acc[ai][bj][m][0] * rs + bv[bj][0], v1 = acc[ai][bj][m][1] * rs + bv[bj][1];
#pragma unroll
                    for (int e = 0; e < 4; ++e) { v0[e] = sigmoid_pre(v0[e]); v1[e] = sigmoid_pre(v1[e]); }
                    pk[bj] = pack8(v0, v1); }
                *(u32x4*)(gt + G4_PRIV(u, wid, ai * 4 + m, 0, l_)) = pk[0]; *(u32x4*)(gt + G4_PRIV(u, wid, ai * 4 + m, 1, l_)) = pk[1]; }
        } else {
            u32x4 gvb[2][2][2], pvb[2][2][2];
#define G4_LOAD(batch, buf) do { _Pragma("unroll") for (int mm = 0; mm < 2; ++mm) { const int g_ = ((batch) >> 1) * 4 + ((batch) & 1) * 2 + mm; \
                _Pragma("unroll") for (int bj = 0; bj < 2; ++bj) { gvb[buf][mm][bj] = *(const u32x4*)(gt + G4_PRIV(u, wid, g_, bj, l_)); if (seq > 0) pvb[buf][mm][bj] = *(const u32x4*)(mgt + G4_PRIV(u, wid, g_, bj, l_)); } } } while (0)
            G4_LOAD(0, 0);
#pragma unroll
            for (int batch = 0; batch < 4; ++batch) { const int ai = batch >> 1, buf = batch & 1;
                if (batch < 3) G4_LOAD(batch + 1, (batch + 1) & 1);
#pragma unroll
                for (int mm = 0; mm < 2; ++mm) { const int m = (batch & 1) * 2 + mm; u32x4 pk[2];
#pragma unroll
                    for (int bj = 0; bj < 2; ++bj) { f32x4 g0, g1; unpack8(gvb[buf][mm][bj], g0, g1);
                        f32x4 v0 = acc[ai][bj][m][0] * g0, v1 = acc[ai][bj][m][1] * g1;
                        if (seq > 0) { f32x4 p0, p1; unpack8(pvb[buf][mm][bj], p0, p1); v0 += p0; v1 += p1; }
                        pk[bj] = pack8(v0, v1); }
                    if (seq < 2) { *(u32x4*)(mgt + G4_PRIV(u, wid, ai * 4 + m, 0, l_)) = pk[0]; *(u32x4*)(mgt + G4_PRIV(u, wid, ai * 4 + m, 1, l_)) = pk[1]; }
                    else store_rows16(pk[0], pk[1], mg + (size_t)EPI_ROW0(u, ai, m) * D + colw, D, wid, l_); }
            }
#undef G4_LOAD
        }
    } };

struct SchedG5 { int G, c;
    __device__ __forceinline__ bool next(int i, pg8::Unit& u) const { int pm, pn; if (!pg8::tile_order(T / 256, 4, G, c, i, pm, pn)) return false; u.pm = pm; u.pn = pn; u.ka = 0; u.kb = 0; u.nt = 16; u.kind = 0; return true; } };
template <bool XF32> struct EpiG5 { const void* x; bf16* xb; int xpitch;
    __device__ __forceinline__ void operator()(const AccT& acc, const pg8::Unit& u, int wr, int wc, int, int) const { const int l_ = lane_id(), fr = l_ & 15, fq = l_ >> 4;
        const int wid = wr * 4 + wc, colw = u.pn * 256 + wc * 64, colb = colw + 8 * fq;
        f32x4 xv[2][2][2][2]; u32x4 xr[2][2][2];
#define G5_LOAD(batch, buf) do { _Pragma("unroll") for (int mm = 0; mm < 2; ++mm) { const size_t off = (size_t)EPI_ROW(u, (batch) >> 1, ((batch) & 1) * 2 + mm) * xpitch + colb; \
            _Pragma("unroll") for (int bj = 0; bj < 2; ++bj) { \
                if (XF32) { xv[buf][mm][bj][0] = *(const f32x4*)((const float*)x + off + bj * 32); xv[buf][mm][bj][1] = *(const f32x4*)((const float*)x + off + bj * 32 + 4); } \
                else xr[buf][mm][bj] = *(const u32x4*)((const bf16*)x + off + bj * 32); } } } while (0)
        G5_LOAD(0, 0);
#pragma unroll
        for (int batch = 0; batch < 4; ++batch) { const int ai = batch >> 1, buf = batch & 1;
            if (batch < 3) G5_LOAD(batch + 1, (batch + 1) & 1);
#pragma unroll
            for (int mm = 0; mm < 2; ++mm) { const int m = (batch & 1) * 2 + mm;
                if (!XF32) { unpack8(xr[buf][mm][0], xv[buf][mm][0][0], xv[buf][mm][0][1]); unpack8(xr[buf][mm][1], xv[buf][mm][1][0], xv[buf][mm][1][1]); }
                store_rows16(pack8(xv[buf][mm][0][0] + acc[ai][0][m][0], xv[buf][mm][0][1] + acc[ai][0][m][1]), pack8(xv[buf][mm][1][0] + acc[ai][1][m][0], xv[buf][mm][1][1] + acc[ai][1][m][1]),
                             xb + (size_t)EPI_ROW0(u, ai, m) * D + colw, D, wid, l_); }
        }
#undef G5_LOAD
    } };

struct SchedPle { int G, c;
    __device__ __forceinline__ bool next(int i, pg8::Unit& u) const { int pm, pn; if (!pg8::tile_order(T / 256, 4, G, c, i, pm, pn)) return false;
        u.pm = pm; u.pn = pn; u.kind = 0; u.ka = 0; u.kb = 0; u.nt = 16; return true; } };
struct EpiPle { const bf16* pin; const bf16* xin_; bf16* xout; int xpitch; const float* rstd; unsigned long long* ssq;
    __device__ __forceinline__ void operator()(const AccT& acc, const pg8::Unit& u, int wr, int wc, int, int) const { const int l_ = lane_id(), fr = l_ & 15, fq = l_ >> 4;
        const int wid = wr * 4 + wc, colw = u.pn * 256 + wc * 64, colb = colw + 8 * fq;
        float rsv[2][4];
        EPI_FOR_AM rsv[ai][m] = rstd[EPI_ROW(u, ai, m)];
        u32x4 pva[2][2], xwa[2][2];
#define PLE_LOAD(g, buf) do { const size_t off = (size_t)EPI_ROW(u, (g) >> 2, (g) & 3) * D + colb; \
            pva[buf][0] = *(const u32x4*)(pin + G4_PRIV(u, wid, g, 0, l_)); pva[buf][1] = *(const u32x4*)(pin + G4_PRIV(u, wid, g, 1, l_)); xwa[buf][0] = *(const u32x4*)(xin_ + off); xwa[buf][1] = *(const u32x4*)(xin_ + off + 32); } while (0)
        PLE_LOAD(0, 0);
#pragma unroll
        for (int g = 0; g < 8; ++g) { const int ai = g >> 2, m = g & 3, buf = g & 1; const float rs = rsv[ai][m]; f32x4 r[2][2];
            if (g < 7) PLE_LOAD(g + 1, (g + 1) & 1);
#pragma unroll
            for (int bj = 0; bj < 2; ++bj) { f32x4 g0 = acc[ai][bj][m][0] * rs, g1 = acc[ai][bj][m][1] * rs, p0, p1, x0, x1;
#pragma unroll
                for (int e = 0; e < 4; ++e) { g0[e] = sigmoid_pre(g0[e]); g1[e] = sigmoid_pre(g1[e]); }
                unpack8(pva[buf][bj], p0, p1); unpack8(xwa[buf][bj], x0, x1); r[bj][0] = x0 + p0 * g0; r[bj][1] = x1 + p1 * g1; }
            if (ssq) { const f32x4 q = r[0][0] * r[0][0] + r[0][1] * r[0][1] + r[1][0] * r[1][0] + r[1][1] * r[1][1]; float ps = (q[0] + q[1]) + (q[2] + q[3]); ps += __shfl_xor(ps, 16); ps += __shfl_xor(ps, 32);
                if (l_ < 16) atomicAdd(ssq + EPI_ROW(u, ai, m), ssq_fix(ps)); }
            store_rows16(pack8(r[0][0], r[0][1]), pack8(r[1][0], r[1][1]), xout + (size_t)EPI_ROW0(u, ai, m) * xpitch + colw, xpitch, wid, l_); }
#undef PLE_LOAD
    } };
struct SchedPin { int stride, c2;
    __device__ __forceinline__ bool next(int i, pg8::Unit& u) const { const int ti = c2 + i * stride; if (c2 < 0 || ti >= (T / 256) * 4) return false; u.pm = ti >> 2; u.pn = ti & 3; u.kind = 0; u.ka = 0; u.kb = 1024; u.nt = 4; return true; } };
struct EpiPin { bf16* pin;
    __device__ __forceinline__ void operator()(const AccT& acc, const pg8::Unit& u, int wr, int wc, int, int) const { const int l_ = lane_id();
        const int wid = wr * 4 + wc, colw = u.pn * 256 + wc * 64;
        EPI_FOR_AM { *(u32x4*)(pin + G4_PRIV(u, wid, ai * 4 + m, 0, l_)) = pack8(acc[ai][0][m][0], acc[ai][0][m][1]); *(u32x4*)(pin + G4_PRIV(u, wid, ai * 4 + m, 1, l_)) = pack8(acc[ai][1][m][0], acc[ai][1][m][1]); }
    } };

constexpr int LDS_TILE_OFF = 132096;
struct SchedM1 { int G, c; const LAS int* tile;
    __device__ __forceinline__ bool next(int i, pg8::Unit& u) const { const int nt_ = __builtin_amdgcn_readfirstlane(tile[0]); const int nrem = 2 * nt_ - i * G; if (c >= nrem) return false; const long L = (long)i * G + xcd_remap(c, nrem < G ? nrem : G); const int rt = (int)(L >> 1), hh = (int)(L & 1);
        u.pm = rt; u.pn = __builtin_amdgcn_readfirstlane(tile[1 + rt]) * 2 + hh; u.ka = 0; u.kb = 0; u.nt = 16; u.kind = hh; return true; } };
struct EpiM1 { bf16* hid; const float* wrow;
    __device__ __forceinline__ void operator()(const AccT& acc, const pg8::Unit& u, int wr, int wc, int, int) const { const int l_ = lane_id(), fr = l_ & 15, fq = l_ >> 4;
        const int colb = u.kind * 128 + wc * 32 + 8 * fq;
        f32x2 wv[2][4];
        EPI_FOR_AM wv[ai][m] = *(const f32x2*)(wrow + 2 * (size_t)EPI_ROW(u, ai, m));
        EPI_FOR_AM { const int row = EPI_ROW(u, ai, m); const float w = wv[ai][m][0], rs = wv[ai][m][1]; f32x4 v0, v1;
#pragma unroll
            for (int e = 0; e < 4; ++e) { const float g0 = acc[ai][0][m][0][e] * rs, g1 = acc[ai][0][m][1][e] * rs;
                v0[e] = g0 * fast_sigmoid(g0) * acc[ai][1][m][0][e] * w; v1[e] = g1 * fast_sigmoid(g1) * acc[ai][1][m][1][e] * w; }
            *(u32x4*)(hid + (size_t)row * EXP_H + colb) = pack8(v0, v1); }
    } };
struct SchedM2 { int G, c; const LAS int* tile;
    __device__ __forceinline__ bool next(int i, pg8::Unit& u) const { const int nt_ = __builtin_amdgcn_readfirstlane(tile[0]); const int nrem = 4 * nt_ - i * G; if (c >= nrem) return false; const long L = (long)i * G + xcd_remap(c, nrem < G ? nrem : G); const int rt = (int)(L >> 2), ct = (int)(L & 3);
        u.pm = rt; u.pn = __builtin_amdgcn_readfirstlane(tile[1 + rt]) * 4 + ct; u.ka = 0; u.kb = 0; u.nt = 4; u.kind = ct; return true; } };
struct EpiM2 { bf16* y2;
    __device__ __forceinline__ void operator()(const AccT& acc, const pg8::Unit& u, int wr, int wc, int, int) const { const int l_ = lane_id(), fr = l_ & 15, fq = l_ >> 4;
        const int wid = wr * 4 + wc, colw = u.kind * 256 + wc * 64;
        EPI_FOR_AM store_rows16(pack8(acc[ai][0][m][0], acc[ai][0][m][1]), pack8(acc[ai][1][m][0], acc[ai][1][m][1]), y2 + (size_t)EPI_ROW0(u, ai, m) * D + colw, D, wid, l_);
    } };

struct RmId { __device__ __forceinline__ int operator()(int n) const { return n; } };
struct RmRope { __device__ __forceinline__ int operator()(int n) const { const int hl = n & 63; return n < 1536 ? (n & ~63) + (hl < 32 ? 2 * hl : 2 * (hl - 32) + 1) : n; } };
struct RmGU { int base; __device__ __forceinline__ int operator()(int n) const { const int f = n & 127; return base + (n >> 7) * 256 + 64 * (f >> 5) + (f & 31); } };
template <class RM>
__device__ __forceinline__ void tr_matrix(const float* W, int ldw, int K_, int N_, bf16* dst, int ldt, int kdst0, RM rm, LAS float* scr, int gw, int NGW, int lane, int& base, float wscale = 1.f, const float* kscale = nullptr) {
    const int nb = N_ / 32, cnt = (K_ / 64) * nb;
    f32x4 v[8], vn[8]; float ks[8], ksn[8];
#define TR_LOAD(it_, V, KS) do { const int k0_ = ((it_) / nb) * 64, n0_ = ((it_) % nb) * 32; _Pragma("unroll") for (int j = 0; j < 8; ++j) { \
        V[j] = *(const f32x4*)(W + (size_t)(k0_ + j * 8 + (lane >> 3)) * ldw + n0_ + (lane & 7) * 4); KS[j] = kscale ? kscale[k0_ + j * 8 + (lane >> 3)] : 1.f; } } while (0)
    int it = ((gw - base) % NGW + NGW) % NGW;
    if (it < cnt) TR_LOAD(it, v, ks);
#pragma unroll 1
    for (; it < cnt; it += NGW) {
        const int k0 = (it / nb) * 64, n0 = (it % nb) * 32;
#pragma unroll
        for (int j = 0; j < 8; ++j) { LAS float* d_ = scr + (j * 8 + (lane >> 3)) * 33 + (lane & 7) * 4; const f32x4 w_ = v[j] * (ks[j] * wscale); d_[0] = w_[0]; d_[1] = w_[1]; d_[2] = w_[2]; d_[3] = w_[3]; }
        if (it + NGW < cnt) TR_LOAD(it + NGW, vn, ksn);
        LDS_WAIT(); asm volatile("" ::: "memory");
        const int c = lane & 7;
#pragma unroll
        for (int j = 0; j < 4; ++j) { const int n = (lane >> 3) + 8 * j; const LAS float* s = scr + (8 * c) * 33 + n;
            u32x4 o; o.x = pk2(s[0 * 33], s[1 * 33]); o.y = pk2(s[2 * 33], s[3 * 33]); o.z = pk2(s[4 * 33], s[5 * 33]); o.w = pk2(s[6 * 33], s[7 * 33]);
            *(u32x4*)(dst + (size_t)rm(n0 + n) * ldt + kdst0 + k0 + 8 * c) = o; }
        LDS_WAIT(); asm volatile("" ::: "memory");
#pragma unroll
        for (int j = 0; j < 8; ++j) { v[j] = vn[j]; ks[j] = ksn[j]; }
    }
#undef TR_LOAD
    base += cnt;
}
template <int PART> __device__ __forceinline__ void wconv_part(const Frame& F, int layer, int gw, int NGW) {
    LAS float* scr = (LAS float*)F.lds + F.wave * (64 * 33);
    bf16* W = (bf16*)(F.ws + WS_W); int base = 0;
#define SRC(idx, per_layer) ((const float*)arg_ptr<idx>() + (size_t)layer * (per_layer))
    if (PART == 0) { tr_matrix(SRC(I_W_IN, (size_t)D * INW), INW, D, INW, W + WO_IN, D, 0, RmRope{}, scr, gw, NGW, F.lane, base, 1.f, SRC(I_NORM_MIX, D)); return; }
    if (PART == 1) for (int b = 0; b < 3; ++b) tr_matrix(SRC(I_W_GATE, (size_t)D * NGATE) + b * 1024, NGATE, D, 1024, W + WO_BCAT, BCAT_LD, b * 1024, RmId{}, scr, gw, NGW, F.lane, base, NEG_LOG2E, SRC(I_NORM_MIX, D));
    if (PART == 1) { tr_matrix(SRC(I_W_UP_A, (size_t)256 * D), D, 256, D, W + WO_BCAT, BCAT_LD, 3072, RmId{}, scr, gw, NGW, F.lane, base);
    tr_matrix(SRC(I_W_UP_B, (size_t)512 * D), D, 512, D, W + WO_BCAT, BCAT_LD, 3328, RmId{}, scr, gw, NGW, F.lane, base);
    tr_matrix(SRC(I_W_OUT, (size_t)D * D), D, D, D, W + WO_OUT, D, 0, RmId{}, scr, gw, NGW, F.lane, base);
    tr_matrix(SRC(I_W_PLE_IN, (size_t)PLE_DIM * D), D, PLE_DIM, D, W + WO_PLE, PLE_LD, 1024, RmId{}, scr, gw, NGW, F.lane, base); }
    if (PART == 2) {
        for (int e = 0; e < NEXP; ++e) tr_matrix(SRC(I_W_ED, (size_t)NEXP * EXP_H * D) + (size_t)e * EXP_H * D, D, EXP_H, D, W + WO_M2 + (size_t)e * D * EXP_H, EXP_H, 0, RmId{}, scr, gw, NGW, F.lane, base);
        tr_matrix(SRC(I_W_PLE_GATE, (size_t)D * D), D, D, D, W + WO_PLE, PLE_LD, 0, RmId{}, scr, gw, NGW, F.lane, base, NEG_LOG2E, SRC(I_NORM_PLE, D));
        return;
    }
    for (int e = 0; e < NEXP; ++e) {
        tr_matrix(SRC(I_W_EG, (size_t)NEXP * D * EXP_H) + (size_t)e * D * EXP_H, EXP_H, D, EXP_H, W + WO_M1, D, 0, RmGU{e * 512}, scr, gw, NGW, F.lane, base, 1.f, SRC(I_NORM_MOE, D));
        tr_matrix(SRC(I_W_EU, (size_t)NEXP * D * EXP_H) + (size_t)e * D * EXP_H, EXP_H, D, EXP_H, W + WO_M1, D, 0, RmGU{e * 512 + 32}, scr, gw, NGW, F.lane, base, 1.f, SRC(I_NORM_MOE, D));
    }
    {
        const float* wp = SRC(I_W_POOL, (size_t)4 * 128 * 128); const float* ps = SRC(I_POOL_SCALE, 512); const float* wc = SRC(I_W_UP_C, (size_t)512 * D);
        for (int it = ((gw - base) % NGW + NGW) % NGW; it < 1024; it += NGW) {
            const int kc = it >> 4, n = (it & 15) * 64 + F.lane, g = kc >> 4, kl0 = (kc & 15) * 8;
            const float ps0 = ps[g * 128 + F.lane], ps1 = ps[g * 128 + 64 + F.lane];
            float al[8], ah[8], a[8];
#pragma unroll
            for (int q = 0; q < 8; ++q) { al[q] = wp[(size_t)(g * 128 + kl0 + q) * 128 + F.lane] * ps0; ah[q] = wp[(size_t)(g * 128 + kl0 + q) * 128 + 64 + F.lane] * ps1; a[q] = 0.f; }
            float bv[16], bvn[16];
#pragma unroll
            for (int j = 0; j < 16; ++j) bv[j] = wc[(size_t)(g * 128 + j) * D + n];
#pragma unroll 1
            for (int d0 = 0; d0 < 128; d0 += 16) {
                if (d0 + 16 < 128) {
#pragma unroll
                    for (int j = 0; j < 16; ++j) bvn[j] = wc[(size_t)(g * 128 + d0 + 16 + j) * D + n]; }
#pragma unroll
                for (int j = 0; j < 16; ++j)
#pragma unroll
                    for (int q = 0; q < 8; ++q) { const float av = __builtin_bit_cast(float, __builtin_amdgcn_readlane(__builtin_bit_cast(int, d0 < 64 ? al[q] : ah[q]), (d0 + j) & 63)); a[q] += av * bv[j]; }
#pragma unroll
                for (int j = 0; j < 16; ++j) bv[j] = bvn[j];
            }
            u32x4 o; o.x = pk2(a[0], a[1]); o.y = pk2(a[2], a[3]); o.z = pk2(a[4], a[5]); o.w = pk2(a[6], a[7]);
            *(u32x4*)(W + WO_BCAT + (size_t)n * BCAT_LD + 3840 + kc * 8) = o;
        }
    }
#undef SRC
}
__device__ __forceinline__ void ph_wconv(const Frame& F0, int layer) { PHASE_FRAME(F0);
    wconv_part<0>(F, layer, F.wg * NWAVES + F.wave, F.G * NWAVES);
}
__device__ __forceinline__ void ph_ropetab(const Frame& F0) { PHASE_FRAME(F0);
    float* rope = (float*)(F.ws + WS_ROPE); const int* pos = (const int*)arg_ptr<I_POS>();
    const int step = F.G * NTHREADS, i0 = F.wg * NTHREADS + F.tid;
    for (int ib = i0; ib < T * 32; ib += 4 * step) {
        int pv[4];
#pragma unroll
        for (int k = 0; k < 4; ++k) { const int i = ib + k * step; pv[k] = i < T * 32 ? pos[i >> 5] : 0; }
#pragma unroll
        for (int k = 0; k < 4; ++k) { const int i = ib + k * step; if (i < T * 32) { const int j = i & 31;
            const float inv = exp2f(-(float)j * (13.287712379549449f / 32.0f)); const float ang = (float)pv[k] * inv;
            double rev = (double)ang * 0.15915494309189535; rev -= floor(rev); const float fr = (float)rev;
            *(f32x2*)(rope + (size_t)i * 2) = (f32x2){__builtin_amdgcn_cosf(fr), __builtin_amdgcn_sinf(fr)}; } }
    }
}

__device__ __forceinline__ void ph_proj_fast(const Frame& F0, int layer) { PHASE_FRAME(F0);
    rowfac_reset(F.wave, F.lane);
    const pg8::Gemm g{(const bf16*)(F.ws + WS_HCAT), HC, (const bf16*)(F.ws + WS_W) + WO_IN, D, nullptr};
    pg8::gemm_phase<EpiProj, SchedProj, true>((LAS unsigned char*)F.lds, g, SchedProj{F.G, F.wg}, EpiProj{(bf16*)(F.ws + WS_PROJ), (const float*)(F.ws + WS_ROPE), layer == 0 ? nullptr : (const unsigned long long*)(F.ws + SM_SSQ)}, F.tid);
    constexpr int NBUSY = (T / 256) * (INW / 256) - 4 * 256;
    if (F.G == 256 && F.wg >= NBUSY) wconv_part<1>(F, layer, (F.wg - NBUSY) * NWAVES + F.wave, (F.G - NBUSY) * NWAVES);
    else if (F.G != 256) wconv_part<1>(F, layer, F.wg * NWAVES + F.wave, F.G * NWAVES);
}
__device__ __forceinline__ void ph_g4_fast(const Frame& F0, int layer) { PHASE_FRAME(F0);
    rowfac_reset(F.wave, F.lane);
    const pg8::Gemm g{(const bf16*)(F.ws + WS_HCAT), HC, (const bf16*)(F.ws + WS_W) + WO_BCAT, BCAT_LD, nullptr};
    pg8::gemm_phase<EpiG4, SchedG4, true>((LAS unsigned char*)F.lds, g, SchedG4{F.G, F.wg, (unsigned*)(F.ws + WS_CTL) + 4096, (const volatile LAS unsigned*)((LAS unsigned char*)lds_raw + (131072 + 320)) + 8, F.wave}, EpiG4{(bf16*)(F.ws + OV_GT), (bf16*)(F.ws + OV_MERGED), (const float*)arg_ptr<I_B_GATE>() + layer * NGATE, layer == 0 ? nullptr : (const unsigned long long*)(F.ws + SM_SSQ), (bf16*)(F.ws + OV_HID)}, F.tid);
}
__device__ __forceinline__ void ph_g5_fast(const Frame& F0, int layer) { PHASE_FRAME(F0);
    const pg8::Gemm g{(const bf16*)(F.ws + OV_MERGED), D, (const bf16*)(F.ws + WS_W) + WO_OUT, D, nullptr};
    if (layer == 0) pg8::gemm_phase<EpiG5<true>, SchedG5, true>((LAS unsigned char*)F.lds, g, SchedG5{F.G, F.wg}, EpiG5<true>{arg_ptr<I_X>(), (bf16*)F.out, D}, F.tid);
    else pg8::gemm_phase<EpiG5<false>, SchedG5, true>((LAS unsigned char*)F.lds, g, SchedG5{F.G, F.wg}, EpiG5<false>{(const void*)((const bf16*)(F.ws + WS_HCAT) + HC_H), (bf16*)F.out, HC}, F.tid);
}
__device__ __forceinline__ void ph_ple_fast(const Frame& F0, int layer) { PHASE_FRAME(F0);
    const pg8::Gemm g{(const bf16*)F.out, D, (const bf16*)(F.ws + WS_W) + WO_PLE, PLE_LD, nullptr};
    const bool last = layer == DEPTH - 1;
    pg8::gemm_phase<EpiPle, SchedPle, true>((LAS unsigned char*)F.lds, g, SchedPle{F.G, F.wg}, EpiPle{(const bf16*)(F.ws + OV_GT), (const bf16*)F.out, last ? (bf16*)(F.ws + OV_X3) : (bf16*)(F.ws + WS_HCAT) + HC_H, last ? D : HC,
        (const float*)(F.ws + SM_RSTD_PLE), last ? nullptr : (unsigned long long*)(F.ws + SM_SSQ)}, F.tid);
}
__device__ __forceinline__ void ph_m1_fast(const Frame& F0, int layer) { PHASE_FRAME(F0);
    const pg8::Gemm g{(const bf16*)F.out, D, (const bf16*)(F.ws + WS_W) + WO_M1, D, (const int*)(F.ws + SM_ROWTOK)};
    { const int* tg = (const int*)(F.ws + SM_TILE); LAS int* tl = (LAS int*)((LAS unsigned char*)F.lds + LDS_TILE_OFF); if (F.tid < 161) tl[F.tid] = tg[F.tid]; __syncthreads(); }
    pg8::gemm_phase<EpiM1, SchedM1, true, true>((LAS unsigned char*)F.lds, g, SchedM1{F.G, F.wg, (const LAS int*)((LAS unsigned char*)F.lds + LDS_TILE_OFF)}, EpiM1{(bf16*)(F.ws + OV_HID), (const float*)(F.ws + SM_WROW)}, F.tid);
    {   const pg8::Gemm gp{(const bf16*)F.out + (size_t)T * D, D, (const bf16*)(F.ws + WS_W) + WO_PLE, PLE_LD, nullptr};
        const bool std_ = F.G == 256;
        if (!std_ || F.wg >= 32) pg8::gemm_phase<EpiPin, SchedPin, true>((LAS unsigned char*)F.lds, gp, SchedPin{std_ ? F.G - 32 : F.G, std_ ? F.wg - 32 : F.wg}, EpiPin{(bf16*)(F.ws + OV_GT)}, F.tid); }
    if (F.G == 256 && F.wg >= 64) { wconv_part<2>(F, layer, (F.wg - 64) * NWAVES + F.wave, (F.G - 64) * NWAVES); if (layer + 1 < DEPTH) wconv_part<0>(F, layer + 1, (F.wg - 64) * NWAVES + F.wave, (F.G - 64) * NWAVES); }
    else if (F.G != 256) { wconv_part<2>(F, layer, F.wg * NWAVES + F.wave, F.G * NWAVES); if (layer + 1 < DEPTH) wconv_part<0>(F, layer + 1, F.wg * NWAVES + F.wave, F.G * NWAVES); }
}
__device__ __forceinline__ void ph_m2_fast(const Frame& F0) { PHASE_FRAME(F0);
    const pg8::Gemm g{(const bf16*)(F.ws + OV_HID), EXP_H, (const bf16*)(F.ws + WS_W) + WO_M2, EXP_H, nullptr};
    { const int* tg = (const int*)(F.ws + SM_TILE); LAS int* tl = (LAS int*)((LAS unsigned char*)F.lds + LDS_TILE_OFF); if (F.tid < 161) tl[F.tid] = tg[F.tid]; __syncthreads(); }
    pg8::gemm_phase<EpiM2, SchedM2, true>((LAS unsigned char*)F.lds, g, SchedM2{F.G, F.wg, (const LAS int*)((LAS unsigned char*)F.lds + LDS_TILE_OFF)}, EpiM2{(bf16*)(F.ws + OV_Y2)}, F.tid);
}

constexpr size_t SM_CHUNK = WS_SMALL + 720 * 1024;
__device__ __forceinline__ int wave_sum_i(int v) {
#pragma unroll
    for (int o = 1; o < 64; o <<= 1) v += __shfl_xor(v, o);
    return v;
}
#define RW_SLOT(gg, k) ((((size_t)(gg) * 8 + ((k) >> 7)) * 2 + ((k) & 1)) * 64 + (((k) >> 1) & 63))
__device__ __forceinline__ void ph_route_pre(const Frame& F0, int layer) { PHASE_FRAME(F0);
    const float* wrg = (const float*)arg_ptr<I_W_RG>() + (size_t)layer * D * 4; const float* wre = (const float*)arg_ptr<I_W_RE>() + (size_t)layer * 4 * D * 4;
    {
        const float* p = (const float*)arg_ptr<I_P>() + (size_t)layer * T * PLE_DIM; bf16* pob = (bf16*)F.out + (size_t)T * D; f32x4 pv8[8];
#pragma unroll
        for (int q = 0; q < 8; ++q) pv8[q] = *(const f32x4*)(p + (size_t)(F.wg * 64 + F.wave * 8 + q) * PLE_DIM + F.lane * 4);
#pragma unroll
        for (int q = 0; q < 8; ++q) { u32x2 po; po.x = pk2(pv8[q][0], pv8[q][1]); po.y = pk2(pv8[q][2], pv8[q][3]); *(u32x2*)(pob + (size_t)(F.wg * 64 + F.wave * 8 + q) * D + F.lane * 4) = po; } }
    LAS float* Wl = (LAS float*)F.lds;
    LAS int* cnt = (LAS int*)(F.lds + 5 * 1024 * 4);
    for (int i = F.tid; i < 1024; i += NTHREADS) { *(LAS f32x4*)(Wl + RW_SLOT(0, i) * 4) = *(const f32x4*)(wrg + (size_t)i * 4);
#pragma unroll
        for (int gg = 0; gg < 4; ++gg) *(LAS f32x4*)(Wl + RW_SLOT(1 + gg, i) * 4) = *(const f32x4*)(wre + ((size_t)gg * D + i) * 4); }
    if (F.tid < 16) cnt[F.tid] = 0;
    __syncthreads();
}
__device__ __forceinline__ void ph_route2(const Frame& F0, int layer) { PHASE_FRAME(F0);
    const float* g = (const float*)arg_ptr<I_NORM_MOE>() + layer * D;
    const float* brg = (const float*)arg_ptr<I_B_RG>() + layer * 4; const float* bre = (const float*)arg_ptr<I_B_RE>() + layer * 16;
    int* eid = (int*)(F.ws + SM_EID); float* wgt = (float*)(F.ws + SM_WGT); int* chunk = (int*)(F.ws + SM_CHUNK);
    LAS float* Wl = (LAS float*)F.lds;
    LAS int* cnt = (LAS int*)(F.lds + 5 * 1024 * 4);
    const int tw0 = F.wg * 64 + F.wave * 8;
    unsigned xw[4][8]; f32x2 gk[8];
#pragma unroll
    for (int i = 0; i < 8; ++i) {
#pragma unroll
        for (int q = 0; q < 4; ++q) xw[q][i] = *(const unsigned*)((const bf16*)F.out + (size_t)(tw0 + q) * D + i * 128 + 2 * F.lane);
        gk[i] = *(const f32x2*)(g + i * 128 + 2 * F.lane); }
#pragma unroll 1
    for (int pass = 0; pass < 2; ++pass) {
        const int tk = tw0 + pass * 4;
        float a20[20];
#pragma unroll
        for (int i = 0; i < 20; ++i) a20[i] = 0.f;
#pragma unroll
        for (int i = 0; i < 8; ++i) { const int k = i * 128 + 2 * F.lane;
            const f32x4 w0 = *(const LAS f32x4*)(Wl + RW_SLOT(0, k) * 4), w1 = *(const LAS f32x4*)(Wl + RW_SLOT(0, k + 1) * 4);
#pragma unroll
            for (int q = 0; q < 4; ++q) { const float x0 = bflo(xw[q][i]), x1 = bfhi(xw[q][i]); a20[q * 5] += x0 * x0 + x1 * x1; const float y0 = x0 * gk[i][0], y1 = x1 * gk[i][1];
#pragma unroll
                for (int e = 0; e < 4; ++e) a20[q * 5 + 1 + e] += y0 * w0[e] + y1 * w1[e]; } }
        float u5[5];
        {   float w10[10];
#pragma unroll
            for (int i = 0; i < 10; ++i) { const float lo = a20[i], hi_ = a20[10 + i]; const bool up = (F.lane & 32) != 0; const float keep = up ? hi_ : lo, send = up ? lo : hi_; w10[i] = keep + __shfl_xor(send, 32); }
#pragma unroll
            for (int i = 0; i < 5; ++i) { const bool up = (F.lane & 16) != 0; const float keep = up ? w10[i + 5] : w10[i], send = up ? w10[i] : w10[i + 5]; u5[i] = keep + __shfl_xor(send, 16); } }
#pragma unroll
        for (int i = 0; i < 5; ++i) { float v = u5[i]; v += __shfl_xor(v, 8); v += __shfl_xor(v, 4); v += __shfl_xor(v, 2); v += __shfl_xor(v, 1); u5[i] = v; }
        const float rsq = 1.f / sqrtf(u5[0] * (1.f / D) + EPS);
        float lg[4];
#pragma unroll
        for (int e = 0; e < 4; ++e) lg[e] = u5[1 + e] * rsq + brg[e];
        int gi = 0; float mx = lg[0];
#pragma unroll
        for (int e = 1; e < 4; ++e) if (lg[e] > mx) { mx = lg[e]; gi = e; }
        float den = 0.f;
#pragma unroll
        for (int e = 0; e < 4; ++e) den += __expf(lg[e] - mx);
        const float p1 = 1.f / den;
        float rs[4]; int gq[4];
#pragma unroll
        for (int q = 0; q < 4; ++q) { rs[q] = __builtin_bit_cast(float, __builtin_amdgcn_readlane(__builtin_bit_cast(int, rsq), q * 16)); gq[q] = __builtin_amdgcn_readlane(gi, q * 16); }
        float a16[16];
#pragma unroll
        for (int i = 0; i < 16; ++i) a16[i] = 0.f;
#pragma unroll
        for (int i = 0; i < 8; ++i) { const int k = i * 128 + 2 * F.lane;
#pragma unroll
            for (int q = 0; q < 4; ++q) { const f32x4 w0 = *(const LAS f32x4*)(Wl + RW_SLOT(1 + gq[q], k) * 4), w1 = *(const LAS f32x4*)(Wl + RW_SLOT(1 + gq[q], k + 1) * 4);
                const float y0 = bflo(xw[q][i]) * gk[i][0], y1 = bfhi(xw[q][i]) * gk[i][1];
#pragma unroll
                for (int e = 0; e < 4; ++e) a16[q * 4 + e] += y0 * w0[e] + y1 * w1[e]; } }
        float u4[4];
        {   float w8[8];
#pragma unroll
            for (int i = 0; i < 8; ++i) { const float lo = a16[i], hi_ = a16[8 + i]; const bool up = (F.lane & 32) != 0; const float keep = up ? hi_ : lo, send = up ? lo : hi_; w8[i] = keep + __shfl_xor(send, 32); }
#pragma unroll
            for (int i = 0; i < 4; ++i) { const bool up = (F.lane & 16) != 0; const float keep = up ? w8[i + 4] : w8[i], send = up ? w8[i] : w8[i + 4]; u4[i] = keep + __shfl_xor(send, 16); } }
#pragma unroll
        for (int i = 0; i < 4; ++i) { float v = u4[i]; v += __shfl_xor(v, 8); v += __shfl_xor(v, 4); v += __shfl_xor(v, 2); v += __shfl_xor(v, 1); u4[i] = v; }
        if ((F.lane & 15) == 0) {
            const int q = F.lane >> 4;
            float ls[4];
#pragma unroll
            for (int e = 0; e < 4; ++e) ls[e] = u4[e] * rsq + bre[gi * 4 + e];
            int i0 = 0; float v0 = ls[0];
#pragma unroll
            for (int e = 1; e < 4; ++e) if (ls[e] > v0) { v0 = ls[e]; i0 = e; }
            int i1 = -1; float v1 = -3.0e38f;
#pragma unroll
            for (int e = 0; e < 4; ++e) if (e != i0 && ls[e] > v1) { v1 = ls[e]; i1 = e; }
            const float ex = __expf(v1 - v0), w0_ = p1 / (1.f + ex), w1_ = p1 * ex / (1.f + ex);
            const int t = tk + q, ea = gi * 4 + i0, eb = gi * 4 + i1;
            eid[t * 2 + 0] = ea; eid[t * 2 + 1] = eb; wgt[t * 2 + 0] = w0_; wgt[t * 2 + 1] = w1_; ((float*)(F.ws + SM_RSTD_MOE))[t] = rsq;
            __hip_atomic_fetch_add(&cnt[ea], 1, __ATOMIC_RELAXED, __HIP_MEMORY_SCOPE_WORKGROUP); __hip_atomic_fetch_add(&cnt[eb], 1, __ATOMIC_RELAXED, __HIP_MEMORY_SCOPE_WORKGROUP);
        }
        if (pass == 0) {
#pragma unroll
            for (int i = 0; i < 8; ++i)
#pragma unroll
                for (int q = 0; q < 4; ++q) xw[q][i] = *(const unsigned*)((const bf16*)F.out + (size_t)(tw0 + 4 + q) * D + i * 128 + 2 * F.lane); }
    }
    __syncthreads();
    if (F.tid < 16) chunk[F.wg * 16 + F.tid] = cnt[F.tid];
}
__device__ __forceinline__ void ph_scatter2(const Frame& F0) { PHASE_FRAME(F0);
    const int* eid = (const int*)(F.ws + SM_EID); const float* wgt = (const float*)(F.ws + SM_WGT); const int* chunk = (const int*)(F.ws + SM_CHUNK);
    int* rowtok = (int*)(F.ws + SM_ROWTOK); float* wrow = (float*)(F.ws + SM_WROW); int* tile = (int*)(F.ws + SM_TILE);
    LAS int* L = (LAS int*)F.lds;
    const int t0 = F.wg * 64;
    int e0 = 0, e1 = 0; float wg0 = 0.f, wg1 = 0.f, r0 = 0.f, r1 = 0.f;
    if (F.wave == 0) { const float* rstd = (const float*)(F.ws + SM_RSTD_MOE); e0 = eid[t0 * 2 + F.lane]; e1 = eid[t0 * 2 + 64 + F.lane]; wg0 = wgt[t0 * 2 + F.lane]; wg1 = wgt[t0 * 2 + 64 + F.lane]; r0 = rstd[t0 + (F.lane >> 1)]; r1 = rstd[t0 + 32 + (F.lane >> 1)]; }
#pragma unroll
    for (int ee = 0; ee < 2; ++ee) { const int e = 2 * F.wave + ee; int ts = 0, ps = 0;
        for (int ch = F.lane; ch < F.G; ch += 64) { const int v = chunk[ch * 16 + e]; ts += v; ps += (ch < F.wg) ? v : 0; }
        ts = wave_sum_i(ts); ps = wave_sum_i(ps);
        if (F.lane == 0) { L[e] = ts; L[16 + e] = ps; } }
    __syncthreads();
    if (F.tid == 0) { int b = 0;
        for (int e = 0; e < NEXP; ++e) { L[32 + e] = b; const int ntl = (L[e] + 255) >> 8; if (F.wg == 0) for (int q = 0; q < ntl; ++q) tile[1 + (b >> 8) + q] = e; b += ntl << 8; }
        if (F.wg == 0) tile[0] = b >> 8; }
    __syncthreads();
    if (F.wave == 0) {
        int p0 = 0, p1 = 0;
        const unsigned long long below = (1ull << F.lane) - 1ull;
#pragma unroll
        for (int e = 0; e < NEXP; ++e) { const unsigned long long b0 = __ballot(e0 == e), b1 = __ballot(e1 == e);
            if (e0 == e) p0 = __popcll(b0 & below); if (e1 == e) p1 = __popcll(b0) + __popcll(b1 & below); }
        const int s0 = L[32 + e0] + L[16 + e0] + p0, s1 = L[32 + e1] + L[16 + e1] + p1;
        L[64 + F.lane] = s0; L[128 + F.lane] = s1;
        ((int*)(F.ws + SM_SLOT2))[t0 * 2 + F.lane] = s0; ((int*)(F.ws + SM_SLOT2))[t0 * 2 + 64 + F.lane] = s1;
        rowtok[s0] = t0 + (F.lane >> 1); *(f32x2*)(wrow + 2 * (size_t)s0) = (f32x2){wg0 * r0, r0}; rowtok[s1] = t0 + 32 + (F.lane >> 1); *(f32x2*)(wrow + 2 * (size_t)s1) = (f32x2){wg1 * r1, r1};
    }
    __syncthreads();
    for (int e = F.wg; e < NEXP; e += F.G) { const int b = L[32 + e], n = L[e], np = ((n + 255) >> 8) << 8; for (int s = n + F.tid; s < np; s += NTHREADS) { rowtok[b + s] = 0; *(f32x2*)(wrow + 2 * (size_t)(b + s)) = (f32x2){0.f, 0.f}; } }
}
__device__ __forceinline__ void ph_e_fast(const Frame& F0, int layer) { PHASE_FRAME(F0);
    const bf16* y2 = (const bf16*)(F.ws + OV_Y2); const int* slot2 = (const int*)(F.ws + SM_SLOT2);
    u32x2 xw[2][4], ya[2][4], yb[2][4], xwn[2][4], yan[2][4], ybn[2][4];
#define E_LOAD(t0_, XW, YA, YB) do { _Pragma("unroll") for (int r = 0; r < 2; ++r) { const size_t t = (size_t)(t0_) + r; \
        const size_t sa = (size_t)__builtin_amdgcn_readfirstlane(slot2[t * 2]), sb = (size_t)__builtin_amdgcn_readfirstlane(slot2[t * 2 + 1]); \
        _Pragma("unroll") for (int j = 0; j < 4; ++j) { const int k = j * 256 + F.lane * 4; XW[r][j] = *(const u32x2*)((const bf16*)F.out + t * D + k); YA[r][j] = *(const u32x2*)(y2 + sa * D + k); YB[r][j] = *(const u32x2*)(y2 + sb * D + k); } } } while (0)
    const int tstep = F.G * NWAVES * 2; int t0 = (F.wg * NWAVES + F.wave) * 2;
    if (t0 < T) E_LOAD(t0, xw, ya, yb);
#pragma unroll 1
    for (; t0 < T; t0 += tstep) {
        const bool has_next = t0 + tstep < T;
        if (has_next) E_LOAD(t0 + tstep, xwn, yan, ybn);
#pragma unroll
        for (int r = 0; r < 2; ++r) { const size_t t = t0 + r; float s = 0.f; f32x4 xv[4];
#pragma unroll
            for (int j = 0; j < 4; ++j) { f32x4 v = (f32x4){bflo(xw[r][j].x), bfhi(xw[r][j].x), bflo(xw[r][j].y), bfhi(xw[r][j].y)};
                v[0] += bflo(ya[r][j].x) + bflo(yb[r][j].x); v[1] += bfhi(ya[r][j].x) + bfhi(yb[r][j].x); v[2] += bflo(ya[r][j].y) + bflo(yb[r][j].y); v[3] += bfhi(ya[r][j].y) + bfhi(yb[r][j].y);
                xv[j] = v; s += (v[0] * v[0] + v[1] * v[1]) + (v[2] * v[2] + v[3] * v[3]); u32x2 xo; xo.x = pk2(v[0], v[1]); xo.y = pk2(v[2], v[3]); *(u32x2*)((bf16*)F.out + t * D + j * 256 + F.lane * 4) = xo; }
            const float rr = 1.f / sqrtf(wave_sum(s) * (1.f / D) + EPS);
            if (F.lane == 0) { ((float*)(F.ws + SM_RSTD_PLE))[t] = rr;
                if (layer + 1 < DEPTH) ((unsigned long long*)(F.ws + SM_SSQ))[t] = 0ull; }
        }
        if (has_next) {
#pragma unroll
            for (int r = 0; r < 2; ++r) {
#pragma unroll
                for (int j = 0; j < 4; ++j) { xw[r][j] = xwn[r][j]; ya[r][j] = yan[r][j]; yb[r][j] = ybn[r][j]; } } }
    }
#undef E_LOAD
}


typedef float f32x16 __attribute__((ext_vector_type(16)));
typedef short s16x4 __attribute__((ext_vector_type(4)));
#define MFMA32(a, b, c) __builtin_amdgcn_mfma_f32_32x32x16_bf16((a), (b), (c), 0, 0, 0)
constexpr int AT_K = 0, AT_V = 49152, AT_OST = 98304, AT_FLAG = 131072;
constexpr float NEG_BIG = -1.0e30f;
#ifndef SB_EARLY_EXIT
#define SB_EARLY_EXIT 1
#endif
constexpr float SB_EXIT_THR = 160.0f;

__device__ __forceinline__ int crow(int r, int hi) { return (r & 3) + 8 * (r >> 2) + 4 * hi; }
template <int S> __device__ __forceinline__ bf16x8 pack_step(const f32x16& x) {
    u32x4 p; p.x = cvt_pk_bf16(x[8 * S], x[8 * S + 1]); p.y = cvt_pk_bf16(x[8 * S + 2], x[8 * S + 3]); p.z = cvt_pk_bf16(x[8 * S + 4], x[8 * S + 5]); p.w = cvt_pk_bf16(x[8 * S + 6], x[8 * S + 7]);
    return __builtin_bit_cast(bf16x8, p); }
__device__ __forceinline__ void glds16(const void* gsrc, LAS unsigned char* dst) { __builtin_amdgcn_global_load_lds((const unsigned*)gsrc, (LAS unsigned*)dst, 16, 0, 0); }
typedef short v4i16_t __attribute__((ext_vector_type(4)));
__device__ __forceinline__ s16x4 vtr(const LAS unsigned char* p) { return __builtin_bit_cast(s16x4, __builtin_amdgcn_ds_read_tr16_b64_v4i16((LAS v4i16_t*)p)); }
#define AT_WAITBAR() asm volatile("s_waitcnt vmcnt(0) lgkmcnt(0)\n\ts_barrier" ::: "memory")

__device__ __forceinline__ void at_qkt(f32x16& p0, f32x16& p1, const LAS unsigned char* kt, const bf16x8 (&qr)[4], int r32, int hi) {
    const LAS unsigned char* kb = kt + r32 * 128; const int x = r32 & 7;
    const f32x16 zero = {0.f, 0.f, 0.f, 0.f, 0.f, 0.f, 0.f, 0.f, 0.f, 0.f, 0.f, 0.f, 0.f, 0.f, 0.f, 0.f};
#pragma unroll
    for (int d0 = 0; d0 < 4; ++d0) { const int off = ((2 * d0 + hi) ^ x) * 16; const bf16x8 b0 = *(const LAS bf16x8*)(kb + off), b1 = *(const LAS bf16x8*)(kb + 4096 + off);
        p0 = MFMA32(b0, qr[d0], d0 == 0 ? zero : p0); p1 = MFMA32(b1, qr[d0], d0 == 0 ? zero : p1); }
}
__device__ __forceinline__ void at_pv(f32x16& o0, f32x16& o1, const LAS unsigned char* vt, int lane, int hi, bf16x8 pa0, bf16x8 pa1, bf16x8 pa2, bf16x8 pa3) {
    const LAS unsigned char* vp = vt + ((lane >> 4) & 1) * 32 + (lane & 3) * 8 + (4 * hi + ((lane & 15) >> 2)) * 64;
#define AT_VF(off) ({ const s16x4 lo_ = vtr(vp + (off)), hi_ = vtr(vp + (off) + 512); (bf16x8){lo_[0], lo_[1], lo_[2], lo_[3], hi_[0], hi_[1], hi_[2], hi_[3]}; })
    o0 = MFMA32(pa0, AT_VF(0), o0);    o0 = MFMA32(pa1, AT_VF(1024), o0); o0 = MFMA32(pa2, AT_VF(2048), o0); o0 = MFMA32(pa3, AT_VF(3072), o0);
    o1 = MFMA32(pa0, AT_VF(4096), o1); o1 = MFMA32(pa1, AT_VF(5120), o1); o1 = MFMA32(pa2, AT_VF(6144), o1); o1 = MFMA32(pa3, AT_VF(7168), o1);
#undef AT_VF
}
template <class RowPtr>
__device__ __forceinline__ void at_store_o(const f32x16& o0, const f32x16& o1, const float (&sc)[16], LAS unsigned char* lds, int wid, int lane, RowPtr rowptr) {
    const int r32 = lane & 31, hi = lane >> 5; LAS bf16* stg = (LAS bf16*)(lds + AT_OST + wid * 4096);
#pragma unroll
    for (int r = 0; r < 16; ++r) { const int orow = crow(r, hi); const unsigned pk = cvt_pk_bf16(o0[r] * sc[r], o1[r] * sc[r]); stg[orow * 64 + r32] = (bf16)(pk & 0xffffu); stg[orow * 64 + 32 + r32] = (bf16)(pk >> 16); }
    LDS_WAIT();
#pragma unroll
    for (int i = 0; i < 4; ++i) { const int row = i * 8 + (lane >> 3), ch = lane & 7; const u32x4 v = *(const LAS u32x4*)(stg + row * 64 + ch * 8); *(u32x4*)(rowptr(row) + ch * 8) = v; }
}

struct SbRow { bf16* base; __device__ __forceinline__ bf16* operator()(int row) const { return base + (size_t)row * HC; } };
__device__ __forceinline__ void sb_unit(const Frame& F, int b, int h, int qb, const bf16* proj, bf16* hc) {
    LAS unsigned char* lds = (LAS unsigned char*)lds_raw;
    const int lane = F.lane, r32 = lane & 31, hi = lane >> 5, wid = F.wave;
    const size_t rowbase = (size_t)b * SEQ; const int q0 = qb * 256;
    const bf16* Qw = proj + PJ_HM(36 + h, rowbase + q0 + wid * 32);
    const bf16* ksrc = proj + PJ_HM(44 + h, rowbase + 8 * wid + (lane >> 3)) + (((lane & 7) ^ ((lane >> 3) & 7)) * 8);
    const bf16* vsrc = proj + PJ_HM(52 + h, rowbase + 16 * (wid & 3) + (lane >> 2)) + (wid >> 2) * 32 + (lane & 3) * 8;
#define SB_DMA(t, slot) do { glds16(ksrc + (size_t)(t) * 64 * 64, lds + AT_K + (slot) * 8192 + wid * 1024); glds16(vsrc + (size_t)(t) * 64 * 64, lds + AT_V + (slot) * 8192 + wid * 1024); } while (0)
    bf16x8 qr[4];
#pragma unroll
    for (int d0 = 0; d0 < 4; ++d0) qr[d0] = *(const bf16x8*)(Qw + (size_t)r32 * 64 + d0 * 16 + hi * 8);
    bf16x8 tri0, tri1, ones;
#pragma unroll
    for (int j = 0; j < 8; ++j) { const int k0 = 8 * (j >> 2) + 4 * hi + (j & 3); tri0[j] = (k0 >= r32) ? (short)0x3F80 : (short)0; tri1[j] = (16 + k0 >= r32) ? (short)0x3F80 : (short)0; ones[j] = (short)0x3F80; }
    const int NT = 4 * (qb + 1), jd = 4 * qb + (wid >> 1), qpos = q0 + wid * 32 + r32;
    f32x16 o0, o1;
#pragma unroll
    for (int r = 0; r < 16; ++r) { o0[r] = 0.f; o1[r] = 0.f; }
    float carry = 0.f;
    SB_DMA(NT - 1, 0); AT_WAITBAR();
    int cur = 0; bool wdone = false;
    for (int t = NT - 1; t >= 0; --t) {
        if (t > 0) SB_DMA(t - 1, cur ^ 1);
        if (t <= jd && !wdone) {
            f32x16 z0, z1;
            at_qkt(z0, z1, lds + AT_K + cur * 8192, qr, r32, hi);
            if (t == jd) { const int kb_ = 64 * t + 4 * hi;
#pragma unroll
                for (int r = 0; r < 16; ++r) { const int kv = kb_ + (r & 3) + 8 * (r >> 2); if (kv >= qpos) z0[r] = NEG_BIG; if (kv + 32 >= qpos) z1[r] = NEG_BIG; } }
            f32x16 s0, s1;
#pragma unroll
            for (int r = 0; r < 16; ++r) { z0[r] = __builtin_amdgcn_fmed3f(z0[r], 126.f, -3.0e38f); z1[r] = __builtin_amdgcn_fmed3f(z1[r], 126.f, -3.0e38f);
                s0[r] = __builtin_amdgcn_logf(1.f + __builtin_amdgcn_exp2f(z0[r])); s1[r] = __builtin_amdgcn_logf(1.f + __builtin_amdgcn_exp2f(z1[r])); }
            const bf16x8 x0a = pack_step<0>(s0), x0b = pack_step<1>(s0), x1a = pack_step<0>(s1), x1b = pack_step<1>(s1);
            f32x16 T1, y1, y0;
#pragma unroll
            for (int r = 0; r < 16; ++r) { T1[r] = carry; y1[r] = carry - z1[r]; }
            T1 = MFMA32(ones, x1a, T1); T1 = MFMA32(ones, x1b, T1);
            y1 = MFMA32(tri0, x1a, y1); y1 = MFMA32(tri1, x1b, y1);
#pragma unroll
            for (int r = 0; r < 16; ++r) y0[r] = T1[r] - z0[r];
            y0 = MFMA32(tri0, x0a, y0); y0 = MFMA32(tri1, x0b, y0);
            T1 = MFMA32(ones, x0a, T1); T1 = MFMA32(ones, x0b, T1); carry = T1[0];
#pragma unroll
            for (int r = 0; r < 16; ++r) { y0[r] = __builtin_amdgcn_exp2f(-y0[r]); y1[r] = __builtin_amdgcn_exp2f(-y1[r]); }
            at_pv(o0, o1, lds + AT_V + cur * 8192, lane, hi, pack_step<0>(y0), pack_step<1>(y0), pack_step<0>(y1), pack_step<1>(y1));
        }
        if (SB_EARLY_EXIT) { wdone = __all(carry > SB_EXIT_THR) != 0; if (lane == 0) ((LAS int*)(lds + AT_FLAG))[(t & 1) * 8 + wid] = wdone ? 1 : 0; }
        AT_WAITBAR();
        if (SB_EARLY_EXIT) { const LAS int* fl = (const LAS int*)(lds + AT_FLAG) + (t & 1) * 8; const int all = fl[0] & fl[1] & fl[2] & fl[3] & fl[4] & fl[5] & fl[6] & fl[7];
            if (__builtin_amdgcn_readfirstlane(all)) break; }
        cur ^= 1;
    }
#undef SB_DMA
    float one[16];
#pragma unroll
    for (int r = 0; r < 16; ++r) one[r] = 1.f;
    at_store_o(o0, o1, one, lds, wid, lane, SbRow{hc + (rowbase + q0 + wid * 32) * HC + HC_OB + h * 64});
    AT_WAITBAR();
}
__device__ __forceinline__ void ph_sb_fast(const Frame& F0) { PHASE_FRAME(F0);
    const bf16* proj = (const bf16*)(F.ws + WS_PROJ); bf16* hc = (bf16*)(F.ws + WS_HCAT);
    for (int idx0 = F.wg; idx0 < 256; idx0 += F.G) { const int idx = F.G == 256 ? xcd_remap(idx0, 256) : idx0, bh = idx >> 3, s = idx & 7;
        sb_unit(F, bh >> 3, bh & 7, 15 - s, proj, hc); sb_unit(F, bh >> 3, bh & 7, s, proj, hc); }
}

struct DilRow { bf16* base; size_t stride; __device__ __forceinline__ bf16* operator()(int row) const { return base + (size_t)row * stride; } };
struct DilUnit { int b, gj, res, blk, d, l0; size_t rowbase, prow; };
__device__ __forceinline__ DilUnit dil_decode(int u) { DilUnit U; const int x = u & 15, bgj = u >> 4; U.gj = bgj % 12; U.b = bgj / 12; const int g = U.gj >> 2;
    U.res = g == 0 ? 0 : (g == 1 ? (x >> 2) : x); U.blk = g == 0 ? x : (g == 1 ? (x & 3) : 0); U.d = (g == 0) ? 1 : (g == 1 ? 4 : 16); U.l0 = U.blk * 256; U.rowbase = (size_t)U.b * SEQ; U.prow = U.rowbase + (size_t)U.res * (SEQ / U.d); return U; }
__device__ __forceinline__ void dil_issue_k(const DilUnit& U, const bf16* proj, LAS unsigned char* lds, int wid, int lane) {
#pragma unroll 1
    for (int tile = 0; tile < 6; ++tile) { int lk = U.l0 - 128 + tile * 64 + 8 * wid + (lane >> 3); lk = lk < 0 ? 0 : lk;
        glds16(proj + PJ_HM(12 + U.gj, U.prow + lk) + (((lane & 7) ^ ((lane >> 3) & 7)) * 8), lds + AT_K + tile * 8192 + wid * 1024); } }
__device__ __forceinline__ void dil_issue_v(const DilUnit& U, const bf16* proj, LAS unsigned char* lds, int wid, int lane) {
#pragma unroll 1
    for (int tile = 0; tile < 6; ++tile) { int lv = U.l0 - 128 + tile * 64 + 16 * (wid & 3) + (lane >> 2); lv = lv < 0 ? 0 : lv;
        glds16(proj + PJ_HM(24 + U.gj, U.prow + lv) + (wid >> 2) * 32 + (lane & 3) * 8, lds + AT_V + tile * 8192 + wid * 1024); } }
__device__ __forceinline__ void dil_load_q(const DilUnit& U, const bf16* proj, bf16x8 (&q)[4], int wid, int r32, int hi) {
    const bf16* qp = proj + PJ_HM(U.gj, U.prow + U.l0 + 32 * wid + r32);
#pragma unroll
    for (int d0 = 0; d0 < 4; ++d0) q[d0] = *(const bf16x8*)(qp + d0 * 16 + hi * 8); }
#define AT_BAR() asm volatile("s_waitcnt lgkmcnt(0)\n\ts_barrier" ::: "memory")
__device__ __forceinline__ void ph_dil_fast(const Frame& F0) { PHASE_FRAME(F0);
    bf16* proj = (bf16*)(F.ws + WS_PROJ); float* lse = (float*)(F.ws + WS_LSE);
    LAS unsigned char* lds = (LAS unsigned char*)lds_raw;
    const int lane = F.lane, r32 = lane & 31, hi = lane >> 5, wid = F.wave;
    const int NU = BATCH * 12 * 16;
    if (F.wg >= NU) return;
    const int c_ = F.G == 256 ? xcd_remap(F.wg, 256) : F.wg;
    DilUnit U = dil_decode(c_);
    bf16x8 qr[4], qn[4];
    dil_load_q(U, proj, qr, wid, r32, hi);
    asm volatile("s_waitcnt vmcnt(0)" : "+v"(qr[0]), "+v"(qr[1]), "+v"(qr[2]), "+v"(qr[3]) :: "memory");
    dil_issue_k(U, proj, lds, wid, lane); dil_issue_v(U, proj, lds, wid, lane);
#pragma unroll 1
    for (int u = c_; u < NU; u += F.G) {
        const bool has_next = u + F.G < NU; DilUnit UN = U;
        asm volatile("s_waitcnt vmcnt(6)" ::: "memory"); AT_BAR();
        if (has_next) { UN = dil_decode(u + F.G); dil_load_q(UN, proj, qn, wid, r32, hi); }
        const int l0 = U.l0, qloc = 32 * wid + r32, tb = wid >> 1, kmin = (128 - l0) > qloc ? (128 - l0) : qloc, kmax = qloc + 128;
        f32x16 za[3], zb[3]; float m = NEG_BIG;
#pragma unroll
        for (int ti = 0; ti < 3; ++ti) {
            at_qkt(za[ti], zb[ti], lds + AT_K + (tb + ti) * 8192, qr, r32, hi);
            const int thr_lo = kmin - 64 * (tb + ti) - 4 * hi, thr_hi = kmax - 64 * (tb + ti) - 4 * hi;
            if (ti == 0 || l0 == 0) {
#pragma unroll
                for (int r = 0; r < 16; ++r) { const int C = (r & 3) + 8 * (r >> 2); za[ti][r] = (C >= thr_lo) ? za[ti][r] : NEG_BIG; zb[ti][r] = (C + 32 >= thr_lo) ? zb[ti][r] : NEG_BIG; } }
            if (ti == 2) {
#pragma unroll
                for (int r = 0; r < 16; ++r) { const int C = (r & 3) + 8 * (r >> 2); za[ti][r] = (C <= thr_hi) ? za[ti][r] : NEG_BIG; zb[ti][r] = (C + 32 <= thr_hi) ? zb[ti][r] : NEG_BIG; } }
#pragma unroll
            for (int r = 0; r < 16; r += 2) m = fmaxf(fmaxf(m, fmaxf(za[ti][r], zb[ti][r])), fmaxf(za[ti][r + 1], zb[ti][r + 1]));
        }
        AT_BAR();
        asm volatile("s_waitcnt vmcnt(0)" : "+v"(qn[0]), "+v"(qn[1]), "+v"(qn[2]), "+v"(qn[3]) :: "memory");
        if (has_next) dil_issue_k(UN, proj, lds, wid, lane);
        m = fmaxf(m, __shfl_xor(m, 32));
        float l = 0.f;
#pragma unroll
        for (int ti = 0; ti < 3; ++ti)
#pragma unroll
            for (int r = 0; r < 16; ++r) { za[ti][r] = __builtin_amdgcn_exp2f(za[ti][r] - m); zb[ti][r] = __builtin_amdgcn_exp2f(zb[ti][r] - m); l += za[ti][r] + zb[ti][r]; }
        l += __shfl_xor(l, 32);
        AT_BAR();
        f32x16 o0, o1;
#pragma unroll
        for (int r = 0; r < 16; ++r) { o0[r] = 0.f; o1[r] = 0.f; }
#pragma unroll
        for (int ti = 0; ti < 3; ++ti) at_pv(o0, o1, lds + AT_V + (tb + ti) * 8192, lane, hi, pack_step<0>(za[ti]), pack_step<1>(za[ti]), pack_step<0>(zb[ti]), pack_step<1>(zb[ti]));
        AT_BAR();
        const size_t qrow = U.rowbase + (size_t)(l0 + qloc) * U.d + U.res;
        LAS float* lsc = (LAS float*)(lds + AT_OST + wid * 4096);
        if (hi == 0) { lsc[r32] = 1.f / l; lse[qrow * 12 + U.gj] = m + __builtin_amdgcn_logf(l); }
        LDS_WAIT();
        float sc[16];
#pragma unroll
        for (int r = 0; r < 16; ++r) sc[r] = lsc[crow(r, hi)];
        LDS_WAIT();
        at_store_o(o0, o1, sc, lds, wid, lane, DilRow{proj + PJ_HM(U.gj, U.prow + l0 + 32 * wid), (size_t)64});
        if (has_next) { dil_issue_v(UN, proj, lds, wid, lane);
#pragma unroll
            for (int d0 = 0; d0 < 4; ++d0) qr[d0] = qn[d0]; U = UN; }
    }
    AT_WAITBAR();
}
template <int W> __device__ __forceinline__ void pool_item(const bf16* uc, bf16* hc, int t0, int s0, int c) {
    unsigned uv[32 + W - 1];
#pragma unroll
    for (int k = 0; k < 32 + W - 1; ++k) { const int dt = k - (W - 1); uv[k] = (s0 + dt >= 0) ? *(const unsigned*)(uc + (size_t)(t0 + dt) * 512 + c) : 0u; }
    float sa = 0.f, sb = 0.f;
#pragma unroll
    for (int k = 0; k < W - 1; ++k) { sa += bflo(uv[k]); sb += bfhi(uv[k]); }
#pragma unroll
    for (int tt = 0; tt < 32; ++tt) { const int s = s0 + tt; const unsigned u = uv[tt + W - 1]; const float ua = bflo(u), ub = bfhi(u);
        sa += ua; sb += ub;
        const float rc = 1.f / (float)((s + 1 < W) ? s + 1 : W);
        *(unsigned*)(hc + (size_t)(t0 + tt) * HC + HC_PL + c) = pk2(sa * rc - ua, sb * rc - ub);
        sa -= bflo(uv[tt]); sb -= bfhi(uv[tt]); }
}
__device__ __forceinline__ void ph_pool_fast(const Frame& F0) { PHASE_FRAME(F0);
    const bf16* uc = (const bf16*)(F.ws + WS_PROJ) + PJ_UC; bf16* hc = (bf16*)(F.ws + WS_HCAT);
    for (int i = F.wg * NTHREADS + F.tid; i < (T / 32) * 256; i += F.G * NTHREADS) {
        const int cp = i & 255, chunk = i >> 8, c = cp * 2, g = __builtin_amdgcn_readfirstlane(c >> 7), t0 = chunk * 32, s0 = t0 % SEQ;
        if (g == 0) pool_item<2>(uc, hc, t0, s0, c); else if (g == 1) pool_item<4>(uc, hc, t0, s0, c); else if (g == 2) pool_item<8>(uc, hc, t0, s0, c); else pool_item<16>(uc, hc, t0, s0, c);
    }
}

typedef __attribute__((address_space(1))) unsigned gu32;
#define RLX_AGENT __ATOMIC_RELAXED, __HIP_MEMORY_SCOPE_AGENT
#define XB_TMO      128
#define XB_XCNT(j)  (256  + 64 * (j))
#define XB_XSUB(j)  (1280 + 64 * (j))
#define XB_XGEN(j)  (2304 + 64 * (j))
#define XB_TOP      3328
#define XB_TOPGEN   3392
#define XCD_BAR_WORDS 3456
#define XB_SPIN_CAP (1u << 18)
__device__ __forceinline__ unsigned xb_ld(unsigned* p)              { return __hip_atomic_load(p, __ATOMIC_RELAXED, __HIP_MEMORY_SCOPE_AGENT); }
__device__ __forceinline__ unsigned xb_add(unsigned* p, unsigned v) { return __hip_atomic_fetch_add(p, v, __ATOMIC_RELAXED, __HIP_MEMORY_SCOPE_AGENT); }
__device__ __forceinline__ unsigned xb_xcc_id() { return (unsigned)__builtin_amdgcn_s_getreg((3 << 11) | 20) & 0xFu; }
#define XB_SPIN(cond, bar) do { unsigned _sp = 0; while (cond) { __builtin_amdgcn_s_sleep(1); \
    if ((++_sp & 255u) == 0u) { if (xb_ld(&(bar)[XB_TMO])) break; if (_sp > XB_SPIN_CAP) { atomicAdd(&(bar)[XB_TMO], 1u); break; } } } } while (0)
struct XcdBarrier { unsigned* bar; unsigned x; volatile LAS unsigned* st; };
__device__ __forceinline__ XcdBarrier xcd_barrier_post(unsigned* bar, volatile LAS unsigned* st, bool t0) {
    XcdBarrier b; b.bar = bar; b.x = xb_xcc_id(); b.st = st;
    if (t0) (void)xb_add(&bar[XB_XCNT(b.x)], 1u);
    return b;
}
__device__ __forceinline__ void xcd_barrier_complete(unsigned* bar, unsigned x, unsigned& nloc, unsigned& nx) {
    const unsigned G = gridDim.x * gridDim.y * gridDim.z;
    unsigned sum, cnt, mine, sp = 0u;
    for (;;) {
        sum = 0u; cnt = 0u; mine = 0u;
#pragma unroll
        for (unsigned j = 0; j < 16; ++j) { const unsigned c = xb_ld(&bar[XB_XCNT(j)]); sum += c; cnt += (c > 0u) ? 1u : 0u; mine = (j == x) ? c : mine; }
        if (sum == G) break;
        __builtin_amdgcn_s_sleep(1);
        if ((++sp & 255u) == 0u) { if (xb_ld(&bar[XB_TMO])) break; if (sp > XB_SPIN_CAP) { atomicAdd(&bar[XB_TMO], 1u); break; } }
    }
    nloc = mine > 0u ? mine : 1u; nx = cnt > 0u ? cnt : 1u;
}
__device__ __forceinline__ void xcd_barrier(const XcdBarrier& b, bool t0) {
    asm volatile("s_waitcnt vmcnt(0)" ::: "memory");
    __syncthreads();
    if (t0) {
        unsigned* bar = b.bar;
        __builtin_amdgcn_s_waitcnt(0);
        unsigned nloc = b.st[0], nx = b.st[1];
        if (nloc == 0u) { xcd_barrier_complete(bar, b.x, nloc, nx); b.st[0] = nloc; b.st[1] = nx; }
        const unsigned old = xb_add(&bar[XB_XSUB(b.x)], 1u);
        const unsigned gen = old / nloc;
        if (old + 1u == (gen + 1u) * nloc) {
            __builtin_amdgcn_fence(__ATOMIC_RELEASE, "agent");
            asm volatile("s_waitcnt vmcnt(0)" ::: "memory");
            const unsigned og = xb_add(&bar[XB_TOP], 1u);
            const unsigned tg = og / nx;
            if (og + 1u == (tg + 1u) * nx) {
#pragma unroll
                for (unsigned j = 0; j < 16; ++j) (void)xb_add(&bar[XB_XGEN(j)], 1u); }
            XB_SPIN(xb_ld(&bar[XB_XGEN(b.x)]) == gen, bar);
            __builtin_amdgcn_fence(__ATOMIC_ACQUIRE, "agent");
            asm volatile("s_waitcnt vmcnt(0)" ::: "memory");
        } else {
            XB_SPIN(xb_ld(&bar[XB_XGEN(b.x)]) == gen, bar);
            __builtin_amdgcn_fence(__ATOMIC_ACQUIRE, "agent");
            asm volatile("s_waitcnt vmcnt(0)" ::: "memory");
        }
    }
    __syncthreads();
}

__device__ __forceinline__ void xcd_barrier_arrive(const XcdBarrier& b, bool t0) {
    asm volatile("s_waitcnt vmcnt(0)" ::: "memory");
    __syncthreads();
    if (t0) {
        unsigned* bar = b.bar;
        __builtin_amdgcn_s_waitcnt(0);
        const unsigned nloc = b.st[0], nx = b.st[1];
        const unsigned old = xb_add(&bar[XB_XSUB(b.x)], 1u);
        const unsigned gen = old / nloc;
        if (old + 1u == (gen + 1u) * nloc) {
            __builtin_amdgcn_fence(__ATOMIC_RELEASE, "agent");
            asm volatile("s_waitcnt vmcnt(0)" ::: "memory");
            const unsigned og = xb_add(&bar[XB_TOP], 1u);
            const unsigned tg = og / nx;
            if (og + 1u == (tg + 1u) * nx) {
#pragma unroll
                for (unsigned j = 0; j < 16; ++j) (void)xb_add(&bar[XB_XGEN(j)], 1u); }
        }
        b.st[4] = gen;
    }
    __syncthreads();
}
__device__ __forceinline__ void xcd_barrier_wait(const XcdBarrier& b, bool t0) {
    if (t0) { unsigned* bar = b.bar; const unsigned gen = b.st[4];
        XB_SPIN(xb_ld(&bar[XB_XGEN(b.x)]) == gen, bar);
        __builtin_amdgcn_fence(__ATOMIC_ACQUIRE, "agent");
        asm volatile("s_waitcnt vmcnt(0)" ::: "memory"); }
    __syncthreads();
}
static_assert(XB_XGEN(0) == 2304, "g4_barrier_wait hard-codes the generation words");

#define USE_FAST_DIL 1
#define USE_FAST_SB 1
#define USE_FAST_POOL 1
constexpr int LDS_BYTES = 163840, MISC_OFF = 131072 + 320;
constexpr int CW_BAR = 4096; static_assert(CW_BAR == 4096 && MISC_OFF == 131072 + 320, "ph_g4_fast hard-codes the barrier words");

__global__ void __launch_bounds__(NTHREADS, 2) mega(Args args) {
    Frame F{}; F.wave = __builtin_amdgcn_readfirstlane((int)threadIdx.x >> 6);
    volatile LAS unsigned* MISC = (volatile LAS unsigned*)((LAS unsigned char*)lds_raw + MISC_OFF);
    if (threadIdx.x < 32) MISC[threadIdx.x] = 0u;
    __syncthreads();
    (void)xcd_barrier_post((unsigned*)((unsigned char*)arg_ptr<26>() + WS_CTL) + CW_BAR, MISC + 8, threadIdx.x == 0);
#define GRID_BAR() do { XcdBarrier b_; b_.bar = (unsigned*)((unsigned char*)arg_ptr<26>() + WS_CTL) + CW_BAR; b_.x = xb_xcc_id(); b_.st = MISC + 8; xcd_barrier(b_, F.wave == 0 && lane_id() == 0); } while (0)
#define GRID_ARRIVE() do { XcdBarrier b_; b_.bar = (unsigned*)((unsigned char*)arg_ptr<26>() + WS_CTL) + CW_BAR; b_.x = xb_xcc_id(); b_.st = MISC + 8; xcd_barrier_arrive(b_, F.wave == 0 && lane_id() == 0); } while (0)
#define GRID_WAIT() do { XcdBarrier b_; b_.bar = (unsigned*)((unsigned char*)arg_ptr<26>() + WS_CTL) + CW_BAR; b_.x = xb_xcc_id(); b_.st = MISC + 8; xcd_barrier_wait(b_, F.wave == 0 && lane_id() == 0); } while (0)
#define LAYER_PROGRAM(layer) do { \
        if (layer == 0) { ph_wconv(F, layer); ph_norm1(F, layer); ph_ropetab(F); \
        GRID_BAR(); } \
        ph_proj_fast(F, layer); \
        GRID_BAR(); \
        ph_dil_fast(F); ph_sb_fast(F); \
        GRID_ARRIVE();   \
        ph_pool_fast(F); \
        GRID_WAIT(); \
        ph_comb_naive(F, layer); \
        GRID_ARRIVE(); \
        ph_g4_fast(F, layer); \
        GRID_BAR(); \
        ph_g5_fast(F, layer); \
        GRID_ARRIVE(); \
        ph_route_pre(F, layer); \
        GRID_WAIT(); \
        ph_route2(F, layer); \
        GRID_BAR(); \
        ph_scatter2(F); \
        GRID_BAR(); \
        ph_m1_fast(F, layer); \
        GRID_BAR(); \
        ph_m2_fast(F); \
        GRID_BAR(); \
        ph_e_fast(F, layer); \
        GRID_BAR(); \
        ph_ple_fast(F, layer); \
        GRID_BAR(); \
     \
    } while (0)
    LAYER_PROGRAM(0);
    LAYER_PROGRAM(1);
    ph_final(F);
}

extern "C" void kernel_launch(void* const* d_in, const int* in_sizes, int n_in, void* d_out, int out_size, void* d_ws, size_t ws_size, hipStream_t stream) {
    static int grid = 0;
    if (grid == 0) {
        if (n_in != N_IN || out_size != T * D || ws_size < WS_END) { fprintf(stderr, "kernel_launch: unexpected shapes n_in %d out %d ws %zu\n", n_in, out_size, ws_size); grid = -1; return; }
        int dev = 0, cus = 0, per_cu = 0;
        (void)hipGetDevice(&dev); (void)hipDeviceGetAttribute(&cus, hipDeviceAttributeMultiprocessorCount, dev);
        if (hipFuncSetAttribute((const void*)mega, hipFuncAttributeMaxDynamicSharedMemorySize, LDS_BYTES) != hipSuccess) { fprintf(stderr, "kernel_launch: hipFuncSetAttribute failed\n"); grid = -1; return; }
        if (hipOccupancyMaxActiveBlocksPerMultiprocessor(&per_cu, (const void*)mega, NTHREADS, LDS_BYTES) != hipSuccess || per_cu < 1) { fprintf(stderr, "kernel_launch: occupancy query says %d blocks per CU\n", per_cu); grid = -1; return; }
        (void)hipGetLastError();
        if (cus < 256) { fprintf(stderr, "kernel_launch: needs >= 256 CUs\n"); grid = -1; return; }
        grid = 256;
    }
    if (grid < 0) return;
    (void)hipMemsetAsync((char*)d_ws + WS_CTL, 0, 32 * 1024, stream);
    Args a{};
    for (int i = 0; i < N_IN; ++i) a.in[i] = d_in[i];
    a.out = (float*)d_out; a.ws = (unsigned char*)d_ws;
    void* kargs[] = {&a};
    hipError_t e = hipLaunchCooperativeKernel((const void*)mega, dim3(grid), dim3(NTHREADS), kargs, LDS_BYTES, stream);
    if (e != hipSuccess) fprintf(stderr, "kernel_launch: cooperative launch failed: %s (grid %d)\n", hipGetErrorString(e), grid);
}
```
